# Optimizing an MI355X kernel written in HIP

```python
import math
import jax
import jax.numpy as jnp
from jax import lax
import numpy as np


D_MODEL = 1024
BATCH = 1
SEQ = 16384
DEPTH = 4

N_MIXERS = 2
S5_GROUP = 16
S5_GROUPS = D_MODEL // S5_GROUP
S5_STATE = 64
N_HEADS = 16
HEAD_DIM = D_MODEL // N_HEADS
IDX_HEADS = 8
IDX_DIM = 64
TOPK_MAX = 256
Q_BLOCK = 128
ROPE_THETA = 10000.0
D_FF = ((8 * D_MODEL // 3 + 255) // 256) * 256
N_S5 = (DEPTH + 1) // 2
N_DSA = DEPTH // 2
DSA_PROJ = 3 * D_MODEL + IDX_HEADS * IDX_DIM + IDX_DIM + IDX_HEADS
EPS = 1e-6

kernel_name = 'hybrid_s5_dsa_swiglu_trunk'


def rmsnorm(x, gain):
    xf = x.astype(jnp.float32)
    y = xf * lax.rsqrt(jnp.mean(xf * xf, axis=-1, keepdims=True) + EPS)
    if gain is not None:
        y = y * gain.astype(jnp.float32)
    return y.astype(x.dtype)


def rope_tables(length):
    inv_freq = ROPE_THETA ** (-jnp.arange(0, HEAD_DIM, 2, dtype=jnp.float32) / HEAD_DIM)
    ang = jnp.arange(length, dtype=jnp.float32)[:, None] * inv_freq[None, :]
    return jnp.cos(ang), jnp.sin(ang)


def apply_rope(t, cos, sin):
    tf = t.astype(jnp.float32)
    t1, t2 = jnp.split(tf, 2, axis=-1)
    c = cos[None, :, None, :]
    s = sin[None, :, None, :]
    out = jnp.concatenate([t1 * c - t2 * s, t2 * c + t1 * s], axis=-1)
    return out.astype(t.dtype)


def _ssm_combine(e1, e2):
    a1, b1 = e1
    a2, b2 = e2
    return a1 * a2, a2 * b1 + b2


def s5_mixer(u, lam_re, lam_im, log_dt, b_re, b_im, c_re, c_im, d_skip, w_glu):
    bsz, length, _ = u.shape
    f32 = jnp.float32
    lam = lax.complex(lam_re.astype(f32), lam_im.astype(f32))
    dt = jnp.exp(log_dt.astype(f32))[:, None]
    a_bar = jnp.exp(lam * dt)
    b_bar = ((a_bar - 1.0) / lam)[..., None] * lax.complex(b_re.astype(f32), b_im.astype(f32))
    ug = u.astype(f32).reshape(bsz, length, S5_GROUPS, S5_GROUP).astype(jnp.complex64)
    bu = jnp.einsum('blgh,gph->blgp', ug, b_bar)
    a_seq = jnp.broadcast_to(a_bar, bu.shape)
    _, states = lax.associative_scan(_ssm_combine, (a_seq, bu), axis=1)
    c = lax.complex(c_re.astype(f32), c_im.astype(f32))
    y = jnp.einsum('blgp,ghp->blgh', states, c).real.reshape(bsz, length, D_MODEL)
    y = y + d_skip.astype(f32) * u.astype(f32)
    y = jax.nn.gelu(y).astype(u.dtype)
    val, gate = jnp.split(y @ w_glu, 2, axis=-1)
    return val * jax.nn.sigmoid(gate)


def dsa_mixer(h, w_in, q_gain, k_gain, w_o, cos, sin, topk):
    bsz, length, _ = h.shape
    f32 = jnp.float32
    proj = h @ w_in
    cuts = [D_MODEL, 2 * D_MODEL, 3 * D_MODEL, 3 * D_MODEL + IDX_HEADS * IDX_DIM,
            3 * D_MODEL + IDX_HEADS * IDX_DIM + IDX_DIM]
    q, k, v, qi, ki, wi = jnp.split(proj, cuts, axis=-1)
    q = q.reshape(bsz, length, N_HEADS, HEAD_DIM)
    k = k.reshape(bsz, length, N_HEADS, HEAD_DIM)
    v = v.reshape(bsz, length, N_HEADS, HEAD_DIM)
    qi = qi.reshape(bsz, length, IDX_HEADS, IDX_DIM)
    q = apply_rope(rmsnorm(q, q_gain), cos, sin)
    k = apply_rope(rmsnorm(k, k_gain), cos, sin)
    qi = apply_rope(qi, cos, sin)
    ki = apply_rope(rmsnorm(ki, None)[:, :, None, :], cos, sin)[:, :, 0, :]
    wi = wi.astype(f32) * (IDX_HEADS ** -0.5)
    nb = length // Q_BLOCK
    kpos = jnp.arange(length, dtype=jnp.int32)
    qpos_blocks = kpos.reshape(nb, Q_BLOCK)
    att_scale = HEAD_DIM ** -0.5
    idx_scale = IDX_DIM ** -0.5

    def to_blocks(t):
        return t.reshape(bsz, nb, Q_BLOCK, *t.shape[2:]).swapaxes(0, 1)

    def attend_block(args):
        qb, qib, wb, qpos = args
        s_idx = jnp.einsum('bqhd,bkd->bqhk', qib, ki).astype(f32) * idx_scale
        score = jnp.einsum('bqhk,bqh->bqk', jax.nn.relu(s_idx), wb)
        causal = kpos[None, None, :] <= qpos[None, :, None]
        score = jnp.where(causal, score, -jnp.inf)
        _, sel = lax.top_k(score, topk)
        kg = jax.vmap(lambda kb, ib: kb[ib])(k, sel)
        vg = jax.vmap(lambda vb, ib: vb[ib])(v, sel)
        logits = jnp.einsum('bqhd,bqkhd->bhqk', qb, kg).astype(f32) * att_scale
        valid = (sel <= qpos[None, :, None])[:, None, :, :]
        logits = jnp.where(valid, logits, -jnp.inf)
        p = jax.nn.softmax(logits, axis=-1).astype(vg.dtype)
        return jnp.einsum('bhqk,bqkhd->bqhd', p, vg)

    out = lax.map(attend_block, (to_blocks(q), to_blocks(qi), to_blocks(wi), qpos_blocks))
    out = out.swapaxes(0, 1).reshape(bsz, length, D_MODEL)
    return out @ w_o


def swiglu(h, w_gate_up, w_down):
    gate, up = jnp.split(h @ w_gate_up, 2, axis=-1)
    return (jax.nn.silu(gate) * up) @ w_down


def setup_inputs(seed: int = 0) -> dict:
    key = jax.random.key(seed)
    ks = jax.random.split(key, 20)
    f32 = jnp.float32
    nrm = lambda k, shape, s: jax.random.normal(k, shape, f32) * s
    x = jax.random.normal(ks[0], (BATCH, SEQ, D_MODEL), f32)
    n_idx = jnp.arange(S5_STATE, dtype=f32)
    s5_lambda_re = -0.5 + nrm(ks[1], (N_S5, S5_GROUPS, S5_STATE), 0.01)
    s5_lambda_im = math.pi * n_idx[None, None, :] + nrm(ks[2], (N_S5, S5_GROUPS, S5_STATE), 0.01)
    s5_log_dt = jax.random.uniform(ks[3], (N_S5, S5_GROUPS), f32, math.log(1e-3), math.log(1e-1))
    s5_b_re = nrm(ks[4], (N_S5, S5_GROUPS, S5_STATE, S5_GROUP), (2 * S5_GROUP) ** -0.5)
    s5_b_im = nrm(ks[5], (N_S5, S5_GROUPS, S5_STATE, S5_GROUP), (2 * S5_GROUP) ** -0.5)
    s5_c_re = nrm(ks[6], (N_S5, S5_GROUPS, S5_GROUP, S5_STATE), (2 * S5_STATE) ** -0.5)
    s5_c_im = nrm(ks[7], (N_S5, S5_GROUPS, S5_GROUP, S5_STATE), (2 * S5_STATE) ** -0.5)
    s5_d = nrm(ks[8], (N_S5, D_MODEL), 1.0)
    s5_w_glu = nrm(ks[9], (N_S5, D_MODEL, 2 * D_MODEL), D_MODEL ** -0.5)
    dsa_w_in = nrm(ks[10], (N_DSA, D_MODEL, DSA_PROJ), D_MODEL ** -0.5)
    dsa_q_norm = 1.0 + nrm(ks[11], (N_DSA, HEAD_DIM), 0.02)
    dsa_k_norm = 1.0 + nrm(ks[12], (N_DSA, HEAD_DIM), 0.02)
    dsa_w_o = nrm(ks[13], (N_DSA, D_MODEL, D_MODEL), D_MODEL ** -0.5)
    ffn_w_gate_up = nrm(ks[14], (DEPTH, D_MODEL, 2 * D_FF), D_MODEL ** -0.5)
    ffn_w_down = nrm(ks[15], (DEPTH, D_FF, D_MODEL), D_FF ** -0.5)
    norm_mix = 1.0 + nrm(ks[16], (DEPTH, D_MODEL), 0.02)
    norm_ffn = 1.0 + nrm(ks[17], (DEPTH, D_MODEL), 0.02)
    return {'x': x, 's5_lambda_re': s5_lambda_re, 's5_lambda_im': s5_lambda_im, 's5_log_dt': s5_log_dt,
            's5_b_re': s5_b_re, 's5_b_im': s5_b_im, 's5_c_re': s5_c_re, 's5_c_im': s5_c_im,
            's5_d': s5_d, 's5_w_glu': s5_w_glu, 'dsa_w_in': dsa_w_in, 'dsa_q_norm': dsa_q_norm,
            'dsa_k_norm': dsa_k_norm, 'dsa_w_o': dsa_w_o, 'ffn_w_gate_up': ffn_w_gate_up,
            'ffn_w_down': ffn_w_down, 'norm_mix': norm_mix, 'norm_ffn': norm_ffn}


def reference(x, s5_lambda_re, s5_lambda_im, s5_log_dt, s5_b_re, s5_b_im, s5_c_re, s5_c_im,
              s5_d, s5_w_glu, dsa_w_in, dsa_q_norm, dsa_k_norm, dsa_w_o, ffn_w_gate_up,
              ffn_w_down, norm_mix, norm_ffn):
    length = x.shape[1]
    topk = min(TOPK_MAX, length // 4)
    cos, sin = rope_tables(length)
    for i in range(DEPTH):
        h = rmsnorm(x, norm_mix[i])
        j = i // N_MIXERS
        if i % N_MIXERS == 0:
            mix = s5_mixer(h, s5_lambda_re[j], s5_lambda_im[j], s5_log_dt[j], s5_b_re[j], s5_b_im[j],
                           s5_c_re[j], s5_c_im[j], s5_d[j], s5_w_glu[j])
        else:
            mix = dsa_mixer(h, dsa_w_in[j], dsa_q_norm[j], dsa_k_norm[j], dsa_w_o[j], cos, sin, topk)
        x = x + mix.astype(x.dtype)
        x = x + swiglu(rmsnorm(x, norm_ffn[i]), ffn_w_gate_up[i], ffn_w_down[i]).astype(x.dtype)
    return x
```

```cpp
#ifndef EMU
#include <hip/hip_runtime.h>
#include <hip/hip_cooperative_groups.h>
#include <cstdio>
#include <cstdint>
#include <cmath>
#endif

#ifdef CFG_SMALL
constexpr int D_MODEL = 256, SEQ = 4096, DEPTH = 2, N_HEADS = 4;
#else
constexpr int D_MODEL = 1024, SEQ = 16384, DEPTH = 4, N_HEADS = 16;
#endif
constexpr int S5_GROUPS = D_MODEL / 16, S5_STATE = 64, HEAD_DIM = 64, IDX_HEADS = 8, TOPK = 256;
constexpr int D_FF = ((8 * D_MODEL / 3 + 255) / 256) * 256;
constexpr int N_S5 = (DEPTH + 1) / 2, N_DSA = DEPTH / 2;
constexpr int DSA_PROJ = 3 * D_MODEL + 512 + 64 + 8;
constexpr int NH4 = D_MODEL / 256;
constexpr int NIN_TILES = 3 * NH4 + 3, NIN_PAD = NIN_TILES * 256;
constexpr int NCH = SEQ / 16, NCHT = NCH / 256;
constexpr int UXW = 384;
constexpr int NSEG = 16, SEGL = NCH / NSEG;
constexpr float EPS = 1e-6f;
constexpr float C2 = 0.125f * 1.4426950408889634f;
constexpr int NWAVES = 8, NTHREADS = 512;
constexpr int NBINS = 1024; constexpr float BIN_LO = -8.f, BIN_SCALE = 64.f;
constexpr int CAND_CAP = 256;

constexpr size_t MiB = 1u << 20;
constexpr size_t WS_CTL = 0, CTL_BYTES = 3 * MiB;
constexpr size_t WS_ROWSS = 1 * MiB;
constexpr size_t SZ_WGLU = (size_t)2 * D_MODEL * D_MODEL * 2, SZ_WIN = (size_t)NIN_PAD * D_MODEL * 2, SZ_WO = (size_t)D_MODEL * D_MODEL * 2,
                 SZ_WGU = (size_t)2 * D_FF * D_MODEL * 2, SZ_WDN = (size_t)D_MODEL * D_FF * 2;
constexpr size_t WS_WGLU = CTL_BYTES, WS_WIN = WS_WGLU + N_S5 * SZ_WGLU, WS_WO = WS_WIN + N_DSA * SZ_WIN, WS_WGU = WS_WO + N_DSA * SZ_WO,
                 WS_WDN = WS_WGU + DEPTH * SZ_WGU, WS_ROPE = WS_WDN + DEPTH * SZ_WDN;
constexpr size_t SZ_ROPE = (size_t)SEQ * 64 * 4;
constexpr size_t S5PRE_STRIDE = 18432;
constexpr size_t WS_S5PRE = WS_ROPE + SZ_ROPE, SZ_S5PRE = (size_t)N_S5 * S5_GROUPS * S5PRE_STRIDE;
constexpr size_t WS_MIX = WS_S5PRE + SZ_S5PRE;
constexpr size_t SZ_AM = (size_t)S5_GROUPS * 256 * UXW * 2, SZ_W1 = (size_t)S5_GROUPS * 256 * 256 * 2, SZ_APOW = (size_t)S5_GROUPS * 64 * 16;
constexpr size_t MIX_AM = 0, MIX_W1 = MIX_AM + SZ_AM;
constexpr size_t MIX_QI = 0, SZ_QI = (size_t)SEQ * 512 * 2, MIX_KI = MIX_QI + SZ_QI, SZ_KI = (size_t)SEQ * 64 * 2, MIX_WI = MIX_KI + SZ_KI, SZ_WI = (size_t)SEQ * 8 * 4;
constexpr size_t SZ_MIX_S5 = MIX_W1 + SZ_W1, SZ_MIX_DSA = MIX_WI + SZ_WI;
constexpr size_t SZ_MIX = ((SZ_MIX_S5 > SZ_MIX_DSA ? SZ_MIX_S5 : SZ_MIX_DSA) + 4095) / 4096 * 4096;
constexpr size_t WS_XB = WS_MIX + SZ_MIX, SZ_XB = (size_t)SEQ * D_MODEL * 2;
constexpr size_t SZ_MASK = (size_t)(SEQ / 32) * SEQ * 4;
constexpr size_t SZ_XBM = SZ_XB > SZ_MASK ? SZ_XB : SZ_MASK;
constexpr size_t WS_R = WS_XB + SZ_XBM;
constexpr size_t R_Q = 0, R_K = SZ_XB, R_V = 2 * SZ_XB;
constexpr size_t R_ACT = 0, SZ_ACT = (size_t)SEQ * D_FF * 2;
constexpr size_t R_UX = 0, SZ_UX = (size_t)S5_GROUPS * NCH * UXW * 2, R_S = ((SZ_UX + 4095) / 4096) * 4096, SZ_S = (size_t)S5_GROUPS * NCH * 128 * 4, R_Y = R_S;
constexpr size_t SZ_R0 = 3 * SZ_XB > SZ_ACT ? 3 * SZ_XB : SZ_ACT, SZ_R1 = R_S + SZ_S, SZ_R = SZ_R0 > SZ_R1 ? SZ_R0 : SZ_R1;
constexpr size_t WS_END = WS_R + SZ_R;
static_assert(SZ_S >= (size_t)SEQ * D_MODEL * 2, "Y fits over S");
static_assert((2 * DEPTH + 1) * (size_t)SEQ * 8 <= 2 * MiB, "rowss arrays fit");
typedef unsigned long long u64;
constexpr float SS_FIX = 1048576.0f, SS_INV = 1.0f / 1048576.0f;

typedef unsigned short bf16_t;
typedef short bf16x8 __attribute__((ext_vector_type(8)));
typedef float f32x4 __attribute__((ext_vector_type(4)));
typedef float f32x16 __attribute__((ext_vector_type(16)));
typedef unsigned u32x4 __attribute__((ext_vector_type(4)));
typedef unsigned u32x2 __attribute__((ext_vector_type(2)));
typedef short s16x4 __attribute__((ext_vector_type(4)));

#ifdef EMU
#define LAS
#define GAS
#define MFMA16(a, b, c) emu_mfma16(a, b, c)
#define MFMA32(a, b, c) emu_mfma32(a, b, c)
#define WAIT_V(n)
#define WAIT_L(n) emu::wave_barrier()
#define WAIT_VM0() do {} while (0)
#define S_BARRIER() emu::block_barrier()
#define SCHED_BAR()
#define PIN16(x)
#define PIN1(x)
#define SETPRIO(x)
#define RFL(x) (x)
#define GLDS16(g, l) emu_glds16((const void*)(g), (void*)(l))
#define DS_TR16(p) emu_ds_read_tr16((const void*)(p))
#define EXP2F(x) exp2f(x)
#define RCPF(x) (1.0f / (x))
#define RSQF(x) (1.0f / sqrtf(x))
#define LDS_ATOMIC_ADD(p, v) atomicAdd((unsigned*)(p), (unsigned)(v))
#define LDS_ATOMIC_OR(p, v) atomicOr((unsigned*)(p), (unsigned)(v))
#define RLX_LOAD(p) (*(p))
#define RLX_STORE(p, v) (*(p) = (v))
#define RLX_ADD(p, v) atomicAdd((unsigned*)(p), (unsigned)(v))
#else
#define LAS __attribute__((address_space(3)))
#define GAS __attribute__((address_space(1)))
#define MFMA16(a, b, c) __builtin_amdgcn_mfma_f32_16x16x32_bf16(a, b, c, 0, 0, 0)
#define MFMA32(a, b, c) __builtin_amdgcn_mfma_f32_32x32x16_bf16(a, b, c, 0, 0, 0)
#define WAIT_V(n) asm volatile("s_waitcnt vmcnt(" #n ")" ::: "memory")
#define WAIT_L(n) asm volatile("s_waitcnt lgkmcnt(" #n ")" ::: "memory")
#define WAIT_VM0() asm volatile("s_waitcnt vmcnt(0)" ::: "memory")
#define S_BARRIER() __builtin_amdgcn_s_barrier()
#define SCHED_BAR() __builtin_amdgcn_sched_barrier(0)
#define PIN16(x) asm volatile("" : "+v"(x))
#define PIN1(x) asm volatile("" : "+v"(x))
#define SETPRIO(x) __builtin_amdgcn_s_setprio(x)
#define RFL(x) __builtin_amdgcn_readfirstlane(x)
#define GLDS16(g, l) __builtin_amdgcn_global_load_lds((const unsigned*)(g), (LAS unsigned*)(l), 16, 0, 0)
typedef short v4i16_t __attribute__((ext_vector_type(4)));
#define DS_TR16(p) __builtin_bit_cast(s16x4, __builtin_amdgcn_ds_read_tr16_b64_v4i16((LAS v4i16_t*)(p)))
#define EXP2F(x) __builtin_amdgcn_exp2f(x)
#define RCPF(x) __builtin_amdgcn_rcpf(x)
#define RSQF(x) __builtin_amdgcn_rsqf(x)
#define LDS_ATOMIC_ADD(p, v) __hip_atomic_fetch_add((LAS unsigned*)(p), (unsigned)(v), __ATOMIC_RELAXED, __HIP_MEMORY_SCOPE_WORKGROUP)
#define LDS_ATOMIC_OR(p, v) __hip_atomic_fetch_or((LAS unsigned*)(p), (unsigned)(v), __ATOMIC_RELAXED, __HIP_MEMORY_SCOPE_WORKGROUP)
#define RLX_LOAD(p) __hip_atomic_load(p, __ATOMIC_RELAXED, __HIP_MEMORY_SCOPE_AGENT)
#define RLX_STORE(p, v) __hip_atomic_store(p, v, __ATOMIC_RELAXED, __HIP_MEMORY_SCOPE_AGENT)
#define RLX_ADD(p, v) __hip_atomic_fetch_add(p, v, __ATOMIC_RELAXED, __HIP_MEMORY_SCOPE_AGENT)
#endif

__device__ __forceinline__ int opaque(int v) { PIN1(v); return v; }
__device__ __forceinline__ unsigned f2bf(float f) { unsigned u = __builtin_bit_cast(unsigned, f); return (u + 0x7fffu + ((u >> 16) & 1u)) >> 16; }
__device__ __forceinline__ unsigned pk2(float lo, float hi) { return f2bf(lo) | (f2bf(hi) << 16); }
__device__ __forceinline__ float bf2f(unsigned h) { return __builtin_bit_cast(float, h << 16); }
__device__ __forceinline__ float bflo(unsigned w) { return __builtin_bit_cast(float, w << 16); }
__device__ __forceinline__ float bfhi(unsigned w) { return __builtin_bit_cast(float, w & 0xffff0000u); }
__device__ __forceinline__ float sigmoidf_(float v) { return RCPF(1.0f + EXP2F(-1.4426950408889634f * v)); }
__device__ __forceinline__ float gelu_tanh(float v) { const float z = 0.7978845608028654f * (v + 0.044715f * v * v * v); return v * RCPF(1.0f + EXP2F(-2.885390081777927f * z)); }
__device__ __forceinline__ float row_rs(const u64* rowss, int r) { return RSQF((float)rowss[r] * (SS_INV / D_MODEL) + EPS); }
__device__ __forceinline__ int crow(int r, int hi) { return (r & 3) + 8 * (r >> 2) + 4 * hi; }

#define XB_TMO      128
#define XB_XCNT(j)  (256  + 64 * (j))
#define XB_XSUB(j)  (1280 + 64 * (j))
#define XB_XGEN(j)  (2304 + 64 * (j))
#define XB_TOP      3328
#define XB_TOPGEN   3392
#define XCD_BAR_WORDS 3456
#define XB_SPIN_CAP 0xF0000000u
struct XcdBarrier { unsigned* bar; unsigned x; volatile LAS unsigned* st; };
#ifdef EMU
__device__ __forceinline__ XcdBarrier xcd_barrier_post(unsigned* bar, volatile unsigned* st) { XcdBarrier b; b.bar = bar; b.x = 0; b.st = st; return b; }
__device__ __forceinline__ void xcd_barrier(const XcdBarrier&) { emu::grid_barrier(); }
#else
__device__ __forceinline__ unsigned xb_ld(unsigned* p)              { return __hip_atomic_load(p, __ATOMIC_RELAXED, __HIP_MEMORY_SCOPE_AGENT); }
__device__ __forceinline__ unsigned xb_add(unsigned* p, unsigned v) { return __hip_atomic_fetch_add(p, v, __ATOMIC_RELAXED, __HIP_MEMORY_SCOPE_AGENT); }
__device__ __forceinline__ unsigned xb_xcc_id() { return (unsigned)__builtin_amdgcn_s_getreg((3 << 11) | 20) & 0xFu; }
#define XB_SPIN(cond, bar) do { unsigned _sp = 0; while (cond) { __builtin_amdgcn_s_sleep(1); \
    if ((++_sp & 255u) == 0u) { if (xb_ld(&(bar)[XB_TMO])) break; if (_sp > XB_SPIN_CAP) { atomicAdd(&(bar)[XB_TMO], 1u); break; } } } } while (0)
__device__ __forceinline__ XcdBarrier xcd_barrier_post(unsigned* bar, volatile LAS unsigned* st) {
    XcdBarrier b; b.bar = bar; b.x = (unsigned)__builtin_amdgcn_readfirstlane((int)xb_xcc_id()); b.st = st;
    if (threadIdx.x == 0) (void)xb_add(&bar[XB_XCNT(b.x)], 1u);
    return b;
}
__device__ __forceinline__ void xcd_barrier_complete(unsigned* bar, unsigned x, unsigned& nloc, unsigned& nx) {
    const unsigned G = gridDim.x * gridDim.y * gridDim.z;
    unsigned sum, cnt, mine, sp = 0u;
    for (;;) {
        sum = 0u; cnt = 0u; mine = 0u;
#pragma unroll
        for (unsigned j = 0; j < 16; ++j) { const unsigned c = xb_ld(&bar[XB_XCNT(j)]); sum += c; cnt += (c > 0u) ? 1u : 0u; mine = (j == x) ? c : mine; }
        if (sum == G) break;
        __builtin_amdgcn_s_sleep(1);
        if ((++sp & 255u) == 0u) { if (xb_ld(&bar[XB_TMO])) break; if (sp > XB_SPIN_CAP) { atomicAdd(&bar[XB_TMO], 1u); break; } }
    }
    nloc = mine > 0u ? mine : 1u; nx = cnt > 0u ? cnt : 1u;
}
__device__ __forceinline__ void xcd_barrier(const XcdBarrier& b) {
    asm volatile("s_waitcnt vmcnt(0)" ::: "memory");
    __syncthreads();
    if (threadIdx.x == 0) {
        unsigned* bar = b.bar; const unsigned bx = (unsigned)__builtin_amdgcn_readfirstlane(opaque((int)b.x));
        __builtin_amdgcn_s_waitcnt(0);
        unsigned nloc = b.st[0], nx = b.st[1];
        if (nloc == 0u) { xcd_barrier_complete(bar, bx, nloc, nx); b.st[0] = nloc; b.st[1] = nx; }
        const unsigned old = xb_add(&bar[XB_XSUB(bx)], 1u);
        const unsigned gen = old / nloc;
        if (old + 1u == (gen + 1u) * nloc) {
            __builtin_amdgcn_fence(__ATOMIC_RELEASE, "agent");
            asm volatile("s_waitcnt vmcnt(0)" ::: "memory");
            const unsigned og = xb_add(&bar[XB_TOP], 1u);
            const unsigned tg = og / nx;
            if (og + 1u == (tg + 1u) * nx) xb_add(&bar[XB_TOPGEN], 1u);
            else XB_SPIN(xb_ld(&bar[XB_TOPGEN]) == tg, bar);
            __builtin_amdgcn_fence(__ATOMIC_ACQUIRE, "agent");
            xb_add(&bar[XB_XGEN(bx)], 1u);
            asm volatile("s_waitcnt vmcnt(0)" ::: "memory");
        } else {
            XB_SPIN(xb_ld(&bar[XB_XGEN(bx)]) == gen, bar);
            __builtin_amdgcn_fence(__ATOMIC_ACQUIRE, "agent");
            asm volatile("s_waitcnt vmcnt(0)" ::: "memory");
        }
    }
    __syncthreads();
}
#endif

namespace pg8 {
constexpr int BM = 256, BK = 64, HALF = 128, HTB = HALF * BK * 2, STAGE_BYTES = 8 * HTB, NXCD = 8, WGM = 8;
__host__ __device__ __forceinline__ int lds_byte(int r, int c) { const int st = (r >> 4) * 2 + (c >> 5), rr = r & 15, cc = c & 31, ob = rr * 64 + cc * 2; return st * 1024 + (ob ^ (((ob >> 9) & 1) << 5)); }
__host__ __device__ __forceinline__ void stage_rc(int b, int& R, int& C) { const int st = b / 1024, sb = b % 1024, swz = sb ^ (((sb >> 9) & 1) << 5); R = (st >> 1) * 16 + swz / 64; C = (st & 1) * 32 + (swz % 64) / 2; }
__host__ __device__ __forceinline__ int perm32(int rho) { const int n = rho >> 4, i = rho & 15; return 8 * (i >> 2) + 4 * n + (i & 3); }
struct Unit { int pm, pn; };
struct Gemm { const bf16_t* A; const bf16_t* Bt; int lda, ldb, K; };
struct StaticOrder {
    int nM, nN, nwg, G, c;
    __host__ __device__ void init(int M, int N, int G_, int c_) { nM = M / BM; nN = N / BM; nwg = nM * nN; G = G_; c = c_; }
    __host__ __device__ bool next(int i, Unit& u) const {
        const long L = (long)i * G + c; if (L >= nwg) return false;
        int wgid = (int)L; { const int q = nwg / NXCD, r = nwg % NXCD, xcd = wgid % NXCD, off = wgid / NXCD; wgid = (xcd < r ? xcd * (q + 1) : r * (q + 1) + (xcd - r) * q) + off; }
        const int nig = WGM * nN, gid = wgid / nig, fm = gid * WGM, gsz = (nM - fm) < WGM ? (nM - fm) : WGM;
        u.pm = fm + ((wgid % nig) % gsz); u.pn = (wgid % nig) / gsz; return true;
    }
};
struct GroupOrder {
    int G, c;
    __host__ __device__ bool next(int i, Unit& u) const { const int idx = i * G + c; if (idx >= S5_GROUPS * NCHT) return false; const int g = idx / NCHT; u.pm = idx; u.pn = g; return true; }
};

template <class Epi, class Sched>
__device__ __forceinline__ void gemm_phase(LAS unsigned char* lds, const Gemm g, const Sched& S, const Epi& E) {
    const int tid = opaque((int)threadIdx.x), wid = RFL(tid >> 6), lane = tid & 63, wr = wid >> 2, wc = wid & 3, fr = lane & 15, fq = lane >> 4;
    const int K = g.K, nt = K / BK;
    unsigned voffA[2], voffB[2];
#pragma unroll
    for (int i = 0; i < 2; ++i) { int R, C; stage_rc(tid * 16 + i * 8192, R, C); const int Rb = Epi::PERM ? ((R & ~31) + perm32(R & 31)) : R;
        voffA[i] = (unsigned)(R * g.lda + C) * 2u; voffB[i] = (unsigned)(Rb * g.ldb + C) * 2u; }
    const size_t kstep = (size_t)(BK * 2);
    const size_t hstepA = (size_t)HALF * g.lda * 2, hstepB = (size_t)HALF * g.ldb * 2;
    const size_t tstepA = 2 * hstepA, tstepB = 2 * hstepB;
    const unsigned ldsw = (unsigned)wid * 1024u;
    const int aoff = lds_byte(wr * 64 + fr, fq * 8), boff = lds_byte(wc * 32 + fr, fq * 8);
#define PG8_SA(b, h) (((b) * 2 + (h)) * HTB)
#define PG8_SB(b, h) ((4 + (b) * 2 + (h)) * HTB)
#define PG8_STAGE(bufoff, gbase, voff) do { _Pragma("unroll") for (int _i = 0; _i < 2; ++_i) \
        GLDS16((const char*)(gbase) + (voff)[_i], lds + (bufoff) + ldsw + _i * 8192); } while (0)
#define PG8_LDA(dst, b, h) do { _Pragma("unroll") for (int m = 0; m < 4; ++m) _Pragma("unroll") for (int k = 0; k < 2; ++k) dst[m][k] = *(const LAS bf16x8*)(lds + PG8_SA(b, h) + aoff + m * 2048 + k * 1024); } while (0)
#define PG8_LDB(dst, b, h) do { _Pragma("unroll") for (int n = 0; n < 2; ++n) _Pragma("unroll") for (int k = 0; k < 2; ++k) dst[n][k] = *(const LAS bf16x8*)(lds + PG8_SB(b, h) + boff + n * 2048 + k * 1024); } while (0)
#define PG8_MMA(ai, bj, At, Bt) do { SETPRIO(1); _Pragma("unroll") for (int m = 0; m < 4; ++m) _Pragma("unroll") for (int n = 0; n < 2; ++n) _Pragma("unroll") for (int k = 0; k < 2; ++k) \
        acc[ai][bj][m][n] = MFMA16(Bt[n][k], At[m][k], acc[ai][bj][m][n]); SETPRIO(0); } while (0)
#define PG8_BAR S_BARRIER()
    Unit cur, nxt; int ui = 0;
    if (!S.next(0, cur)) return;
    f32x4 acc[2][2][4][2];
#pragma unroll
    for (int a = 0; a < 2; ++a)
#pragma unroll
        for (int b = 0; b < 2; ++b)
#pragma unroll
            for (int m = 0; m < 4; ++m)
#pragma unroll
                for (int n = 0; n < 2; ++n) acc[a][b][m][n] = (f32x4){0.f, 0.f, 0.f, 0.f};
    bf16x8 At[4][2], B0[2][2], B1[2][2];
    const char* cA = (const char*)g.A + (size_t)cur.pm * tstepA; const char* cB = (const char*)g.Bt + (size_t)cur.pn * tstepB;
    PG8_STAGE(PG8_SB(0, 0), cB, voffB); PG8_STAGE(PG8_SB(0, 1), cB + hstepB, voffB); PG8_STAGE(PG8_SA(0, 0), cA, voffA); PG8_STAGE(PG8_SA(0, 1), cA + hstepA, voffA);
    if (wr == 1) PG8_BAR;
    WAIT_V(2); PG8_BAR;
    PG8_STAGE(PG8_SB(1, 0), cB + kstep, voffB); PG8_STAGE(PG8_SA(1, 0), cA + kstep, voffA); PG8_STAGE(PG8_SB(1, 1), cB + hstepB + kstep, voffB);
    WAIT_V(6); PG8_BAR;
    for (;;) {
        const bool has_next = S.next(ui + 1, nxt);
        const char* nA = has_next ? (const char*)g.A + (size_t)nxt.pm * tstepA : cA; const char* nB = has_next ? (const char*)g.Bt + (size_t)nxt.pn * tstepB : cB;
        for (int t = 0; t < nt; t += 2) {
            const bool last = (t == nt - 2);
            const char* a1 = cA + (size_t)(t + 1) * kstep;
            const char* a2 = last ? nA : cA + (size_t)(t + 2) * kstep; const char* b2 = last ? nB : cB + (size_t)(t + 2) * kstep;
            const char* a3 = a2 + kstep; const char* b3 = b2 + kstep;
            PG8_LDB(B0, 0, 0); PG8_LDB(B1, 0, 1); SCHED_BAR(); PG8_LDA(At, 0, 0); PG8_STAGE(PG8_SA(1, 1), a1 + hstepA, voffA);
            WAIT_V(8); WAIT_L(0); PG8_BAR; PG8_MMA(0, 0, At, B0); PG8_MMA(0, 1, At, B1); PG8_BAR; SCHED_BAR();
            PG8_LDA(At, 0, 1); PG8_STAGE(PG8_SB(0, 0), b2, voffB); PG8_STAGE(PG8_SB(0, 1), b2 + hstepB, voffB); PG8_STAGE(PG8_SA(0, 0), a2, voffA);
            WAIT_V(8); WAIT_L(0); PG8_BAR; PG8_MMA(1, 0, At, B0); PG8_MMA(1, 1, At, B1); PG8_BAR; SCHED_BAR();
            PG8_LDB(B0, 1, 0); PG8_LDB(B1, 1, 1); SCHED_BAR(); PG8_LDA(At, 1, 0); PG8_STAGE(PG8_SA(0, 1), a2 + hstepA, voffA);
            WAIT_V(8); WAIT_L(0); PG8_BAR; PG8_MMA(0, 0, At, B0); PG8_MMA(0, 1, At, B1); PG8_BAR; SCHED_BAR();
            PG8_LDA(At, 1, 1); PG8_STAGE(PG8_SB(1, 0), b3, voffB); PG8_STAGE(PG8_SB(1, 1), b3 + hstepB, voffB); PG8_STAGE(PG8_SA(1, 0), a3, voffA);
            WAIT_V(8); WAIT_L(0); PG8_BAR; PG8_MMA(1, 0, At, B0); PG8_MMA(1, 1, At, B1); PG8_BAR; SCHED_BAR();
        }
        if (wr == 0) PG8_BAR;
        E(acc, cur, wr, wc, fr, fq);
        if (!has_next) break;
#pragma unroll
        for (int a = 0; a < 2; ++a)
#pragma unroll
            for (int b = 0; b < 2; ++b)
#pragma unroll
                for (int m = 0; m < 4; ++m)
#pragma unroll
                    for (int n = 0; n < 2; ++n) acc[a][b][m][n] = (f32x4){0.f, 0.f, 0.f, 0.f};
        cur = nxt; cA = nA; cB = nB; ++ui;
        if (wr == 1) PG8_BAR;
    }
    WAIT_V(0);
    PG8_BAR;
#undef PG8_SA
#undef PG8_SB
#undef PG8_STAGE
#undef PG8_LDA
#undef PG8_LDB
#undef PG8_MMA
#undef PG8_BAR
}
}
using pg8::Unit;

__device__ __forceinline__ float quad_sum(float s) { s += __shfl_xor(s, 16); s += __shfl_xor(s, 32); return s; }

template <bool GLU> struct EpiRes {
    static constexpr bool PERM = true;
    const float* xin; float* xout; bf16_t* xb; u64* rowss;
    __device__ __forceinline__ void operator()(const f32x4 (&acc)[2][2][4][2], const Unit& u, int wr, int wc, int fr, int fq) const {
#pragma unroll
        for (int ai = 0; ai < 2; ++ai)
#pragma unroll
            for (int m = 0; m < 4; ++m) {
                const int r = u.pm * 256 + ai * 128 + wr * 64 + m * 16 + fr; float ss = 0.f;
                if (GLU) {
                    const size_t off = (size_t)r * D_MODEL + u.pn * 128 + wc * 32 + 8 * fq;
                    f32x4 o[2];
#pragma unroll
                    for (int n = 0; n < 2; ++n) { const f32x4 xo = *(const f32x4*)(xin + off + 4 * n); const f32x4 v = acc[ai][0][m][n], gt = acc[ai][1][m][n];
#pragma unroll
                        for (int i = 0; i < 4; ++i) { const float t = xo[i] + v[i] * sigmoidf_(gt[i]); o[n][i] = t; ss += t * t; }
                        *(f32x4*)(xout + off + 4 * n) = o[n]; }
                    u32x4 w; w.x = pk2(o[0][0], o[0][1]); w.y = pk2(o[0][2], o[0][3]); w.z = pk2(o[1][0], o[1][1]); w.w = pk2(o[1][2], o[1][3]);
                    *(u32x4*)(xb + off) = w;
                } else {
#pragma unroll
                    for (int bj = 0; bj < 2; ++bj) { const size_t off = (size_t)r * D_MODEL + u.pn * 256 + bj * 128 + wc * 32 + 8 * fq; f32x4 o[2];
#pragma unroll
                        for (int n = 0; n < 2; ++n) { const f32x4 xo = *(const f32x4*)(xin + off + 4 * n); const f32x4 v = acc[ai][bj][m][n];
#pragma unroll
                            for (int i = 0; i < 4; ++i) { const float t = xo[i] + v[i]; o[n][i] = t; ss += t * t; }
                            *(f32x4*)(xout + off + 4 * n) = o[n]; }
                        u32x4 w; w.x = pk2(o[0][0], o[0][1]); w.y = pk2(o[0][2], o[0][3]); w.z = pk2(o[1][0], o[1][1]); w.w = pk2(o[1][2], o[1][3]);
                        *(u32x4*)(xb + off) = w; }
                }
                ss = quad_sum(ss);
                if (fq == 0) atomicAdd(rowss + r, (u64)(ss * SS_FIX));
            }
    }
};
struct EpiSwiGLU {
    static constexpr bool PERM = true;
    bf16_t* act; const u64* rowss;
    __device__ __forceinline__ void operator()(const f32x4 (&acc)[2][2][4][2], const Unit& u, int wr, int wc, int fr, int fq) const {
#pragma unroll
        for (int ai = 0; ai < 2; ++ai)
#pragma unroll
            for (int m = 0; m < 4; ++m) {
                const int r = u.pm * 256 + ai * 128 + wr * 64 + m * 16 + fr; const float rs = row_rs(rowss, r);
                float o[8];
#pragma unroll
                for (int n = 0; n < 2; ++n)
#pragma unroll
                    for (int i = 0; i < 4; ++i) { const float gt = rs * acc[ai][0][m][n][i], up = rs * acc[ai][1][m][n][i]; o[4 * n + i] = gt * sigmoidf_(gt) * up; }
                u32x4 w; w.x = pk2(o[0], o[1]); w.y = pk2(o[2], o[3]); w.z = pk2(o[4], o[5]); w.w = pk2(o[6], o[7]);
                *(u32x4*)(act + (size_t)r * D_FF + u.pn * 128 + wc * 32 + 8 * fq) = w;
            }
    }
};
struct EpiInProj {
    static constexpr bool PERM = true;
    bf16_t *Q, *Kb, *V, *QI, *KI; float* WI; const u64* rowss; const float* rope; const float* qg; const float* kg;
    __device__ __forceinline__ void operator()(const f32x4 (&acc)[2][2][4][2], const Unit& u, int wr, int wc, int fr, int fq) const {
        const int pn = u.pn;
#pragma unroll
        for (int ai = 0; ai < 2; ++ai)
#pragma unroll
            for (int m = 0; m < 4; ++m) {
                const int r = u.pm * 256 + ai * 128 + wr * 64 + m * 16 + fr; const float rs = row_rs(rowss, r);
                float t1[8], t2[8];
#pragma unroll
                for (int n = 0; n < 2; ++n)
#pragma unroll
                    for (int i = 0; i < 4; ++i) { t1[4 * n + i] = rs * acc[ai][0][m][n][i]; t2[4 * n + i] = rs * acc[ai][1][m][n][i]; }
                if (pn >= 2 * NH4 && pn < 3 * NH4) {
                    const size_t off = (size_t)r * D_MODEL + (pn - 2 * NH4) * 256 + wc * 32 + 8 * fq;
                    u32x4 w; w.x = pk2(t1[0], t1[1]); w.y = pk2(t1[2], t1[3]); w.z = pk2(t1[4], t1[5]); w.w = pk2(t1[6], t1[7]); *(u32x4*)(V + off) = w;
                    w.x = pk2(t2[0], t2[1]); w.y = pk2(t2[2], t2[3]); w.z = pk2(t2[4], t2[5]); w.w = pk2(t2[6], t2[7]); *(u32x4*)(V + off + 128) = w;
                    continue;
                }
                const bool last = (pn == 3 * NH4 + 2);
                if (last && wc == 1) { if (fq == 0) { const float sc = 0.35355339059327373f * 0.125f;
                        *(f32x4*)(WI + (size_t)r * 8) = (f32x4){t1[0] * sc, t1[1] * sc, t1[2] * sc, t1[3] * sc}; *(f32x4*)(WI + (size_t)r * 8 + 4) = (f32x4){t1[4] * sc, t1[5] * sc, t1[6] * sc, t1[7] * sc}; }
                    continue; }
                if (last && wc != 0) continue;
                const bool isq = pn < NH4, isk = (pn >= NH4 && pn < 2 * NH4);
                if (isq || isk || last) {
                    float ss = 0.f;
#pragma unroll
                    for (int i = 0; i < 8; ++i) ss += t1[i] * t1[i] + t2[i] * t2[i];
                    ss = quad_sum(ss); const float rn = RSQF(ss * (1.0f / 64.0f) + EPS);
                    const float* gn = isq ? qg : kg;
#pragma unroll
                    for (int i = 0; i < 8; ++i) { const float g1 = last ? 1.0f : gn[8 * fq + i], g2 = last ? 1.0f : gn[32 + 8 * fq + i]; t1[i] *= rn * g1; t2[i] *= rn * g2; }
                }
                const float* cs = rope + (size_t)r * 64 + 8 * fq; float o1[8], o2[8]; const float qs = isq ? C2 : 1.0f;
#pragma unroll
                for (int i = 0; i < 8; ++i) { const float c = cs[i], s = cs[32 + i]; o1[i] = (t1[i] * c - t2[i] * s) * qs; o2[i] = (t2[i] * c + t1[i] * s) * qs; }
                bf16_t* dst;
                if (isq) dst = Q + (size_t)r * D_MODEL + (pn * 4 + wc) * 64; else if (isk) dst = Kb + (size_t)r * D_MODEL + ((pn - NH4) * 4 + wc) * 64;
                else if (last) dst = KI + (size_t)r * 64; else dst = QI + (size_t)r * 512 + ((pn - 3 * NH4) * 4 + wc) * 64;
                u32x4 w; w.x = pk2(o1[0], o1[1]); w.y = pk2(o1[2], o1[3]); w.z = pk2(o1[4], o1[5]); w.w = pk2(o1[6], o1[7]); *(u32x4*)(dst + 8 * fq) = w;
                w.x = pk2(o2[0], o2[1]); w.y = pk2(o2[2], o2[3]); w.z = pk2(o2[4], o2[5]); w.w = pk2(o2[6], o2[7]); *(u32x4*)(dst + 32 + 8 * fq) = w;
            }
    }
};
struct EpiS5State {
    static constexpr bool PERM = true;
    float* S;
    __device__ __forceinline__ void operator()(const f32x4 (&acc)[2][2][4][2], const Unit& u, int wr, int wc, int fr, int fq) const {
#pragma unroll
        for (int ai = 0; ai < 2; ++ai)
#pragma unroll
            for (int m = 0; m < 4; ++m) { const size_t row = (size_t)u.pm * 256 + ai * 128 + wr * 64 + m * 16 + fr;
                float* p = S + row * 128 + wc * 32 + 8 * fq; *(f32x4*)p = acc[ai][0][m][0]; *(f32x4*)(p + 4) = acc[ai][0][m][1]; }
    }
};
struct EpiS5Out {
    static constexpr bool PERM = true;
    bf16_t* Y; const bf16_t* UX; const float* dskip;
    __device__ __forceinline__ void operator()(const f32x4 (&acc)[2][2][4][2], const Unit& u, int wr, int wc, int fr, int fq) const {
        PIN1(fr); PIN1(fq);
        const int g = u.pn;
#pragma unroll
        for (int ai = 0; ai < 2; ++ai)
#pragma unroll
            for (int m = 0; m < 4; ++m) { const size_t row = (size_t)u.pm * 256 + ai * 128 + wr * 64 + m * 16 + fr; const int c = (int)(row - (size_t)g * NCH);
#pragma unroll
                for (int bj = 0; bj < 2; ++bj) { const int col = bj * 128 + wc * 32 + 8 * fq, i = col >> 4, ho = col & 15;
                    const u32x4 uw = *(const u32x4*)(UX + row * UXW + col); const float* dk = dskip + 16 * g + ho;
                    float o[8]; const unsigned uu[4] = {uw.x, uw.y, uw.z, uw.w};
#pragma unroll
                    for (int n = 0; n < 2; ++n)
#pragma unroll
                        for (int j = 0; j < 4; ++j) { const int e = 4 * n + j; const float uv = (e & 1) ? bfhi(uu[e >> 1]) : bflo(uu[e >> 1]); o[e] = gelu_tanh(acc[ai][bj][m][n][j] + dk[e] * uv); }
                    u32x4 w; w.x = pk2(o[0], o[1]); w.y = pk2(o[2], o[3]); w.z = pk2(o[4], o[5]); w.w = pk2(o[6], o[7]);
                    *(u32x4*)(Y + (size_t)(16 * c + i) * D_MODEL + 16 * g + ho) = w; }
                asm volatile("" ::: "memory"); }
    }
};

constexpr int RING_BYTES = 131072, LDSCTL_OFF = RING_BYTES, LDS_BYTES = 147456;
struct Args { const float* in[18]; float* out; unsigned char* ws; };
struct Frame {
    LAS unsigned char* lds; int tid, lane, wave, vcu, G;
    const float* in[18]; float* out; unsigned char* ws;
};
__device__ __forceinline__ float wave_sum(float v) {
#pragma unroll
    for (int o = 1; o < 64; o <<= 1) v += __shfl_xor(v, o);
    return v;
}
__device__ __forceinline__ int win_src(int np) {
    const int pn = np >> 8, y = np & 255, bj = y >> 7, hh = (y >> 5) & 3, dd = y & 31;
    if (pn < 2 * NH4) { const int base = pn < NH4 ? 0 : D_MODEL, t = pn < NH4 ? pn : pn - NH4; return base + (4 * t + hh) * 64 + 32 * bj + dd; }
    if (pn < 3 * NH4) return np;
    if (pn < 3 * NH4 + 2) return 3 * D_MODEL + (4 * (pn - 3 * NH4) + hh) * 64 + 32 * bj + dd;
    if (hh == 0) return 3 * D_MODEL + 512 + 32 * bj + dd;
    if (hh == 1 && bj == 0 && dd < 8) return 3 * D_MODEL + 512 + 64 + dd;
    return -1;
}
__device__ __forceinline__ int glu_src(int np, int HW) { const int pn = np >> 8, y = np & 255; return (y >> 7) * HW + pn * 128 + (y & 127); }

template <int MODE> __device__ __forceinline__ void transpose_item(const float* W, int K, int N, int HW, const float* gain, bf16_t* WT, LAS float* scr, int item, int NP, int lane) {
    const int nblk = NP / 32, kb = item / nblk, nb = item % nblk, k0 = 64 * kb, n0 = 32 * nb;
    const int np = n0 + (lane & 31); const int src = MODE == 0 ? np : (MODE == 1 ? glu_src(np, HW) : win_src(np));
#pragma unroll 8
    for (int i = 0; i < 32; ++i) { const int kk = 2 * i + (lane >> 5); float v = 0.f; if (src >= 0) v = W[(size_t)(k0 + kk) * N + src]; if (gain) v *= gain[k0 + kk]; scr[kk * 33 + (lane & 31)] = v; }
    WAIT_L(0);
    const int c = lane & 7;
#pragma unroll
    for (int j = 0; j < 4; ++j) { const int n = (lane >> 3) + 8 * j; const LAS float* s = scr + (8 * c) * 33 + n;
        u32x4 o; o.x = pk2(s[0 * 33], s[1 * 33]); o.y = pk2(s[2 * 33], s[3 * 33]); o.z = pk2(s[4 * 33], s[5 * 33]); o.w = pk2(s[6 * 33], s[7 * 33]);
        *(u32x4*)(WT + (size_t)(n0 + n) * K + k0 + 8 * c) = o; }
    WAIT_L(0);
}

__device__ __forceinline__ void s5_pre(Frame& F0) {
    Frame F = F0; F.tid = opaque(F0.tid); F.lane = F.tid & 63;
    for (int jg = blockIdx.x; jg < N_S5 * S5_GROUPS; jg += F.G) {
        const float* lre = F.in[1] + (size_t)jg * 64; const float* lim = F.in[2] + (size_t)jg * 64; const float* bre = F.in[4] + (size_t)jg * 1024; const float* bim = F.in[5] + (size_t)jg * 1024;
        float* pre = (float*)(F.ws + WS_S5PRE + (size_t)jg * S5PRE_STRIDE);
        const double dt = exp((double)F.in[3][jg]);
        for (int e = F.tid; e < 18 * 64; e += NTHREADS) { const int tau = e >> 6, p = e & 63; const double zr = (double)lre[p] * dt * tau, zi = (double)lim[p] * dt * tau, m = exp(zr);
            pre[e * 2] = (float)(m * cos(zi)); pre[e * 2 + 1] = (float)(m * sin(zi)); }
        for (int e = F.tid; e < 1024; e += NTHREADS) { const int p = e >> 4; const double lr = lre[p], li = lim[p], m = exp(lr * dt), ar = m * cos(li * dt) - 1.0, ai = m * sin(li * dt);
            const double den = lr * lr + li * li, qr = (ar * lr + ai * li) / den, qi = (ai * lr - ar * li) / den;
            const double br = bre[e], bi = bim[e];
            pre[2304 + e * 2] = (float)(qr * br - qi * bi); pre[2304 + e * 2 + 1] = (float)(qr * bi + qi * br); }
        if (F.tid < 64) { const int p = F.tid; const double lr = lre[p], li = lim[p]; const double m1 = exp(lr * dt * 16), m2 = exp(lr * dt * 16 * SEGL);
            f32x4 v; v.x = (float)(m1 * cos(li * dt * 16)); v.y = (float)(m1 * sin(li * dt * 16)); v.z = (float)(m2 * cos(li * dt * 16 * SEGL)); v.w = (float)(m2 * sin(li * dt * 16 * SEGL));
            *(f32x4*)(pre + 4352 + p * 4) = v; }
    }
}
__device__ __forceinline__ void s5_setup(Frame& F0, int j) {
    Frame F = F0; F.tid = opaque(F0.tid); F.lane = F.tid & 63;
    const float* cre = F.in[6] + (size_t)j * S5_GROUPS * 1024; const float* cim = F.in[7] + (size_t)j * S5_GROUPS * 1024;
    bf16_t* AM = (bf16_t*)(F.ws + WS_MIX + MIX_AM); bf16_t* W1 = (bf16_t*)(F.ws + WS_MIX + MIX_W1);
    LAS float* ap = (LAS float*)F.lds;
    LAS float* bb = ap + 18 * 128;
    LAS float* cc = bb + 2048;
    LAS float* kt = cc + 2048;
    for (int g = blockIdx.x; g < S5_GROUPS; g += F.G) {
        __syncthreads();
        const float* pre = (const float*)(F.ws + WS_S5PRE + ((size_t)j * S5_GROUPS + g) * S5PRE_STRIDE);
        for (int e = F.tid; e < 4352; e += NTHREADS) ap[e] = pre[e];
        for (int e = F.tid; e < 1024; e += NTHREADS) { cc[e * 2] = cre[(size_t)g * 1024 + e]; cc[e * 2 + 1] = cim[(size_t)g * 1024 + e]; }
        __syncthreads();
        for (int e = F.tid; e < 4096; e += NTHREADS) { const int tau = e >> 8, ho = (e >> 4) & 15, hi = e & 15; float s = 0.f;
            for (int p = 0; p < 64; ++p) { const float cr = cc[(ho * 64 + p) * 2], ci = cc[(ho * 64 + p) * 2 + 1], ar = ap[(tau * 64 + p) * 2], ai = ap[(tau * 64 + p) * 2 + 1];
                const float xr = cr * ar - ci * ai, xi = cr * ai + ci * ar; s += xr * bb[(p * 16 + hi) * 2] - xi * bb[(p * 16 + hi) * 2 + 1]; }
            kt[e] = s; }
        __syncthreads();
        bf16_t* am = AM + (size_t)g * 256 * UXW;
        for (int e = F.tid; e < 256 * (UXW / 2); e += NTHREADS) { const int np = e / (UXW / 2), k = 2 * (e % (UXW / 2)), i = np >> 4, ho = np & 15; float v0, v1;
            if (k < 256) { const int jj = k >> 4, hi = k & 15; v0 = (jj <= i) ? kt[((i - jj) * 16 + ho) * 16 + hi] : 0.f; v1 = (jj <= i) ? kt[((i - jj) * 16 + ho) * 16 + hi + 1] : 0.f; }
            else { const int p = (k - 256) >> 1; const float cr = cc[(ho * 64 + p) * 2], ci = cc[(ho * 64 + p) * 2 + 1], ar = ap[((i + 1) * 64 + p) * 2], ai = ap[((i + 1) * 64 + p) * 2 + 1];
                v0 = cr * ar - ci * ai; v1 = -(cr * ai + ci * ar); }
            *(unsigned*)(am + (size_t)np * UXW + k) = pk2(v0, v1); }
        bf16_t* w1 = W1 + (size_t)g * 256 * 256;
        for (int e = F.tid; e < 256 * 128; e += NTHREADS) { const int np = e >> 7, k = 2 * (e & 127); float v[2] = {0.f, 0.f};
            if (np < 128) { const int p = np >> 1, comp = np & 1, jj = k >> 4;
#pragma unroll
                for (int t = 0; t < 2; ++t) { const int h = (k & 15) + t; const float ar = ap[((15 - jj) * 64 + p) * 2], ai = ap[((15 - jj) * 64 + p) * 2 + 1], br = bb[(p * 16 + h) * 2], bi = bb[(p * 16 + h) * 2 + 1];
                    v[t] = comp ? (ar * bi + ai * br) : (ar * br - ai * bi); } }
            *(unsigned*)(w1 + (size_t)np * 256 + k) = pk2(v[0], v[1]); }
    }
    __syncthreads();
}

__device__ __forceinline__ void convert_weights(Frame& F0) {
    Frame F = F0; F.tid = opaque(F0.tid); F.lane = F.tid & 63;
    LAS float* scr = (LAS float*)(F.lds + 32768 + F.wave * 8704);
    const int gw = F.vcu * NWAVES + F.wave, NGW = F.G * NWAVES;
    constexpr int I_GLU = (D_MODEL / 64) * (2 * D_MODEL / 32), I_IN = (D_MODEL / 64) * (NIN_PAD / 32), I_O = (D_MODEL / 64) * (D_MODEL / 32), I_GU = (D_MODEL / 64) * (2 * D_FF / 32), I_DN = (D_FF / 64) * (D_MODEL / 32);
    constexpr int NITEMS = N_S5 * I_GLU + N_DSA * (I_IN + I_O) + DEPTH * (I_GU + I_DN);
    for (int it = gw; it < NITEMS; it += NGW) {
        int r = it;
        if (r < N_S5 * I_GLU) { const int j = r / I_GLU; transpose_item<1>(F.in[9] + (size_t)j * D_MODEL * 2 * D_MODEL, D_MODEL, 2 * D_MODEL, D_MODEL, nullptr, (bf16_t*)(F.ws + WS_WGLU + j * SZ_WGLU), scr, r % I_GLU, 2 * D_MODEL, F.lane); continue; } r -= N_S5 * I_GLU;
        if (r < N_DSA * I_IN) { const int j = r / I_IN; transpose_item<2>(F.in[10] + (size_t)j * D_MODEL * DSA_PROJ, D_MODEL, DSA_PROJ, 0, F.in[16] + (size_t)(2 * j + 1) * D_MODEL, (bf16_t*)(F.ws + WS_WIN + j * SZ_WIN), scr, r % I_IN, NIN_PAD, F.lane); continue; } r -= N_DSA * I_IN;
        if (r < N_DSA * I_O) { const int j = r / I_O; transpose_item<0>(F.in[13] + (size_t)j * D_MODEL * D_MODEL, D_MODEL, D_MODEL, 0, nullptr, (bf16_t*)(F.ws + WS_WO + j * SZ_WO), scr, r % I_O, D_MODEL, F.lane); continue; } r -= N_DSA * I_O;
        if (r < DEPTH * I_GU) { const int j = r / I_GU; transpose_item<1>(F.in[14] + (size_t)j * D_MODEL * 2 * D_FF, D_MODEL, 2 * D_FF, D_FF, F.in[17] + (size_t)j * D_MODEL, (bf16_t*)(F.ws + WS_WGU + j * SZ_WGU), scr, r % I_GU, 2 * D_FF, F.lane); continue; } r -= DEPTH * I_GU;
        { const int j = r / I_DN; transpose_item<0>(F.in[15] + (size_t)j * D_FF * D_MODEL, D_FF, D_MODEL, 0, nullptr, (bf16_t*)(F.ws + WS_WDN + j * SZ_WDN), scr, r % I_DN, D_MODEL, F.lane); }
    }
}
__device__ __forceinline__ void prologue_rows(Frame& F0) {
    Frame F = F0; F.tid = opaque(F0.tid); F.lane = F.tid & 63;
    const int gw = F.vcu * NWAVES + F.wave, NGW = F.G * NWAVES;
    u64* rowss0 = (u64*)(F.ws + WS_ROWSS); float* rope = (float*)(F.ws + WS_ROPE); bf16_t* XB = (bf16_t*)(F.ws + WS_XB);
    for (int m = gw; m < SEQ; m += NGW) {
        const float* xr = F.in[0] + (size_t)m * D_MODEL; float s = 0.f;
        for (int c = F.lane * 4; c < D_MODEL; c += 256) { const f32x4 v = *(const f32x4*)(xr + c); s += (v.x * v.x + v.y * v.y) + (v.z * v.z + v.w * v.w);
            u32x2 w; w.x = pk2(v.x, v.y); w.y = pk2(v.z, v.w); *(u32x2*)(XB + (size_t)m * D_MODEL + c) = w; }
        s = wave_sum(s); if (F.lane == 0) rowss0[m] = (u64)(s * SS_FIX);
        if (F.lane < 32) { const float inv = powf(10000.0f, -(float)(2 * F.lane) / 64.0f); const float ang = (float)m * inv; rope[(size_t)m * 64 + F.lane] = (float)cos((double)ang); rope[(size_t)m * 64 + 32 + F.lane] = (float)sin((double)ang); }
    }
}

__device__ __forceinline__ void s5_build_ux(Frame& F0, const float* x, const u64* rowss, const float* gain) {
    Frame F = F0; F.tid = opaque(F0.tid); F.lane = F.tid & 63;
    bf16_t* UX = (bf16_t*)(F.ws + WS_R + R_UX);
    const int gw = F.vcu * NWAVES + F.wave, NGW = F.G * NWAVES; const int j = F.lane >> 2, p = F.lane & 3;
    for (int it = gw; it < NCH * (S5_GROUPS / 4); it += NGW) { const int c = it / (S5_GROUPS / 4), gq = it % (S5_GROUPS / 4), g = 4 * gq + p, t = 16 * c + j;
        const float rs = row_rs(rowss, t); const float* xr = x + (size_t)t * D_MODEL + 16 * g; const float* gn = gain + 16 * g; float v[16];
#pragma unroll
        for (int q = 0; q < 4; ++q) { const f32x4 a = *(const f32x4*)(xr + 4 * q), gg = *(const f32x4*)(gn + 4 * q); v[4 * q] = a.x * rs * gg.x; v[4 * q + 1] = a.y * rs * gg.y; v[4 * q + 2] = a.z * rs * gg.z; v[4 * q + 3] = a.w * rs * gg.w; }
        bf16_t* dst = UX + ((size_t)g * NCH + c) * UXW + 16 * j;
        u32x4 w; w.x = pk2(v[0], v[1]); w.y = pk2(v[2], v[3]); w.z = pk2(v[4], v[5]); w.w = pk2(v[6], v[7]); *(u32x4*)dst = w;
        w.x = pk2(v[8], v[9]); w.y = pk2(v[10], v[11]); w.z = pk2(v[12], v[13]); w.w = pk2(v[14], v[15]); *(u32x4*)(dst + 8) = w; }
}
__device__ __forceinline__ void s5_scan(Frame& F0, int j) {
    Frame F = F0; F.tid = opaque(F0.tid); F.lane = F.tid & 63;
    bf16_t* UX = (bf16_t*)(F.ws + WS_R + R_UX); const float* S = (const float*)(F.ws + WS_R + R_S);
    LAS float* E = (LAS float*)F.lds;
    const int pl = F.tid & 31, seg = F.tid >> 5;
    for (int b = blockIdx.x; b < S5_GROUPS * 2; b += F.G) { const int g = b >> 1, p = (b & 1) * 32 + pl;
        __syncthreads();
        const f32x4 av = *(const f32x4*)((const float*)(F.ws + WS_S5PRE + ((size_t)j * S5_GROUPS + g) * S5PRE_STRIDE) + 4352 + p * 4); const float ar = av.x, ai = av.y, sr = av.z, si = av.w;
        const float* sp = S + ((size_t)g * NCH + (size_t)seg * SEGL) * 128 + 2 * p; float xr = 0.f, xi = 0.f;
        for (int c = 0; c < SEGL; ++c) { const float br = sp[(size_t)c * 128], bi = sp[(size_t)c * 128 + 1]; const float nr = ar * xr - ai * xi + br, ni = ar * xi + ai * xr + bi; xr = nr; xi = ni; }
        E[(seg * 32 + pl) * 2] = xr; E[(seg * 32 + pl) * 2 + 1] = xi;
        __syncthreads();
        xr = 0.f; xi = 0.f;
        for (int s = 0; s < seg; ++s) { const float er = E[(s * 32 + pl) * 2], ei = E[(s * 32 + pl) * 2 + 1]; const float nr = sr * xr - si * xi + er, ni = sr * xi + si * xr + ei; xr = nr; xi = ni; }
        bf16_t* up = UX + ((size_t)g * NCH + (size_t)seg * SEGL) * UXW + 256 + 2 * p;
        for (int c = 0; c < SEGL; ++c) { *(unsigned*)(up + (size_t)c * UXW) = pk2(xr, xi); const float br = sp[(size_t)c * 128], bi = sp[(size_t)c * 128 + 1]; const float nr = ar * xr - ai * xi + br, ni = ar * xi + ai * xr + bi; xr = nr; xi = ni; }
    }
    __syncthreads();
}

__device__ __forceinline__ void idx_scores(f32x16& sc, const LAS unsigned char* qt, const float (&wf)[8], const bf16_t* KI, int k0, int lane) {
    bf16x8 ka[4]; const bf16_t* kp = KI + (size_t)(k0 + (lane & 31)) * 64 + 8 * (lane >> 5);
#pragma unroll
    for (int ks = 0; ks < 4; ++ks) ka[ks] = *(const bf16x8*)(kp + 16 * ks);
#pragma unroll
    for (int r = 0; r < 16; ++r) sc[r] = 0.f;
    const int ql = lane & 31, hi = lane >> 5; const LAS unsigned char* qrow = qt + ql * 1024;
#pragma unroll
    for (int h = 0; h < 8; ++h) { f32x16 d;
#pragma unroll
        for (int r = 0; r < 16; ++r) d[r] = 0.f;
#pragma unroll
        for (int ks = 0; ks < 4; ++ks) { const bf16x8 qf = *(const LAS bf16x8*)(qrow + (((8 * h + 2 * ks + hi) ^ (ql & 15)) * 16)); d = MFMA32(ka[ks], qf, d); }
#pragma unroll
        for (int r = 0; r < 16; ++r) sc[r] += fmaxf(d[r], 0.f) * wf[h];
        PIN16(sc); }
}
__device__ __forceinline__ int score_bin(float s) { float t = (s - BIN_LO) * BIN_SCALE;   t = fminf(fmaxf(t, 0.f), (float)(NBINS - 1)); return (int)t; }

template <int PASS> __device__ __forceinline__ void idx_pass(Frame& F0, int un, LAS unsigned* hist, LAS int* qinfo) {
    Frame F = F0; F.tid = opaque(F0.tid); F.lane = F.tid & 63;
    const bf16_t* KI = (const bf16_t*)(F.ws + WS_MIX + MIX_KI); const float* WI = (const float*)(F.ws + WS_MIX + MIX_WI);
    const int lane = F.lane, ql = lane & 31, hi = lane >> 5, q = 32 * un + ql, ntiles = un + 1;
    float wf[8];
#pragma unroll
    for (int h = 0; h < 8; ++h) wf[h] = WI[(size_t)q * 8 + h];
    const LAS unsigned char* qt = F.lds + 65536;
    const int bstar = PASS == 2 ? qinfo[ql * 4] : 0; const float inv = __builtin_bit_cast(float, qinfo[ql * 4 + 3]);
    LAS unsigned* cand = (LAS unsigned*)(F.lds + 98304) + (ql * 16 + F.wave * 2 + hi) * 16; int mycnt = 0;
    for (int kt = F.wave; kt < ntiles; kt += NWAVES) { f32x16 sc; idx_scores(sc, qt, wf, KI, 32 * kt, lane);
        const bool diag = (kt == ntiles - 1);
        if (PASS == 1) {
#pragma unroll
            for (int r = 0; r < 16; ++r) { const int key = 32 * kt + crow(r, hi); if (!diag || key <= q) { const int b = score_bin(sc[r] * inv); LDS_ATOMIC_ADD(hist + ql * (NBINS / 2) + (b >> 1), 1u << (16 * (b & 1))); } }
        } else {
            unsigned m = 0, cm = 0;
#pragma unroll
            for (int r = 0; r < 16; ++r) { const int key = 32 * kt + crow(r, hi); const bool valid = (!diag || key <= q); const int b = score_bin(sc[r] * inv);
                m = (m << 1) | ((valid && b > bstar) ? 1u : 0u); cm = (cm << 1) | ((valid && b == bstar) ? 1u : 0u); }
            ((LAS unsigned short*)hist)[(kt * 32 + ql) * 2 + hi] = (unsigned short)m;
            while (cm) { const int bit = 31 - __builtin_clz(cm); cm &= ~(1u << bit); const int r = 15 - bit; const int key = 32 * kt + crow(r, hi);
                if (mycnt < 16) cand[mycnt] = (unsigned)key; ++mycnt; }
        }
    }
    if (PASS == 2) ((LAS int*)(F.lds + RING_BYTES + 2048))[ql * 16 + F.wave * 2 + hi] = mycnt < 16 ? mycnt : 16;
}
__device__ __forceinline__ void indexer_unit(Frame& F0, int un) {
    Frame F = F0; F.tid = opaque(F0.tid); F.lane = F.tid & 63;
    const bf16_t* QI = (const bf16_t*)(F.ws + WS_MIX + MIX_QI); const bf16_t* KI = (const bf16_t*)(F.ws + WS_MIX + MIX_KI); const float* WI = (const float*)(F.ws + WS_MIX + MIX_WI);
    unsigned* M32 = (unsigned*)(F.ws + WS_XB);
    LAS unsigned* hist = (LAS unsigned*)F.lds; LAS int* qinfo = (LAS int*)(F.lds + RING_BYTES); LAS int* ccnt = (LAS int*)(F.lds + RING_BYTES + 2048);
    LAS float* nrm = (LAS float*)(F.lds + 98304);
    const int lane = F.lane, q0 = 32 * un;
    __syncthreads();
    { const unsigned zz = (unsigned)opaque(0); const u32x4 z4 = (u32x4){zz, zz, zz, zz};
      for (int e = F.tid; e < 32 * NBINS / 2 / 4; e += NTHREADS) ((LAS u32x4*)hist)[e] = z4; }
    if (F.tid < 128) qinfo[F.tid] = 0;
    for (int e = F.tid; e < 32 * 64; e += NTHREADS) { const int row = e >> 6, c = e & 63;
        *(LAS u32x4*)(F.lds + 65536 + row * 1024 + ((c ^ (row & 15)) * 16)) = *(const u32x4*)(QI + (size_t)(q0 + row) * 512 + 8 * c); }
    if (F.tid < 256) { const int row = F.tid & 31, h = F.tid >> 5; const bf16_t* qr = QI + (size_t)(q0 + row) * 512 + h * 64; float ss = 0.f;
        for (int e = 0; e < 64; e += 8) { const u32x4 a = *(const u32x4*)(qr + e); ss += bflo(a.x) * bflo(a.x) + bfhi(a.x) * bfhi(a.x) + bflo(a.y) * bflo(a.y) + bfhi(a.y) * bfhi(a.y) + bflo(a.z) * bflo(a.z) + bfhi(a.z) * bfhi(a.z) + bflo(a.w) * bflo(a.w) + bfhi(a.w) * bfhi(a.w); }
        const float w = WI[(size_t)(q0 + row) * 8 + h]; nrm[row * 8 + h] = w * w * ss; }
    __syncthreads();
    if (F.tid < 32) { float a = 0.f;
#pragma unroll
        for (int h = 0; h < 8; ++h) a += nrm[F.tid * 8 + h];
        const float inv = a > 1e-30f ? RSQF(0.5f * a) : 1.0f; qinfo[F.tid * 4 + 3] = __builtin_bit_cast(int, inv); }
    __syncthreads();
    idx_pass<1>(F, un, hist, qinfo);
    __syncthreads();
    for (int i = 0; i < 4; ++i) { const int qq = 4 * F.wave + i; const int n = q0 + qq + 1;
        unsigned cnt[16]; unsigned tot = 0;
#pragma unroll
        for (int e = 0; e < 2; ++e) { const u32x4 w = ((const LAS u32x4*)(hist + qq * (NBINS / 2) + lane * 8))[e]; const unsigned ww[4] = {w.x, w.y, w.z, w.w};
#pragma unroll
            for (int t = 0; t < 4; ++t) { cnt[8 * e + 2 * t] = ww[t] & 0xffffu; cnt[8 * e + 2 * t + 1] = ww[t] >> 16; tot += (ww[t] & 0xffffu) + (ww[t] >> 16); } }
        unsigned v = tot;
#pragma unroll
        for (int o = 1; o < 64; o <<= 1) { const unsigned t = __shfl(v, (lane + o) & 63); if (lane + o < 64) v += t; }
        const unsigned above = v - tot;
        if (n > TOPK) { const bool mine = (above < (unsigned)TOPK) && (above + tot >= (unsigned)TOPK);
            if (mine) { unsigned a = above, abest = above; int bb = 15; bool found = false;
#pragma unroll
                for (int t = 15; t >= 0; --t) { const bool hit = !found && (a + cnt[t] >= (unsigned)TOPK); if (hit) { bb = t; abest = a; found = true; } a += cnt[t]; }
                qinfo[qq * 4] = lane * 16 + bb; qinfo[qq * 4 + 1] = TOPK - (int)abest; }
        } else if (lane == 0) { qinfo[qq * 4] = opaque(-1); qinfo[qq * 4 + 1] = opaque(0); }
    }
    __syncthreads();
    idx_pass<2>(F, un, hist, qinfo);
    __syncthreads();
    LAS unsigned* cand = (LAS unsigned*)(F.lds + 98304); LAS float* csc = (LAS float*)(F.lds + 65536);
    for (int i = 0; i < 4; ++i) { const int qq = 4 * F.wave + i, qa = q0 + qq; const int rneed = qinfo[qq * 4 + 1];
        if (rneed <= 0) continue;
        bool vld[4];
#pragma unroll
        for (int k = 0; k < 4; ++k) { const int sl = lane + 64 * k; vld[k] = (sl & 15) < ccnt[qq * 16 + (sl >> 4)];
            if (vld[k]) { const int key = (int)cand[qq * 256 + sl]; float s = 0.f; const bf16_t* kr = KI + (size_t)key * 64; const bf16_t* qr = QI + (size_t)qa * 512;
                for (int h = 0; h < 8; ++h) { float d = 0.f;
                    for (int e = 0; e < 64; e += 8) { const u32x4 a = *(const u32x4*)(qr + h * 64 + e), b = *(const u32x4*)(kr + e);
                        d += bflo(a.x) * bflo(b.x) + bfhi(a.x) * bfhi(b.x) + bflo(a.y) * bflo(b.y) + bfhi(a.y) * bfhi(b.y) + bflo(a.z) * bflo(b.z) + bfhi(a.z) * bfhi(b.z) + bflo(a.w) * bflo(b.w) + bfhi(a.w) * bfhi(b.w); }
                    s += fmaxf(d, 0.f) * WI[(size_t)qa * 8 + h]; }
                csc[qq * 256 + sl] = s; } }
        WAIT_L(0);
#pragma unroll
        for (int k = 0; k < 4; ++k) { const int sl = lane + 64 * k;
            if (vld[k]) { const float s = csc[qq * 256 + sl]; const unsigned key = cand[qq * 256 + sl]; int rank = 0;
                for (int sb = 0; sb < 16; ++sb) { const int c2 = ccnt[qq * 16 + sb];
                    for (int p2 = 0; p2 < c2; ++p2) { const float so = csc[qq * 256 + sb * 16 + p2]; const unsigned ko = cand[qq * 256 + sb * 16 + p2]; rank += (so > s || (so == s && ko < key)) ? 1 : 0; } }
                if (rank < rneed) { const int kk = key & 31, h2 = (kk >> 2) & 1, r = (kk & 3) + 4 * (kk >> 3); LDS_ATOMIC_OR(hist + (key >> 5) * 32 + qq, 1u << (16 * h2 + 15 - r)); } } }
    }
    __syncthreads();
    for (int e = F.tid; e < (un + 1) * 32; e += NTHREADS) M32[(size_t)(e >> 5) * SEQ + q0 + (e & 31)] = hist[e];
}
__device__ __forceinline__ void indexer_phase(Frame& F) {
    constexpr int NU = SEQ / 32;
    for (int p = F.vcu; p < NU / 2; p += F.G) { indexer_unit(F, p); indexer_unit(F, NU - 1 - p); }
    __syncthreads();
}

__device__ __forceinline__ void attn_unit(Frame& F0, int head, int qb, float moff) {
    Frame F = F0; F.tid = opaque(F0.tid); F.lane = F.tid & 63;
    bf16_t* Q = (bf16_t*)(F.ws + WS_R + R_Q); const bf16_t* Kb = (const bf16_t*)(F.ws + WS_R + R_K); const bf16_t* Vb = (const bf16_t*)(F.ws + WS_R + R_V);
    const unsigned short* M16 = (const unsigned short*)(F.ws + WS_XB);
    LAS unsigned char* Kl = F.lds; LAS unsigned char* Vl = F.lds + 8192; LAS float* lsc = (LAS float*)(F.lds + 16384) + F.wave * 32;
    const int lane = F.lane, ql = lane & 31, hi = lane >> 5, q0 = qb * 256, q = q0 + 32 * F.wave + ql, NT = 4 * (qb + 1);
    bf16x8 qf[4];
#pragma unroll
    for (int ks = 0; ks < 4; ++ks) qf[ks] = *(const bf16x8*)(Q + (size_t)q * D_MODEL + head * 64 + 16 * ks + 8 * hi);
    f32x16 o0, o1;
#pragma unroll
    for (int r = 0; r < 16; ++r) { o0[r] = 0.f; o1[r] = 0.f; }
    float lsum = 0.f;
    const int srow = F.tid >> 3, sch = F.tid & 7;
    const bf16_t* kg = Kb + (size_t)srow * D_MODEL + head * 64 + 8 * sch; const bf16_t* vg = Vb + (size_t)srow * D_MODEL + head * 64 + 8 * sch;
    u32x4 kreg = *(const u32x4*)kg, vreg = *(const u32x4*)vg;
    const int kst = srow * 128 + ((sch ^ (srow & 7)) * 16), vst = srow * 128 + sch * 16;
    for (int t = 0; t < NT; ++t) {
        __syncthreads();
        *(LAS u32x4*)(Kl + kst) = kreg; *(LAS u32x4*)(Vl + vst) = vreg;
        const int qt = (q0 >> 5) + F.wave;
        const unsigned mw0 = (2 * t <= qt) ? (unsigned)M16[((size_t)(2 * t) * SEQ + q) * 2 + hi] : 0u, mw1 = (2 * t + 1 <= qt) ? (unsigned)M16[((size_t)(2 * t + 1) * SEQ + q) * 2 + hi] : 0u;
        if (t + 1 < NT) { kreg = *(const u32x4*)(kg + (size_t)(t + 1) * 64 * D_MODEL); vreg = *(const u32x4*)(vg + (size_t)(t + 1) * 64 * D_MODEL); }
        __syncthreads();
        f32x16 p0, p1;
#pragma unroll
        for (int r = 0; r < 16; ++r) { p0[r] = -moff; p1[r] = -moff; }
#pragma unroll
        for (int ks = 0; ks < 4; ++ks) { const int ch = 2 * ks + hi;
            const bf16x8 a0 = *(const LAS bf16x8*)(Kl + ql * 128 + ((ch ^ (ql & 7)) * 16)), a1 = *(const LAS bf16x8*)(Kl + (32 + ql) * 128 + ((ch ^ (ql & 7)) * 16));
            p0 = MFMA32(a0, qf[ks], p0); p1 = MFMA32(a1, qf[ks], p1); }
        float ps = 0.f;
#pragma unroll
        for (int r = 0; r < 16; ++r) { const float e0 = ((mw0 >> (15 - r)) & 1u) ? EXP2F(p0[r]) : 0.f, e1 = ((mw1 >> (15 - r)) & 1u) ? EXP2F(p1[r]) : 0.f; p0[r] = e0; p1[r] = e1; ps += e0 + e1; }
        lsum += ps;
        bf16x8 pa[4];
#pragma unroll
        for (int s = 0; s < 2; ++s) { u32x4 w0, w1;
            w0.x = pk2(p0[8 * s], p0[8 * s + 1]); w0.y = pk2(p0[8 * s + 2], p0[8 * s + 3]); w0.z = pk2(p0[8 * s + 4], p0[8 * s + 5]); w0.w = pk2(p0[8 * s + 6], p0[8 * s + 7]);
            w1.x = pk2(p1[8 * s], p1[8 * s + 1]); w1.y = pk2(p1[8 * s + 2], p1[8 * s + 3]); w1.z = pk2(p1[8 * s + 4], p1[8 * s + 5]); w1.w = pk2(p1[8 * s + 6], p1[8 * s + 7]);
            pa[s] = __builtin_bit_cast(bf16x8, w0); pa[2 + s] = __builtin_bit_cast(bf16x8, w1); }
        const int trow = 4 * hi + ((lane & 15) >> 2), tcol = 16 * ((lane >> 4) & 1) + 4 * (lane & 3);
#pragma unroll
        for (int s = 0; s < 4; ++s) {
#pragma unroll
            for (int d0 = 0; d0 < 2; ++d0) { const LAS unsigned char* vp = Vl + (16 * s + trow) * 128 + (32 * d0 + tcol) * 2;
                const s16x4 lo = DS_TR16(vp), hh = DS_TR16(vp + 8 * 128);
                const bf16x8 vf = (bf16x8){lo[0], lo[1], lo[2], lo[3], hh[0], hh[1], hh[2], hh[3]};
                if (d0 == 0) o0 = MFMA32(pa[s], vf, o0); else o1 = MFMA32(pa[s], vf, o1); } }
    }
    lsum += __shfl_xor(lsum, 32);
    __syncthreads();
    if (hi == 0) lsc[ql] = lsum;
    __syncthreads();
    bf16_t* Ow = Q + (size_t)(q0 + 32 * F.wave) * D_MODEL + head * 64;
#pragma unroll
    for (int r = 0; r < 16; ++r) { const int row = crow(r, hi); const float rl = RCPF(lsc[row]);
        Ow[(size_t)row * D_MODEL + ql] = (bf16_t)f2bf(o0[r] * rl); Ow[(size_t)row * D_MODEL + 32 + ql] = (bf16_t)f2bf(o1[r] * rl); }
}
__device__ __forceinline__ void attn_phase(Frame& F, const float* qg, const float* kg) {
    float mq = 0.f, mk = 0.f;
    for (int i = 0; i < 64; ++i) { mq = fmaxf(mq, fabsf(qg[i])); mk = fmaxf(mk, fabsf(kg[i])); }
    const float moff = mq * mk * 64.0f * C2 * 1.02f;
    constexpr int NQB = SEQ / 256, NP = N_HEADS * (NQB / 2);
    for (int p = F.vcu; p < NP; p += F.G) { const int head = p / (NQB / 2), s = p % (NQB / 2); attn_unit(F, head, s, moff); attn_unit(F, head, NQB - 1 - s, moff); }
    __syncthreads();
}

#ifdef EMU
#define CG_SYNC() emu::grid_barrier()
#define LDS_DECL(name) unsigned char* name = emu::lds_ptr()
#else
namespace cg = cooperative_groups;
#define CG_SYNC() cg::this_grid().sync()
#define LDS_DECL(name) extern __shared__ __attribute__((aligned(16))) unsigned char name[]
#endif

#ifdef EMU
static int g_emu_max_layers = DEPTH;
#define MAX_LAYERS g_emu_max_layers
static int g_emu_stop = 0;
#define EMU_STOP(k) do { if (g_emu_stop == (k)) return; } while (0)
#else
#define MAX_LAYERS DEPTH
#define EMU_SNAPSHOT() do {} while (0)
#define EMU_STOP(k) do {} while (0)
#endif
__global__ void __launch_bounds__(NTHREADS, 2) mega_fwd(Args args) {
    LDS_DECL(lds_raw);
    Frame F;
    F.lds = (LAS unsigned char*)lds_raw; F.tid = threadIdx.x; F.lane = F.tid & 63; F.wave = RFL(F.tid >> 6);
    F.G = gridDim.x; { const int bx = blockIdx.x; F.vcu = (F.G % 8 == 0) ? (bx % 8) * (F.G / 8) + bx / 8 : bx; }
#pragma unroll
    for (int i = 0; i < 18; ++i) F.in[i] = args.in[i];
    F.out = args.out; F.ws = args.ws;
    volatile LAS unsigned* MISC = (volatile LAS unsigned*)(F.lds + LDSCTL_OFF + 1024);
    if (F.tid < 64) MISC[F.tid] = 0u;
    __syncthreads();
    XcdBarrier bar = xcd_barrier_post((unsigned*)(F.ws + WS_CTL) + 4096, MISC + 8);
#define GRID_BAR() xcd_barrier(bar)
    u64* rowss = (u64*)(F.ws + WS_ROWSS); bf16_t* XB = (bf16_t*)(F.ws + WS_XB);
    LAS unsigned char* ring = F.lds;

#ifndef KN
#define KN 0xffff
#endif
    if (KN & 1) { s5_pre(F);
    convert_weights(F);
    prologue_rows(F); }
    EMU_STOP(1);
    CG_SYNC();
    if (KN & 1) s5_setup(F, 0);
    GRID_BAR();

    for (int layer = 0; layer < MAX_LAYERS; ++layer) {
        const int j = layer >> 1;
        const float* xin = layer == 0 ? F.in[0] : F.out;
        u64* rs_mix = rowss + (size_t)(2 * layer) * SEQ; u64* rs_ffn = rowss + (size_t)(2 * layer + 1) * SEQ; u64* rs_next = rowss + (size_t)(2 * layer + 2) * SEQ;
        if ((layer & 1) == 0) {
            if (KN & 2) s5_build_ux(F, xin, rs_mix, F.in[16] + (size_t)layer * D_MODEL);
            GRID_BAR(); EMU_STOP(2);
            if (KN & 4) { pg8::Gemm g{(const bf16_t*)(F.ws + WS_R + R_UX), (const bf16_t*)(F.ws + WS_MIX + MIX_W1), UXW, 256, 256}; pg8::GroupOrder S{F.G, (int)blockIdx.x};
              EpiS5State E{(float*)(F.ws + WS_R + R_S)}; pg8::gemm_phase(ring, g, S, E); }
            GRID_BAR(); EMU_STOP(3);
            if (KN & 8) s5_scan(F, j);
            GRID_BAR(); EMU_STOP(4);
            if (KN & 16) { pg8::Gemm g{(const bf16_t*)(F.ws + WS_R + R_UX), (const bf16_t*)(F.ws + WS_MIX + MIX_AM), UXW, UXW, UXW}; pg8::GroupOrder S{F.G, (int)blockIdx.x};
              EpiS5Out E{(bf16_t*)(F.ws + WS_R + R_Y), (const bf16_t*)(F.ws + WS_R + R_UX), F.in[8] + (size_t)j * D_MODEL}; pg8::gemm_phase(ring, g, S, E); }
            GRID_BAR(); EMU_STOP(5);
            if (KN & 32) { pg8::Gemm g{(const bf16_t*)(F.ws + WS_R + R_Y), (const bf16_t*)(F.ws + WS_WGLU + j * SZ_WGLU), D_MODEL, D_MODEL, D_MODEL}; pg8::StaticOrder S; S.init(SEQ, 2 * D_MODEL, F.G, (int)blockIdx.x);
              EpiRes<true> E{xin, F.out, XB, rs_ffn}; pg8::gemm_phase(ring, g, S, E); }
            GRID_BAR();
        } else {
            if (KN & 64) { pg8::Gemm g{XB, (const bf16_t*)(F.ws + WS_WIN + j * SZ_WIN), D_MODEL, D_MODEL, D_MODEL}; pg8::StaticOrder S; S.init(SEQ, NIN_PAD, F.G, (int)blockIdx.x);
              EpiInProj E{(bf16_t*)(F.ws + WS_R + R_Q), (bf16_t*)(F.ws + WS_R + R_K), (bf16_t*)(F.ws + WS_R + R_V), (bf16_t*)(F.ws + WS_MIX + MIX_QI), (bf16_t*)(F.ws + WS_MIX + MIX_KI), (float*)(F.ws + WS_MIX + MIX_WI),
                          rs_mix, (const float*)(F.ws + WS_ROPE), F.in[11] + (size_t)j * 64, F.in[12] + (size_t)j * 64};
              pg8::gemm_phase(ring, g, S, E); }
            GRID_BAR(); EMU_STOP(7);
            if (KN & 128) indexer_phase(F);
            GRID_BAR(); EMU_STOP(8);
            if (KN & 256) attn_phase(F, F.in[11] + (size_t)j * 64, F.in[12] + (size_t)j * 64);
            GRID_BAR(); EMU_STOP(9);
            if (KN & 512) { pg8::Gemm g{(const bf16_t*)(F.ws + WS_R + R_Q), (const bf16_t*)(F.ws + WS_WO + j * SZ_WO), D_MODEL, D_MODEL, D_MODEL}; pg8::StaticOrder S; S.init(SEQ, D_MODEL, F.G, (int)blockIdx.x);
              EpiRes<false> E{xin, F.out, XB, rs_ffn}; pg8::gemm_phase(ring, g, S, E); }
            GRID_BAR();
        }
        EMU_SNAPSHOT();
        if ((KN & 1) && layer + 1 < DEPTH && ((layer + 1) & 1) == 0) s5_setup(F, (layer + 1) >> 1);
        if (KN & 1024) { pg8::Gemm g{XB, (const bf16_t*)(F.ws + WS_WGU + layer * SZ_WGU), D_MODEL, D_MODEL, D_MODEL}; pg8::StaticOrder S; S.init(SEQ, 2 * D_FF, F.G, (int)blockIdx.x);
          EpiSwiGLU E{(bf16_t*)(F.ws + WS_R + R_ACT), rs_ffn}; pg8::gemm_phase(ring, g, S, E); }
        GRID_BAR();
        if (KN & 2048) { pg8::Gemm g{(const bf16_t*)(F.ws + WS_R + R_ACT), (const bf16_t*)(F.ws + WS_WDN + layer * SZ_WDN), D_FF, D_FF, D_FF}; pg8::StaticOrder S; S.init(SEQ, D_MODEL, F.G, (int)blockIdx.x);
          EpiRes<false> E{F.out, F.out, XB, rs_next}; pg8::gemm_phase(ring, g, S, E); }
        if (layer + 1 < DEPTH) GRID_BAR();
#ifdef EMU
        else GRID_BAR();
        EMU_SNAPSHOT();
#endif
    }
}

#ifndef EMU
extern "C" void kernel_launch(void* const* d_in, const int* in_sizes, int n_in, void* d_out, int out_size, void* d_ws, size_t ws_size, hipStream_t stream) {
    static int grid = 0;
    if (grid == 0) {
        if (n_in != 18 || out_size != SEQ * D_MODEL || ws_size < WS_END) { fprintf(stderr, "kernel_launch: unexpected shapes (n_in %d out %d ws %zu need %zu)\n", n_in, out_size, ws_size, (size_t)WS_END); grid = -1; return; }
        int dev = 0, cus = 0, per_cu = 0;
        hipGetDevice(&dev); hipDeviceGetAttribute(&cus, hipDeviceAttributeMultiprocessorCount, dev);
        hipFuncSetAttribute((const void*)mega_fwd, hipFuncAttributeMaxDynamicSharedMemorySize, LDS_BYTES);
        hipOccupancyMaxActiveBlocksPerMultiprocessor(&per_cu, (const void*)mega_fwd, NTHREADS, LDS_BYTES);
        if (per_cu < 1) { fprintf(stderr, "kernel_launch: occupancy query says %d blocks/CU\n", per_cu); grid = -1; return; }
        grid = cus;
        (void)hipGetLastError();
    }
    if (grid < 0) return;
    hipMemsetAsync((char*)d_ws + WS_CTL, 0, CTL_BYTES, stream);
    Args a{};
    for (int i = 0; i < 18; ++i) a.in[i] = (const float*)d_in[i];
    a.out = (float*)d_out; a.ws = (unsigned char*)d_ws;
    void* params[] = {&a};
    hipError_t e = hipLaunchCooperativeKernel((const void*)mega_fwd, dim3(grid), dim3(NTHREADS), params, LDS_BYTES, stream);
    if (e != hipSuccess) fprintf(stderr, "cooperative launch failed: %s (grid %d)\n", hipGetErrorString(e), grid);
}
#endif
```

```cpp
#ifndef EMU
#include <hip/hip_runtime.h>
#include <hip/hip_cooperative_groups.h>
#include <cstdio>
#include <cstdint>
#include <cmath>
#endif

#ifdef CFG_SMALL
constexpr int D_MODEL = 256, SEQ = 4096, DEPTH = 2, N_HEADS = 4;
#else
constexpr int D_MODEL = 1024, SEQ = 16384, DEPTH = 4, N_HEADS = 16;
#endif
constexpr int S5_GROUPS = D_MODEL / 16, S5_STATE = 64, HEAD_DIM = 64, IDX_HEADS = 8, TOPK = 256;
constexpr int D_FF = ((8 * D_MODEL / 3 + 255) / 256) * 256;
constexpr int N_S5 = (DEPTH + 1) / 2, N_DSA = DEPTH / 2;
constexpr int DSA_PROJ = 3 * D_MODEL + 512 + 64 + 8;
constexpr int NH4 = D_MODEL / 256;
constexpr int NIN_TILES = 3 * NH4 + 3, NIN_PAD = NIN_TILES * 256;
constexpr int NCH = SEQ / 16, NCHT = NCH / 256;
constexpr int UXW = 384;
constexpr int NSEG = 16, SEGL = NCH / NSEG;
constexpr float EPS = 1e-6f;
constexpr float C2 = 0.125f * 1.4426950408889634f;
constexpr int NWAVES = 8, NTHREADS = 512;
constexpr int NBINS = 1024; constexpr float BIN_LO = -8.f, BIN_SCALE = 64.f;
constexpr int CAND_CAP = 256;

constexpr size_t MiB = 1u << 20;
constexpr size_t WS_CTL = 0, CTL_BYTES = 3 * MiB;
constexpr size_t WS_ROWSS = 1 * MiB;
constexpr size_t SZ_WGLU = (size_t)2 * D_MODEL * D_MODEL * 2, SZ_WIN = (size_t)NIN_PAD * D_MODEL * 2, SZ_WO = (size_t)D_MODEL * D_MODEL * 2,
                 SZ_WGU = (size_t)2 * D_FF * D_MODEL * 2, SZ_WDN = (size_t)D_MODEL * D_FF * 2;
constexpr size_t WS_WGLU = CTL_BYTES, WS_WIN = WS_WGLU + N_S5 * SZ_WGLU, WS_WO = WS_WIN + N_DSA * SZ_WIN, WS_WGU = WS_WO + N_DSA * SZ_WO,
                 WS_WDN = WS_WGU + DEPTH * SZ_WGU, WS_ROPE = WS_WDN + DEPTH * SZ_WDN;
constexpr size_t SZ_ROPE = (size_t)SEQ * 64 * 4;
constexpr size_t S5PRE_STRIDE = 18432;
constexpr size_t WS_S5PRE = WS_ROPE + SZ_ROPE, SZ_S5PRE = (size_t)N_S5 * S5_GROUPS * S5PRE_STRIDE;
constexpr size_t WS_MIX = WS_S5PRE + SZ_S5PRE;
constexpr size_t SZ_AM = (size_t)S5_GROUPS * 256 * UXW * 2, SZ_W1 = (size_t)S5_GROUPS * 256 * 256 * 2, SZ_APOW = (size_t)S5_GROUPS * 64 * 16;
constexpr size_t MIX_AM = 0, MIX_W1 = MIX_AM + SZ_AM;
constexpr size_t MIX_QI = 0, SZ_QI = (size_t)SEQ * 512 * 2, MIX_KI = MIX_QI + SZ_QI, SZ_KI = (size_t)SEQ * 64 * 2, MIX_WI = MIX_KI + SZ_KI, SZ_WI = (size_t)SEQ * 8 * 4;
constexpr size_t SZ_S5TAB = MIX_W1 + SZ_W1, SZ_MIX_DSA = MIX_WI + SZ_WI;
constexpr size_t SZ_MIX = (SZ_MIX_DSA + 4095) / 4096 * 4096;
constexpr size_t WS_XB = WS_MIX + SZ_MIX, SZ_XB = (size_t)SEQ * D_MODEL * 2;
constexpr size_t SZ_MASK = (size_t)(SEQ / 32) * SEQ * 4;
constexpr size_t SZ_XBM = SZ_XB > SZ_MASK ? SZ_XB : SZ_MASK;
constexpr size_t WS_R = WS_XB + SZ_XBM;
constexpr size_t R_Q = 0, R_K = SZ_XB, R_V = 2 * SZ_XB;
constexpr size_t R_ACT = 0, SZ_ACT = (size_t)SEQ * D_FF * 2;
constexpr size_t R_UX = 0, SZ_UX = (size_t)S5_GROUPS * NCH * UXW * 2, R_S = ((SZ_UX + 4095) / 4096) * 4096, SZ_S = (size_t)S5_GROUPS * NCH * 128 * 4, R_Y = R_S;
constexpr size_t SZ_R0 = 3 * SZ_XB > SZ_ACT ? 3 * SZ_XB : SZ_ACT, SZ_R1 = R_S + SZ_S, SZ_R = SZ_R0 > SZ_R1 ? SZ_R0 : SZ_R1;
constexpr size_t WS_S5TAB = ((WS_R + SZ_R + 4095) / 4096) * 4096;
constexpr size_t WS_END = WS_S5TAB + N_S5 * SZ_S5TAB;
static_assert(SZ_S >= (size_t)SEQ * D_MODEL * 2, "Y fits over S");
static_assert(SEQ <= 16384, "candidate packing holds 14-bit keys");
static_assert((2 * DEPTH + 1) * (size_t)SEQ * 8 <= 2 * MiB, "rowss arrays fit");
typedef unsigned long long u64;
constexpr float SS_FIX = 1048576.0f, SS_INV = 1.0f / 1048576.0f;

typedef unsigned short bf16_t;
typedef short bf16x8 __attribute__((ext_vector_type(8)));
typedef float f32x4 __attribute__((ext_vector_type(4)));
typedef float f32x16 __attribute__((ext_vector_type(16)));
typedef unsigned u32x4 __attribute__((ext_vector_type(4)));
typedef unsigned u32x2 __attribute__((ext_vector_type(2)));
typedef short s16x4 __attribute__((ext_vector_type(4)));
typedef float f32x2 __attribute__((ext_vector_type(2)));

#ifdef EMU
#define LAS
#define GAS
#define MFMA16(a, b, c) emu_mfma16(a, b, c)
#define MFMA32(a, b, c) emu_mfma32(a, b, c)
#define WAIT_V(n)
#define WAIT_L(n) emu::wave_barrier()
#define WAIT_VM0() do {} while (0)
#define S_BARRIER() emu::block_barrier()
#define SCHED_BAR()
#define PIN16(x)
#define PIN1(x)
#define PINS(x)
#define PIN2(x)
#define SETPRIO(x)
#define RFL(x) (x)
#define LANE_ID() ((int)(threadIdx.x & 63))
#define GLDS16(g, l) emu_glds16((const void*)(g), (void*)(l))
#define DS_TR16(p) emu_ds_read_tr16((const void*)(p))
#define EXP2F(x) exp2f(x)
#define RCPF(x) (1.0f / (x))
#define RSQF(x) (1.0f / sqrtf(x))
#define LDS_ATOMIC_ADD(p, v) atomicAdd((unsigned*)(p), (unsigned)(v))
#define LDS_ATOMIC_OR(p, v) atomicOr((unsigned*)(p), (unsigned)(v))
#define INVB(m) ((int)(((m) >> (threadIdx.x & 63)) & 1ull))
#define MED3F(a, lo, hi) fminf(fmaxf((a), (lo)), (hi))
#define RLX_LOAD(p) (*(p))
#define RLX_STORE(p, v) (*(p) = (v))
#define RLX_ADD(p, v) atomicAdd((unsigned*)(p), (unsigned)(v))
#else
#define LAS __attribute__((address_space(3)))
#define GAS __attribute__((address_space(1)))
#define MFMA16(a, b, c) __builtin_amdgcn_mfma_f32_16x16x32_bf16(a, b, c, 0, 0, 0)
#define MFMA32(a, b, c) __builtin_amdgcn_mfma_f32_32x32x16_bf16(a, b, c, 0, 0, 0)
#define WAIT_V(n) asm volatile("s_waitcnt vmcnt(" #n ")" ::: "memory")
#define WAIT_L(n) asm volatile("s_waitcnt lgkmcnt(" #n ")" ::: "memory")
#define WAIT_VM0() asm volatile("s_waitcnt vmcnt(0)" ::: "memory")
#define S_BARRIER() __builtin_amdgcn_s_barrier()
#define SCHED_BAR() __builtin_amdgcn_sched_barrier(0)
#define PIN16(x) asm volatile("" : "+v"(x))
#define PIN1(x) asm volatile("" : "+v"(x))
#define PINS(x) asm volatile("" : "+s"(x))
#define PIN2(x) asm volatile("" : "+v"(x))
#define SETPRIO(x) __builtin_amdgcn_s_setprio(x)
#define RFL(x) __builtin_amdgcn_readfirstlane(x)
#define LANE_ID() ((int)__builtin_amdgcn_mbcnt_hi(~0u, __builtin_amdgcn_mbcnt_lo(~0u, (unsigned)opaque(0))))
#define GLDS16(g, l) __builtin_amdgcn_global_load_lds((const unsigned*)(g), (LAS unsigned*)(l), 16, 0, 0)
typedef short v4i16_t __attribute__((ext_vector_type(4)));
#define DS_TR16(p) __builtin_bit_cast(s16x4, __builtin_amdgcn_ds_read_tr16_b64_v4i16((LAS v4i16_t*)(p)))
#define EXP2F(x) __builtin_amdgcn_exp2f(x)
#define RCPF(x) __builtin_amdgcn_rcpf(x)
#define RSQF(x) __builtin_amdgcn_rsqf(x)
#define LDS_ATOMIC_ADD(p, v) __hip_atomic_fetch_add((LAS unsigned*)(p), (unsigned)(v), __ATOMIC_RELAXED, __HIP_MEMORY_SCOPE_WORKGROUP)
#define LDS_ATOMIC_OR(p, v) __hip_atomic_fetch_or((LAS unsigned*)(p), (unsigned)(v), __ATOMIC_RELAXED, __HIP_MEMORY_SCOPE_WORKGROUP)
#define INVB(m) __builtin_amdgcn_inverse_ballot_w64(m)
#define MED3F(a, lo, hi) __builtin_amdgcn_fmed3f((a), (lo), (hi))
#define RLX_LOAD(p) __hip_atomic_load(p, __ATOMIC_RELAXED, __HIP_MEMORY_SCOPE_AGENT)
#define RLX_STORE(p, v) __hip_atomic_store(p, v, __ATOMIC_RELAXED, __HIP_MEMORY_SCOPE_AGENT)
#define RLX_ADD(p, v) __hip_atomic_fetch_add(p, v, __ATOMIC_RELAXED, __HIP_MEMORY_SCOPE_AGENT)
#endif

__device__ __forceinline__ int opaque(int v) { PIN1(v); return v; }
__device__ __forceinline__ int opaque_s(int v) { PINS(v); return v; }
__device__ __forceinline__ unsigned f2bf(float f) { unsigned u = __builtin_bit_cast(unsigned, f); return (u + 0x7fffu + ((u >> 16) & 1u)) >> 16; }
__device__ __forceinline__ unsigned pk2(float lo, float hi) { return f2bf(lo) | (f2bf(hi) << 16); }
__device__ __forceinline__ float bf2f(unsigned h) { return __builtin_bit_cast(float, h << 16); }
__device__ __forceinline__ float bflo(unsigned w) { return __builtin_bit_cast(float, w << 16); }
__device__ __forceinline__ float bfhi(unsigned w) { return __builtin_bit_cast(float, w & 0xffff0000u); }
__device__ __forceinline__ float sigmoidf_(float v) { return RCPF(1.0f + EXP2F(-1.4426950408889634f * v)); }
__device__ __forceinline__ float gelu_tanh(float v) { const float z = 0.7978845608028654f * (v + 0.044715f * v * v * v); return v * RCPF(1.0f + EXP2F(-2.885390081777927f * z)); }
__device__ __forceinline__ float row_rs(const u64* rowss, int r) { return RSQF((float)rowss[r] * (SS_INV / D_MODEL) + EPS); }
__device__ __forceinline__ int crow(int r, int hi) { return (r & 3) + 8 * (r >> 2) + 4 * hi; }

#define XB_TMO      128
#define XB_XCNT(j)  (256  + 64 * (j))
#define XB_XSUB(j)  (1280 + 64 * (j))
#define XB_XGEN(j)  (2304 + 64 * (j))
#define XB_TOP      3328
#define XB_TOPGEN   3392
#define XCD_BAR_WORDS 3456
#define XB_SPIN_CAP 0xF0000000u
struct XcdBarrier { unsigned* bar; unsigned x; volatile LAS unsigned* st; };
#ifdef EMU
__device__ __forceinline__ XcdBarrier xcd_barrier_post(unsigned* bar, volatile unsigned* st) { XcdBarrier b; b.bar = bar; b.x = 0; b.st = st; return b; }
__device__ __forceinline__ void xcd_barrier(const XcdBarrier&) { emu::grid_barrier(); }
#else
__device__ __forceinline__ unsigned xb_ld(unsigned* p)              { return __hip_atomic_load(p, __ATOMIC_RELAXED, __HIP_MEMORY_SCOPE_AGENT); }
__device__ __forceinline__ unsigned xb_add(unsigned* p, unsigned v) { return __hip_atomic_fetch_add(p, v, __ATOMIC_RELAXED, __HIP_MEMORY_SCOPE_AGENT); }
__device__ __forceinline__ unsigned xb_xcc_id() { return (unsigned)__builtin_amdgcn_s_getreg((3 << 11) | 20) & 0xFu; }
#define XB_SPIN(cond, bar) do { unsigned _sp = 0; while (cond) { __builtin_amdgcn_s_sleep(1); \
    if ((++_sp & 255u) == 0u) { if (xb_ld(&(bar)[XB_TMO])) break; if (_sp > XB_SPIN_CAP) { atomicAdd(&(bar)[XB_TMO], 1u); break; } } } } while (0)
__device__ __forceinline__ XcdBarrier xcd_barrier_post(unsigned* bar, volatile LAS unsigned* st) {
    XcdBarrier b; b.bar = bar; b.x = (unsigned)__builtin_amdgcn_readfirstlane((int)xb_xcc_id()); b.st = st;
    if (threadIdx.x == 0) (void)xb_add(&bar[XB_XCNT(b.x)], 1u);
    return b;
}
__device__ __forceinline__ void xcd_barrier_complete(unsigned* bar, unsigned x, unsigned& nloc, unsigned& nx) {
    const unsigned G = gridDim.x * gridDim.y * gridDim.z;
    unsigned sum, cnt, mine, sp = 0u;
    for (;;) {
        sum = 0u; cnt = 0u; mine = 0u;
#pragma unroll
        for (unsigned j = 0; j < 16; ++j) { const unsigned c = xb_ld(&bar[XB_XCNT(j)]); sum += c; cnt += (c > 0u) ? 1u : 0u; mine = (j == x) ? c : mine; }
        if (sum == G) break;
        __builtin_amdgcn_s_sleep(1);
        if ((++sp & 255u) == 0u) { if (xb_ld(&bar[XB_TMO])) break; if (sp > XB_SPIN_CAP) { atomicAdd(&bar[XB_TMO], 1u); break; } }
    }
    nloc = mine > 0u ? mine : 1u; nx = cnt > 0u ? cnt : 1u;
}
__device__ __forceinline__ void xcd_barrier(const XcdBarrier& b) {
    asm volatile("s_waitcnt vmcnt(0)" ::: "memory");
    __syncthreads();
    if (threadIdx.x == 0) {
        unsigned* bar = b.bar; const unsigned bx = (unsigned)__builtin_amdgcn_readfirstlane(opaque((int)b.x));
        __builtin_amdgcn_s_waitcnt(0);
        unsigned nloc = b.st[0], nx = b.st[1];
        if (nloc == 0u) { xcd_barrier_complete(bar, bx, nloc, nx); b.st[0] = nloc; b.st[1] = nx; }
        const unsigned old = xb_add(&bar[XB_XSUB(bx)], 1u);
        const unsigned gen = old / nloc;
        if (old + 1u == (gen + 1u) * nloc) {
            __builtin_amdgcn_fence(__ATOMIC_RELEASE, "agent");
            asm volatile("s_waitcnt vmcnt(0)" ::: "memory");
            const unsigned og = xb_add(&bar[XB_TOP], 1u);
            const unsigned tg = og / nx;
            if (og + 1u == (tg + 1u) * nx) xb_add(&bar[XB_TOPGEN], 1u);
            else XB_SPIN(xb_ld(&bar[XB_TOPGEN]) == tg, bar);
            __builtin_amdgcn_fence(__ATOMIC_ACQUIRE, "agent");
            xb_add(&bar[XB_XGEN(bx)], 1u);
            asm volatile("s_waitcnt vmcnt(0)" ::: "memory");
        } else {
            XB_SPIN(xb_ld(&bar[XB_XGEN(bx)]) == gen, bar);
            __builtin_amdgcn_fence(__ATOMIC_ACQUIRE, "agent");
            asm volatile("s_waitcnt vmcnt(0)" ::: "memory");
        }
    }
    __syncthreads();
}
#endif

namespace pg8 {
constexpr int BM = 256, BK = 64, HALF = 128, HTB = HALF * BK * 2, STAGE_BYTES = 8 * HTB, NXCD = 8, WGM = 8;
__host__ __device__ __forceinline__ int lds_byte(int r, int c) { const int st = (r >> 4) * 2 + (c >> 5), rr = r & 15, cc = c & 31, ob = rr * 64 + cc * 2; return st * 1024 + (ob ^ (((ob >> 9) & 1) << 5)); }
__host__ __device__ __forceinline__ void stage_rc(int b, int& R, int& C) { const int st = b / 1024, sb = b % 1024, swz = sb ^ (((sb >> 9) & 1) << 5); R = (st >> 1) * 16 + swz / 64; C = (st & 1) * 32 + (swz % 64) / 2; }
__host__ __device__ __forceinline__ int perm32(int rho) { const int n = rho >> 4, i = rho & 15; return 8 * (i >> 2) + 4 * n + (i & 3); }
struct Unit { int pm, pn; };
struct Gemm { const bf16_t* A; const bf16_t* Bt; int lda, ldb, K; };
struct StaticOrder {
    int nM, nN, nwg, G, c;
    __host__ __device__ void init(int M, int N, int G_, int c_) { nM = M / BM; nN = N / BM; nwg = nM * nN; G = G_; c = c_; }
    __host__ __device__ bool next(int i, Unit& u) const {
        const long L = (long)i * G + c; if (L >= nwg) return false;
        int wgid = (int)L; { const int q = nwg / NXCD, r = nwg % NXCD, xcd = wgid % NXCD, off = wgid / NXCD; wgid = (xcd < r ? xcd * (q + 1) : r * (q + 1) + (xcd - r) * q) + off; }
        const int nig = WGM * nN, gid = wgid / nig, fm = gid * WGM, gsz = (nM - fm) < WGM ? (nM - fm) : WGM;
        u.pm = fm + ((wgid % nig) % gsz); u.pn = (wgid % nig) / gsz; return true;
    }
};
struct GroupOrder {
    int G, c;
    __host__ __device__ bool next(int i, Unit& u) const { const int idx = i * G + c; if (idx >= S5_GROUPS * NCHT) return false; const int g = idx / NCHT; u.pm = idx; u.pn = g; return true; }
};

template <class Epi, class Sched>
__device__ __forceinline__ void gemm_phase(LAS unsigned char* lds, const int wave_id, const Gemm g, const Sched& S, const Epi& E) {
    const int lane = LANE_ID(), wid = opaque_s(wave_id), tid = wid * 64 + lane, wr = wid >> 2, wc = wid & 3, fr = lane & 15, fq = lane >> 4;
    const int K = g.K, nt = K / BK;
    unsigned voffA[2], voffB[2];
#pragma unroll
    for (int i = 0; i < 2; ++i) { int R, C; stage_rc(tid * 16 + i * 8192, R, C); const int Rb = Epi::PERM ? ((R & ~31) + perm32(R & 31)) : R;
        voffA[i] = (unsigned)(R * g.lda + C) * 2u; voffB[i] = (unsigned)(Rb * g.ldb + C) * 2u; }
    const size_t kstep = (size_t)(BK * 2);
    const size_t hstepA = (size_t)HALF * g.lda * 2, hstepB = (size_t)HALF * g.ldb * 2;
    const size_t tstepA = 2 * hstepA, tstepB = 2 * hstepB;
    const unsigned ldsw = (unsigned)wid * 1024u;
    const int aoff = lds_byte(wr * 64 + fr, fq * 8), boff = lds_byte(wc * 32 + fr, fq * 8);
#define PG8_SA(b, h) (((b) * 2 + (h)) * HTB)
#define PG8_SB(b, h) ((4 + (b) * 2 + (h)) * HTB)
#define PG8_STAGE(bufoff, gbase, voff) do { _Pragma("unroll") for (int _i = 0; _i < 2; ++_i) \
        GLDS16((const char*)(gbase) + (voff)[_i], lds + (bufoff) + ldsw + _i * 8192); } while (0)
#define PG8_LDA(dst, b, h) do { _Pragma("unroll") for (int m = 0; m < 4; ++m) _Pragma("unroll") for (int k = 0; k < 2; ++k) dst[m][k] = *(const LAS bf16x8*)(lds + PG8_SA(b, h) + aoff + m * 2048 + k * 1024); } while (0)
#define PG8_LDB(dst, b, h) do { _Pragma("unroll") for (int n = 0; n < 2; ++n) _Pragma("unroll") for (int k = 0; k < 2; ++k) dst[n][k] = *(const LAS bf16x8*)(lds + PG8_SB(b, h) + boff + n * 2048 + k * 1024); } while (0)
#define PG8_MMA(ai, bj, At, Bt) do { SETPRIO(1); _Pragma("unroll") for (int m = 0; m < 4; ++m) _Pragma("unroll") for (int n = 0; n < 2; ++n) _Pragma("unroll") for (int k = 0; k < 2; ++k) \
        acc[ai][bj][m][n] = MFMA16(Bt[n][k], At[m][k], acc[ai][bj][m][n]); SETPRIO(0); } while (0)
#define PG8_BAR S_BARRIER()
    Unit cur, nxt; int ui = 0;
    if (!S.next(0, cur)) return;
    f32x4 acc[2][2][4][2];
#pragma unroll
    for (int a = 0; a < 2; ++a)
#pragma unroll
        for (int b = 0; b < 2; ++b)
#pragma unroll
            for (int m = 0; m < 4; ++m)
#pragma unroll
                for (int n = 0; n < 2; ++n) acc[a][b][m][n] = (f32x4){0.f, 0.f, 0.f, 0.f};
    bf16x8 At[4][2], B0[2][2], B1[2][2];
    const char* cA = (const char*)g.A + (size_t)cur.pm * tstepA; const char* cB = (const char*)g.Bt + (size_t)cur.pn * tstepB;
    PG8_STAGE(PG8_SB(0, 0), cB, voffB); PG8_STAGE(PG8_SB(0, 1), cB + hstepB, voffB); PG8_STAGE(PG8_SA(0, 0), cA, voffA); PG8_STAGE(PG8_SA(0, 1), cA + hstepA, voffA);
    if (wr == 1) PG8_BAR;
    WAIT_V(2); PG8_BAR;
    PG8_STAGE(PG8_SB(1, 0), cB + kstep, voffB); PG8_STAGE(PG8_SA(1, 0), cA + kstep, voffA); PG8_STAGE(PG8_SB(1, 1), cB + hstepB + kstep, voffB);
    WAIT_V(6); PG8_BAR;
    for (;;) {
        const bool has_next = S.next(ui + 1, nxt);
        const char* nA = has_next ? (const char*)g.A + (size_t)nxt.pm * tstepA : cA; const char* nB = has_next ? (const char*)g.Bt + (size_t)nxt.pn * tstepB : cB;
        for (int t = 0; t < nt; t += 2) {
            const bool last = (t == nt - 2);
            const char* a1 = cA + (size_t)(t + 1) * kstep;
            const char* a2 = last ? nA : cA + (size_t)(t + 2) * kstep; const char* b2 = last ? nB : cB + (size_t)(t + 2) * kstep;
            const char* a3 = a2 + kstep; const char* b3 = b2 + kstep;
            PG8_LDB(B0, 0, 0); PG8_LDB(B1, 0, 1); SCHED_BAR(); PG8_LDA(At, 0, 0); PG8_STAGE(PG8_SA(1, 1), a1 + hstepA, voffA);
            WAIT_V(8); WAIT_L(0); PG8_BAR; PG8_MMA(0, 0, At, B0); PG8_MMA(0, 1, At, B1); PG8_BAR; SCHED_BAR();
            PG8_LDA(At, 0, 1); PG8_STAGE(PG8_SB(0, 0), b2, voffB); PG8_STAGE(PG8_SB(0, 1), b2 + hstepB, voffB); PG8_STAGE(PG8_SA(0, 0), a2, voffA);
            WAIT_V(8); WAIT_L(0); PG8_BAR; PG8_MMA(1, 0, At, B0); PG8_MMA(1, 1, At, B1); PG8_BAR; SCHED_BAR();
            PG8_LDB(B0, 1, 0); PG8_LDB(B1, 1, 1); SCHED_BAR(); PG8_LDA(At, 1, 0); PG8_STAGE(PG8_SA(0, 1), a2 + hstepA, voffA);
            WAIT_V(8); WAIT_L(0); PG8_BAR; PG8_MMA(0, 0, At, B0); PG8_MMA(0, 1, At, B1); PG8_BAR; SCHED_BAR();
            PG8_LDA(At, 1, 1); PG8_STAGE(PG8_SB(1, 0), b3, voffB); PG8_STAGE(PG8_SB(1, 1), b3 + hstepB, voffB); PG8_STAGE(PG8_SA(1, 0), a3, voffA);
            WAIT_V(8); WAIT_L(0); PG8_BAR; PG8_MMA(1, 0, At, B0); PG8_MMA(1, 1, At, B1); PG8_BAR; SCHED_BAR();
        }
        if (wr == 0) PG8_BAR;
        { const int le = LANE_ID(); E(acc, cur, wr, wc, le & 15, le >> 4); }
        if (!has_next) break;
#pragma unroll
        for (int a = 0; a < 2; ++a)
#pragma unroll
            for (int b = 0; b < 2; ++b)
#pragma unroll
                for (int m = 0; m < 4; ++m)
#pragma unroll
                    for (int n = 0; n < 2; ++n) acc[a][b][m][n] = (f32x4){0.f, 0.f, 0.f, 0.f};
        cur = nxt; cA = nA; cB = nB; ++ui;
        if (wr == 1) PG8_BAR;
    }
    WAIT_V(0);
    PG8_BAR;
#undef PG8_SA
#undef PG8_SB
#undef PG8_STAGE
#undef PG8_LDA
#undef PG8_LDB
#undef PG8_MMA
#undef PG8_BAR
}
}
using pg8::Unit;

__device__ __forceinline__ float quad_sum(float s) { s += __shfl_xor(s, 16); s += __shfl_xor(s, 32); return s; }

template <bool GLU> struct EpiRes {
    static constexpr bool PERM = true;
    const float* xin; float* xout; bf16_t* xb; u64* rowss;
    __device__ __forceinline__ void operator()(const f32x4 (&acc)[2][2][4][2], const Unit& u, int wr, int wc, int fr, int fq) const {
        PIN1(fr); PIN1(fq);
#pragma unroll
        for (int ai = 0; ai < 2; ++ai)
#pragma unroll
            for (int m = 0; m < 4; ++m) {
                const int r = u.pm * 256 + ai * 128 + wr * 64 + m * 16 + fr; float ss = 0.f;
                if (GLU) {
                    const size_t off = (size_t)r * D_MODEL + u.pn * 128 + wc * 32 + 8 * fq;
                    f32x4 o[2];
#pragma unroll
                    for (int n = 0; n < 2; ++n) { const f32x4 xo = *(const f32x4*)(xin + off + 4 * n); const f32x4 v = acc[ai][0][m][n], gt = acc[ai][1][m][n];
#pragma unroll
                        for (int i = 0; i < 4; ++i) { const float t = xo[i] + v[i] * sigmoidf_(gt[i]); o[n][i] = t; ss += t * t; }
                        *(f32x4*)(xout + off + 4 * n) = o[n]; }
                    u32x4 w; w.x = pk2(o[0][0], o[0][1]); w.y = pk2(o[0][2], o[0][3]); w.z = pk2(o[1][0], o[1][1]); w.w = pk2(o[1][2], o[1][3]);
                    *(u32x4*)(xb + off) = w;
                } else {
#pragma unroll
                    for (int bj = 0; bj < 2; ++bj) { const size_t off = (size_t)r * D_MODEL + u.pn * 256 + bj * 128 + wc * 32 + 8 * fq; f32x4 o[2];
#pragma unroll
                        for (int n = 0; n < 2; ++n) { const f32x4 xo = *(const f32x4*)(xin + off + 4 * n); const f32x4 v = acc[ai][bj][m][n];
#pragma unroll
                            for (int i = 0; i < 4; ++i) { const float t = xo[i] + v[i]; o[n][i] = t; ss += t * t; }
                            *(f32x4*)(xout + off + 4 * n) = o[n]; }
                        u32x4 w; w.x = pk2(o[0][0], o[0][1]); w.y = pk2(o[0][2], o[0][3]); w.z = pk2(o[1][0], o[1][1]); w.w = pk2(o[1][2], o[1][3]);
                        *(u32x4*)(xb + off) = w; }
                }
                ss = quad_sum(ss);
                if (fq == 0) atomicAdd(rowss + r, (u64)(ss * SS_FIX));
            }
    }
};
struct EpiSwiGLU {
    static constexpr bool PERM = true;
    bf16_t* act; const u64* rowss;
    __device__ __forceinline__ void operator()(const f32x4 (&acc)[2][2][4][2], const Unit& u, int wr, int wc, int fr, int fq) const {
        PIN1(fr); PIN1(fq);
#pragma unroll
        for (int ai = 0; ai < 2; ++ai)
#pragma unroll
            for (int m = 0; m < 4; ++m) {
                const int r = u.pm * 256 + ai * 128 + wr * 64 + m * 16 + fr; const float rs = row_rs(rowss, r);
                float o[8];
#pragma unroll
                for (int n = 0; n < 2; ++n)
#pragma unroll
                    for (int i = 0; i < 4; ++i) { const float gt = rs * acc[ai][0][m][n][i], up = rs * acc[ai][1][m][n][i]; o[4 * n + i] = gt * sigmoidf_(gt) * up; }
                u32x4 w; w.x = pk2(o[0], o[1]); w.y = pk2(o[2], o[3]); w.z = pk2(o[4], o[5]); w.w = pk2(o[6], o[7]);
                *(u32x4*)(act + (size_t)r * D_FF + u.pn * 128 + wc * 32 + 8 * fq) = w;
            }
    }
};
struct EpiInProj {
    static constexpr bool PERM = true;
    bf16_t *Q, *Kb, *V, *QI, *KI; float* WI; const u64* rowss; const float* rope; const float* qg; const float* kg;
    __device__ __forceinline__ void operator()(const f32x4 (&acc)[2][2][4][2], const Unit& u, int wr, int wc, int fr, int fq) const {
        PIN1(fr); PIN1(fq);
        const int pn = u.pn;
#pragma unroll
        for (int ai = 0; ai < 2; ++ai)
#pragma unroll
            for (int m = 0; m < 4; ++m) {
                const int r = u.pm * 256 + ai * 128 + wr * 64 + m * 16 + fr; const float rs = row_rs(rowss, r);
                float t1[8], t2[8];
#pragma unroll
                for (int n = 0; n < 2; ++n)
#pragma unroll
                    for (int i = 0; i < 4; ++i) { t1[4 * n + i] = rs * acc[ai][0][m][n][i]; t2[4 * n + i] = rs * acc[ai][1][m][n][i]; }
                if (pn >= 2 * NH4 && pn < 3 * NH4) {
                    const size_t off = (size_t)r * D_MODEL + (pn - 2 * NH4) * 256 + wc * 32 + 8 * fq;
                    u32x4 w; w.x = pk2(t1[0], t1[1]); w.y = pk2(t1[2], t1[3]); w.z = pk2(t1[4], t1[5]); w.w = pk2(t1[6], t1[7]); *(u32x4*)(V + off) = w;
                    w.x = pk2(t2[0], t2[1]); w.y = pk2(t2[2], t2[3]); w.z = pk2(t2[4], t2[5]); w.w = pk2(t2[6], t2[7]); *(u32x4*)(V + off + 128) = w;
                    continue;
                }
                const bool last = (pn == 3 * NH4 + 2);
                if (last && wc == 1) { if (fq == 0) { const float sc = 0.35355339059327373f * 0.125f;
                        *(f32x4*)(WI + (size_t)r * 8) = (f32x4){t1[0] * sc, t1[1] * sc, t1[2] * sc, t1[3] * sc}; *(f32x4*)(WI + (size_t)r * 8 + 4) = (f32x4){t1[4] * sc, t1[5] * sc, t1[6] * sc, t1[7] * sc}; }
                    continue; }
                if (last && wc != 0) continue;
                const bool isq = pn < NH4, isk = (pn >= NH4 && pn < 2 * NH4);
                if (isq || isk || last) {
                    float ss = 0.f;
#pragma unroll
                    for (int i = 0; i < 8; ++i) ss += t1[i] * t1[i] + t2[i] * t2[i];
                    ss = quad_sum(ss); const float rn = RSQF(ss * (1.0f / 64.0f) + EPS);
                    const float* gn = isq ? qg : kg;
#pragma unroll
                    for (int i = 0; i < 8; ++i) { const float g1 = last ? 1.0f : gn[8 * fq + i], g2 = last ? 1.0f : gn[32 + 8 * fq + i]; t1[i] *= rn * g1; t2[i] *= rn * g2; }
                }
                const float* cs = rope + (size_t)r * 64 + 8 * fq; float o1[8], o2[8]; const float qs = isq ? C2 : 1.0f;
#pragma unroll
                for (int i = 0; i < 8; ++i) { const float c = cs[i], s = cs[32 + i]; o1[i] = (t1[i] * c - t2[i] * s) * qs; o2[i] = (t2[i] * c + t1[i] * s) * qs; }
                bf16_t* dst;
                if (isq) dst = Q + (size_t)r * D_MODEL + (pn * 4 + wc) * 64; else if (isk) dst = Kb + (size_t)r * D_MODEL + ((pn - NH4) * 4 + wc) * 64;
                else if (last) dst = KI + (size_t)r * 64; else dst = QI + (size_t)r * 512 + ((pn - 3 * NH4) * 4 + wc) * 64;
                u32x4 w; w.x = pk2(o1[0], o1[1]); w.y = pk2(o1[2], o1[3]); w.z = pk2(o1[4], o1[5]); w.w = pk2(o1[6], o1[7]); *(u32x4*)(dst + 8 * fq) = w;
                w.x = pk2(o2[0], o2[1]); w.y = pk2(o2[2], o2[3]); w.z = pk2(o2[4], o2[5]); w.w = pk2(o2[6], o2[7]); *(u32x4*)(dst + 32 + 8 * fq) = w;
            }
    }
};
struct EpiS5State {
    static constexpr bool PERM = true;
    float* S;
    __device__ __forceinline__ void operator()(const f32x4 (&acc)[2][2][4][2], const Unit& u, int wr, int wc, int fr, int fq) const {
        PIN1(fr); PIN1(fq);
#pragma unroll
        for (int ai = 0; ai < 2; ++ai)
#pragma unroll
            for (int m = 0; m < 4; ++m) { const size_t row = (size_t)u.pm * 256 + ai * 128 + wr * 64 + m * 16 + fr;
                float* p = S + row * 128 + wc * 32 + 8 * fq; *(f32x4*)p = acc[ai][0][m][0]; *(f32x4*)(p + 4) = acc[ai][0][m][1]; }
    }
};
struct EpiS5Out {
    static constexpr bool PERM = true;
    bf16_t* Y; const bf16_t* UX; const float* dskip;
    __device__ __forceinline__ void operator()(const f32x4 (&acc)[2][2][4][2], const Unit& u, int wr, int wc, int fr, int fq) const {
        PIN1(fr); PIN1(fq);
        const int g = u.pn;
#pragma unroll
        for (int ai = 0; ai < 2; ++ai)
#pragma unroll
            for (int m = 0; m < 4; ++m) { const size_t row = (size_t)u.pm * 256 + ai * 128 + wr * 64 + m * 16 + fr; const int c = (int)(row - (size_t)g * NCH);
#pragma unroll
                for (int bj = 0; bj < 2; ++bj) { const int col = bj * 128 + wc * 32 + 8 * fq, i = col >> 4, ho = col & 15;
                    const u32x4 uw = *(const u32x4*)(UX + row * UXW + col); const float* dk = dskip + 16 * g + ho;
                    float o[8]; const unsigned uu[4] = {uw.x, uw.y, uw.z, uw.w};
#pragma unroll
                    for (int n = 0; n < 2; ++n)
#pragma unroll
                        for (int j = 0; j < 4; ++j) { const int e = 4 * n + j; const float uv = (e & 1) ? bfhi(uu[e >> 1]) : bflo(uu[e >> 1]); o[e] = gelu_tanh(acc[ai][bj][m][n][j] + dk[e] * uv); }
                    u32x4 w; w.x = pk2(o[0], o[1]); w.y = pk2(o[2], o[3]); w.z = pk2(o[4], o[5]); w.w = pk2(o[6], o[7]);
                    *(u32x4*)(Y + (size_t)(16 * c + i) * D_MODEL + 16 * g + ho) = w; }
                asm volatile("" ::: "memory"); }
    }
};

constexpr int RING_BYTES = 131072, LDSCTL_OFF = RING_BYTES, LDS_BYTES = 147456;
struct Args { const float* in[18]; float* out; unsigned char* ws; };
struct Frame {
    LAS unsigned char* lds; int tid, lane, wave, vcu, G;
    const float* in[18]; float* out; unsigned char* ws;
};
__device__ __forceinline__ float wave_sum(float v) {
#pragma unroll
    for (int o = 1; o < 64; o <<= 1) v += __shfl_xor(v, o);
    return v;
}
__device__ __forceinline__ int win_src(int np) {
    const int pn = np >> 8, y = np & 255, bj = y >> 7, hh = (y >> 5) & 3, dd = y & 31;
    if (pn < 2 * NH4) { const int base = pn < NH4 ? 0 : D_MODEL, t = pn < NH4 ? pn : pn - NH4; return base + (4 * t + hh) * 64 + 32 * bj + dd; }
    if (pn < 3 * NH4) return np;
    if (pn < 3 * NH4 + 2) return 3 * D_MODEL + (4 * (pn - 3 * NH4) + hh) * 64 + 32 * bj + dd;
    if (hh == 0) return 3 * D_MODEL + 512 + 32 * bj + dd;
    if (hh == 1 && bj == 0 && dd < 8) return 3 * D_MODEL + 512 + 64 + dd;
    return -1;
}
__device__ __forceinline__ int glu_src(int np, int HW) { const int pn = np >> 8, y = np & 255; return (y >> 7) * HW + pn * 128 + (y & 127); }

template <int MODE> __device__ __forceinline__ void transpose_item(const float* W, int K, int N, int HW, const float* gain, bf16_t* WT, LAS float* scr, int item, int NP, int lane) {
    const int nblk = NP / 32, kb = item / nblk, nb = item % nblk, k0 = 64 * kb, n0 = 32 * nb;
    const int np = n0 + (lane & 31); const int src = MODE == 0 ? np : (MODE == 1 ? glu_src(np, HW) : win_src(np));
    float v[32];
#pragma unroll
    for (int i = 0; i < 32; ++i) { const int kk = 2 * i + (lane >> 5); v[i] = (src >= 0) ? W[(size_t)(k0 + kk) * N + src] : 0.f; }
    if (gain) {
#pragma unroll
        for (int i = 0; i < 32; ++i) v[i] *= gain[k0 + 2 * i + (lane >> 5)]; }
#pragma unroll
    for (int i = 0; i < 32; ++i) scr[(2 * i + (lane >> 5)) * 33 + (lane & 31)] = v[i];
    WAIT_L(0);
    const int c = lane & 7;
#pragma unroll
    for (int j = 0; j < 4; ++j) { const int n = (lane >> 3) + 8 * j; const LAS float* s = scr + (8 * c) * 33 + n;
        u32x4 o; o.x = pk2(s[0 * 33], s[1 * 33]); o.y = pk2(s[2 * 33], s[3 * 33]); o.z = pk2(s[4 * 33], s[5 * 33]); o.w = pk2(s[6 * 33], s[7 * 33]);
        *(u32x4*)(WT + (size_t)(n0 + n) * K + k0 + 8 * c) = o; }
    WAIT_L(0);
}

__device__ __forceinline__ void s5_pre(Frame& F0) {
    Frame F = F0; F.lane = LANE_ID(); F.tid = F0.wave * 64 + F.lane;
    for (int jg = blockIdx.x; jg < N_S5 * S5_GROUPS; jg += F.G) {
        const float* lre = F.in[1] + (size_t)jg * 64; const float* lim = F.in[2] + (size_t)jg * 64; const float* bre = F.in[4] + (size_t)jg * 1024; const float* bim = F.in[5] + (size_t)jg * 1024;
        float* pre = (float*)(F.ws + WS_S5PRE + (size_t)jg * S5PRE_STRIDE);
        const double dt = exp((double)F.in[3][jg]);
        for (int e = F.tid; e < 18 * 64; e += NTHREADS) { const int tau = e >> 6, p = e & 63; const double zr = (double)lre[p] * dt * tau, zi = (double)lim[p] * dt * tau, m = exp(zr);
            pre[e * 2] = (float)(m * cos(zi)); pre[e * 2 + 1] = (float)(m * sin(zi)); }
        for (int e = F.tid; e < 1024; e += NTHREADS) { const int p = e >> 4; const double lr = lre[p], li = lim[p], m = exp(lr * dt), ar = m * cos(li * dt) - 1.0, ai = m * sin(li * dt);
            const double den = lr * lr + li * li, qr = (ar * lr + ai * li) / den, qi = (ai * lr - ar * li) / den;
            const double br = bre[e], bi = bim[e];
            pre[2304 + e * 2] = (float)(qr * br - qi * bi); pre[2304 + e * 2 + 1] = (float)(qr * bi + qi * br); }
        if (F.tid < 64) { const int p = F.tid; const double lr = lre[p], li = lim[p]; const double m1 = exp(lr * dt * 16), m2 = exp(lr * dt * 16 * SEGL);
            f32x4 v; v.x = (float)(m1 * cos(li * dt * 16)); v.y = (float)(m1 * sin(li * dt * 16)); v.z = (float)(m2 * cos(li * dt * 16 * SEGL)); v.w = (float)(m2 * sin(li * dt * 16 * SEGL));
            *(f32x4*)(pre + 4352 + p * 4) = v; }
    }
}
__device__ __forceinline__ void s5_setup(Frame& F0) {
    Frame F = F0; F.lane = LANE_ID(); F.tid = F0.wave * 64 + F.lane;
    LAS float* ap = (LAS float*)F.lds;
    LAS float* bb = ap + 18 * 128;
    LAS float* cc = bb + 2048;
    LAS float* kt = cc + 2048;
    for (int jg = blockIdx.x; jg < N_S5 * S5_GROUPS; jg += F.G) {
        const int j = jg / S5_GROUPS, g = jg % S5_GROUPS;
        const float* cre = F.in[6] + (size_t)j * S5_GROUPS * 1024; const float* cim = F.in[7] + (size_t)j * S5_GROUPS * 1024;
        bf16_t* AM = (bf16_t*)(F.ws + WS_S5TAB + (size_t)j * SZ_S5TAB + MIX_AM); bf16_t* W1 = (bf16_t*)(F.ws + WS_S5TAB + (size_t)j * SZ_S5TAB + MIX_W1);
        __syncthreads();
        const float* pre = (const float*)(F.ws + WS_S5PRE + ((size_t)j * S5_GROUPS + g) * S5PRE_STRIDE);
        for (int e = F.tid; e < 4352; e += NTHREADS) ap[e] = pre[e];
        for (int e = F.tid; e < 1024; e += NTHREADS) { cc[e * 2] = cre[(size_t)g * 1024 + e]; cc[e * 2 + 1] = cim[(size_t)g * 1024 + e]; }
        __syncthreads();
        for (int e = F.tid; e < 4096; e += NTHREADS) { const int tau = e >> 8, ho = (e >> 4) & 15, hi = e & 15; float s = 0.f;
            for (int p = 0; p < 64; ++p) { const float cr = cc[(ho * 64 + p) * 2], ci = cc[(ho * 64 + p) * 2 + 1], ar = ap[(tau * 64 + p) * 2], ai = ap[(tau * 64 + p) * 2 + 1];
                const float xr = cr * ar - ci * ai, xi = cr * ai + ci * ar; s += xr * bb[(p * 16 + hi) * 2] - xi * bb[(p * 16 + hi) * 2 + 1]; }
            kt[e] = s; }
        __syncthreads();
        bf16_t* am = AM + (size_t)g * 256 * UXW;
        for (int e = F.tid; e < 256 * (UXW / 2); e += NTHREADS) { const int np = e / (UXW / 2), k = 2 * (e % (UXW / 2)), i = np >> 4, ho = np & 15; float v0, v1;
            if (k < 256) { const int jj = k >> 4, hi = k & 15; v0 = (jj <= i) ? kt[((i - jj) * 16 + ho) * 16 + hi] : 0.f; v1 = (jj <= i) ? kt[((i - jj) * 16 + ho) * 16 + hi + 1] : 0.f; }
            else { const int p = (k - 256) >> 1; const float cr = cc[(ho * 64 + p) * 2], ci = cc[(ho * 64 + p) * 2 + 1], ar = ap[((i + 1) * 64 + p) * 2], ai = ap[((i + 1) * 64 + p) * 2 + 1];
                v0 = cr * ar - ci * ai; v1 = -(cr * ai + ci * ar); }
            *(unsigned*)(am + (size_t)np * UXW + k) = pk2(v0, v1); }
        bf16_t* w1 = W1 + (size_t)g * 256 * 256;
        for (int e = F.tid; e < 256 * 128; e += NTHREADS) { const int np = e >> 7, k = 2 * (e & 127); float v[2] = {0.f, 0.f};
            if (np < 128) { const int p = np >> 1, comp = np & 1, jj = k >> 4;
#pragma unroll
                for (int t = 0; t < 2; ++t) { const int h = (k & 15) + t; const float ar = ap[((15 - jj) * 64 + p) * 2], ai = ap[((15 - jj) * 64 + p) * 2 + 1], br = bb[(p * 16 + h) * 2], bi = bb[(p * 16 + h) * 2 + 1];
                    v[t] = comp ? (ar * bi + ai * br) : (ar * br - ai * bi); } }
            *(unsigned*)(w1 + (size_t)np * 256 + k) = pk2(v[0], v[1]); }
    }
    __syncthreads();
}

__device__ __forceinline__ void convert_weights(Frame& F0) {
    Frame F = F0; F.lane = LANE_ID(); F.tid = F0.wave * 64 + F.lane;
    LAS float* scr = (LAS float*)(F.lds + 32768 + F.wave * 8704);
    const int nbusy = N_S5 * S5_GROUPS < F.G ? N_S5 * S5_GROUPS : F.G, bx = (int)blockIdx.x;
    const int NGW = nbusy * 4 + (F.G - nbusy) * NWAVES; const int gw = bx < nbusy ? (F.wave < 4 ? bx * 4 + F.wave : NGW) : nbusy * 4 + (bx - nbusy) * NWAVES + F.wave;
    constexpr int I_GLU = (D_MODEL / 64) * (2 * D_MODEL / 32), I_IN = (D_MODEL / 64) * (NIN_PAD / 32), I_O = (D_MODEL / 64) * (D_MODEL / 32), I_GU = (D_MODEL / 64) * (2 * D_FF / 32), I_DN = (D_FF / 64) * (D_MODEL / 32);
    constexpr int NITEMS = N_S5 * I_GLU + N_DSA * (I_IN + I_O) + DEPTH * (I_GU + I_DN);
    for (int it = gw; it < NITEMS; it += NGW) {
        int r = it;
        if (r < N_S5 * I_GLU) { const int j = r / I_GLU; transpose_item<1>(F.in[9] + (size_t)j * D_MODEL * 2 * D_MODEL, D_MODEL, 2 * D_MODEL, D_MODEL, nullptr, (bf16_t*)(F.ws + WS_WGLU + j * SZ_WGLU), scr, r % I_GLU, 2 * D_MODEL, F.lane); continue; } r -= N_S5 * I_GLU;
        if (r < N_DSA * I_IN) { const int j = r / I_IN; transpose_item<2>(F.in[10] + (size_t)j * D_MODEL * DSA_PROJ, D_MODEL, DSA_PROJ, 0, F.in[16] + (size_t)(2 * j + 1) * D_MODEL, (bf16_t*)(F.ws + WS_WIN + j * SZ_WIN), scr, r % I_IN, NIN_PAD, F.lane); continue; } r -= N_DSA * I_IN;
        if (r < N_DSA * I_O) { const int j = r / I_O; transpose_item<0>(F.in[13] + (size_t)j * D_MODEL * D_MODEL, D_MODEL, D_MODEL, 0, nullptr, (bf16_t*)(F.ws + WS_WO + j * SZ_WO), scr, r % I_O, D_MODEL, F.lane); continue; } r -= N_DSA * I_O;
        if (r < DEPTH * I_GU) { const int j = r / I_GU; transpose_item<1>(F.in[14] + (size_t)j * D_MODEL * 2 * D_FF, D_MODEL, 2 * D_FF, D_FF, F.in[17] + (size_t)j * D_MODEL, (bf16_t*)(F.ws + WS_WGU + j * SZ_WGU), scr, r % I_GU, 2 * D_FF, F.lane); continue; } r -= DEPTH * I_GU;
        { const int j = r / I_DN; transpose_item<0>(F.in[15] + (size_t)j * D_FF * D_MODEL, D_FF, D_MODEL, 0, nullptr, (bf16_t*)(F.ws + WS_WDN + j * SZ_WDN), scr, r % I_DN, D_MODEL, F.lane); }
    }
}
__device__ __forceinline__ void prologue_rows(Frame& F0) {
    Frame F = F0; F.lane = LANE_ID(); F.tid = F0.wave * 64 + F.lane;
    const int gw = F.vcu * NWAVES + F.wave, NGW = F.G * NWAVES;
    u64* rowss0 = (u64*)(F.ws + WS_ROWSS); float* rope = (float*)(F.ws + WS_ROPE); bf16_t* XB = (bf16_t*)(F.ws + WS_XB);
    for (int m = gw; m < SEQ; m += NGW) {
        const float* xr = F.in[0] + (size_t)m * D_MODEL; float s = 0.f;
        for (int c = F.lane * 4; c < D_MODEL; c += 256) { const f32x4 v = *(const f32x4*)(xr + c); s += (v.x * v.x + v.y * v.y) + (v.z * v.z + v.w * v.w);
            u32x2 w; w.x = pk2(v.x, v.y); w.y = pk2(v.z, v.w); *(u32x2*)(XB + (size_t)m * D_MODEL + c) = w; }
        s = wave_sum(s); if (F.lane == 0) rowss0[m] = (u64)(s * SS_FIX);
        if (F.lane < 32) { const float inv = powf(10000.0f, -(float)(2 * F.lane) / 64.0f); const float ang = (float)m * inv; rope[(size_t)m * 64 + F.lane] = (float)cos((double)ang); rope[(size_t)m * 64 + 32 + F.lane] = (float)sin((double)ang); }
    }
}

__device__ __forceinline__ void s5_build_ux(Frame& F0, const float* x, const u64* rowss, const float* gain) {
    Frame F = F0; F.lane = LANE_ID(); F.tid = F0.wave * 64 + F.lane;
    bf16_t* UX = (bf16_t*)(F.ws + WS_R + R_UX);
    const int gw = F.vcu * NWAVES + F.wave, NGW = F.G * NWAVES; const int j = F.lane >> 2, p = F.lane & 3;
    for (int it = gw; it < NCH * (S5_GROUPS / 4); it += NGW) { const int c = it / (S5_GROUPS / 4), gq = it % (S5_GROUPS / 4), g = 4 * gq + p, t = 16 * c + j;
        const float rs = row_rs(rowss, t); const float* xr = x + (size_t)t * D_MODEL + 16 * g; const float* gn = gain + 16 * g; float v[16];
#pragma unroll
        for (int q = 0; q < 4; ++q) { const f32x4 a = *(const f32x4*)(xr + 4 * q), gg = *(const f32x4*)(gn + 4 * q); v[4 * q] = a.x * rs * gg.x; v[4 * q + 1] = a.y * rs * gg.y; v[4 * q + 2] = a.z * rs * gg.z; v[4 * q + 3] = a.w * rs * gg.w; }
        bf16_t* dst = UX + ((size_t)g * NCH + c) * UXW + 16 * j;
        u32x4 w; w.x = pk2(v[0], v[1]); w.y = pk2(v[2], v[3]); w.z = pk2(v[4], v[5]); w.w = pk2(v[6], v[7]); *(u32x4*)dst = w;
        w.x = pk2(v[8], v[9]); w.y = pk2(v[10], v[11]); w.z = pk2(v[12], v[13]); w.w = pk2(v[14], v[15]); *(u32x4*)(dst + 8) = w; }
}
__device__ __forceinline__ void s5_scan(Frame& F0, int j) {
    Frame F = F0; F.lane = LANE_ID(); F.tid = F0.wave * 64 + F.lane;
    bf16_t* UX = (bf16_t*)(F.ws + WS_R + R_UX); const float* S = (const float*)(F.ws + WS_R + R_S);
    LAS float* E = (LAS float*)F.lds;
    const int pl = F.tid & 31, seg = F.tid >> 5;
    for (int b = blockIdx.x; b < S5_GROUPS * 2; b += F.G) { const int g = b >> 1, p = (b & 1) * 32 + pl;
        __syncthreads();
        const f32x4 av = *(const f32x4*)((const float*)(F.ws + WS_S5PRE + ((size_t)j * S5_GROUPS + g) * S5PRE_STRIDE) + 4352 + p * 4); const float ar = av.x, ai = av.y, sr = av.z, si = av.w;
        const float* sp = S + ((size_t)g * NCH + (size_t)seg * SEGL) * 128 + 2 * p; float xr = 0.f, xi = 0.f;
#pragma unroll 16
        for (int c = 0; c < SEGL; ++c) { const float br = sp[(size_t)c * 128], bi = sp[(size_t)c * 128 + 1]; const float nr = ar * xr - ai * xi + br, ni = ar * xi + ai * xr + bi; xr = nr; xi = ni; }
        E[(seg * 32 + pl) * 2] = xr; E[(seg * 32 + pl) * 2 + 1] = xi;
        __syncthreads();
        xr = 0.f; xi = 0.f;
        for (int s = 0; s < seg; ++s) { const float er = E[(s * 32 + pl) * 2], ei = E[(s * 32 + pl) * 2 + 1]; const float nr = sr * xr - si * xi + er, ni = sr * xi + si * xr + ei; xr = nr; xi = ni; }
        bf16_t* up = UX + ((size_t)g * NCH + (size_t)seg * SEGL) * UXW + 256 + 2 * p;
#pragma unroll 16
        for (int c = 0; c < SEGL; ++c) { *(unsigned*)(up + (size_t)c * UXW) = pk2(xr, xi); const float br = sp[(size_t)c * 128], bi = sp[(size_t)c * 128 + 1]; const float nr = ar * xr - ai * xi + br, ni = ar * xi + ai * xr + bi; xr = nr; xi = ni; }
    }
    __syncthreads();
}

__device__ __forceinline__ void idx_kload(bf16x8 (&ka)[2][4], const bf16_t* KI, int k0, int lane) {
    const bf16_t* kp = KI + (size_t)(k0 + (lane & 31)) * 64 + 8 * (lane >> 5);
#pragma unroll
    for (int t = 0; t < 2; ++t)
#pragma unroll
        for (int ks = 0; ks < 4; ++ks) ka[t][ks] = *(const bf16x8*)(kp + (size_t)t * 32 * 64 + 16 * ks);
}
struct QAddr { int e[4], o[4], l[4]; };
constexpr int QLIN_OFF = 135168;
__device__ __forceinline__ QAddr idx_qaddr(int lane) { QAddr A; const int ql = lane & 31, hi = lane >> 5, s3 = (ql >> 3) & 1;
#pragma unroll
    for (int ks = 0; ks < 4; ++ks) { const int lo = ql * 1024 + (((2 * ks + hi) ^ (ql & 7)) * 16); A.e[ks] = opaque(lo + (s3 ? 128 : 0)); A.o[ks] = opaque(lo - (s3 ? 128 : 0)); A.l[ks] = opaque(QLIN_OFF - 65536 + ql * 128 + (((2 * ks + hi) ^ (ql & 7)) * 16)); }
    return A; }
__device__ __forceinline__ void idx_qload(bf16x8 (&qf)[4], const LAS unsigned char* qt, const QAddr& A, int h) {
#pragma unroll
    for (int ks = 0; ks < 4; ++ks) qf[ks] = (h == 8) ? *(const LAS bf16x8*)(qt + A.l[ks]) : *(const LAS bf16x8*)(qt + ((h & 1) ? A.o[ks] : A.e[ks]) + 128 * h);
}
__device__ __forceinline__ void idx_mma(f32x16& d0, f32x16& d1, const bf16x8 (&ka)[2][4], const bf16x8 (&qf)[4]) {
#pragma unroll
    for (int r = 0; r < 16; ++r) { d0[r] = 0.f; d1[r] = 0.f; }
#pragma unroll
    for (int ks = 0; ks < 4; ++ks) { d0 = MFMA32(ka[0][ks], qf[ks], d0); d1 = MFMA32(ka[1][ks], qf[ks], d1); }
}
#ifdef EMU
#define MFMA_SETTLE(x, y)
#define FMA_ABS(s, d, w) (s) = fmaf(fabsf(d), (w), (s))
#else
#define MFMA_SETTLE(x, y) asm volatile("s_nop 11" : "+v"(x), "+v"(y))
#define FMA_ABS(s, d, w) asm("v_fma_f32 %0, |%1|, %2, %0" : "+v"(s) : "v"(d), "v"(w))
#endif
__device__ __forceinline__ void idx_acc(f32x16& S, const f32x16& D, const float hw) {
#pragma unroll
    for (int i = 0; i < 16; ++i) { float t = S[i]; const float d = D[i]; FMA_ABS(t, d, hw); S[i] = t; }
}
__device__ __forceinline__ void idx_scores2(f32x16& s0, f32x16& s1, const LAS unsigned char* qt, const QAddr& A, const float (&hw)[8], const bf16x8 (&ka)[2][4]) {
    bf16x8 qa[4], qb[4]; f32x16 a0, a1, b0, b1;
    idx_qload(qa, qt, A, 8); idx_qload(qb, qt, A, 0); SCHED_BAR();
    idx_mma(s0, s1, ka, qa); idx_qload(qa, qt, A, 1); SCHED_BAR();
    idx_mma(a0, a1, ka, qb); idx_qload(qb, qt, A, 2); SCHED_BAR();
#pragma unroll
    for (int h = 0; h < 8; h += 2) {
        idx_mma(b0, b1, ka, qa); if (h + 3 < 8) idx_qload(qa, qt, A, h + 3); SCHED_BAR();
        idx_acc(s0, a0, hw[h]); idx_acc(s1, a1, hw[h]); SCHED_BAR();
        if (h + 2 < 8) { idx_mma(a0, a1, ka, qb); if (h + 4 < 8) idx_qload(qb, qt, A, h + 4); SCHED_BAR(); } else { MFMA_SETTLE(b0, b1); }
        idx_acc(s0, b0, hw[h + 1]); idx_acc(s1, b1, hw[h + 1]); SCHED_BAR();
    }
}
__device__ __forceinline__ int score_bin(float s, float inv64) { return (int)MED3F(__builtin_fmaf(s, inv64, -BIN_LO * BIN_SCALE), 0.f, (float)(NBINS - 1)); }

template <int PASS> __device__ __forceinline__ void idx_pass(Frame& F0, int un, LAS unsigned* hist, LAS int* qinfo) {
    Frame F = F0; F.lane = LANE_ID(); F.tid = F0.wave * 64 + F.lane;
    const bf16_t* KI = (const bf16_t*)(F.ws + WS_MIX + MIX_KI); const float* WI = (const float*)(F.ws + WS_MIX + MIX_WI);
    const int lane = F.lane, ql = lane & 31, hi = lane >> 5, q = 32 * un + ql, ntiles = un + 1, npairs = (ntiles + 1) >> 1;
    const LAS unsigned char* qt = F.lds + 65536;
    float hwp[8];
#pragma unroll
    for (int h = 0; h < 8; ++h) hwp[h] = 0.5f * WI[(size_t)q * 8 + h];
    const int bstar = PASS == 2 ? qinfo[ql * 4] : 0; const float inv64 = __builtin_bit_cast(float, qinfo[ql * 4 + 3]) * BIN_SCALE;
    LAS unsigned* cand = (LAS unsigned*)(F.lds + 98304) + (ql * 16 + F.wave * 2 + hi) * 16; int mycnt = 0;
    const unsigned hb = (unsigned)(ql * (NBINS / 2)); const QAddr QA = idx_qaddr(lane);
    bf16x8 ka[2][4];
    if (F.wave < npairs) idx_kload(ka, KI, 64 * F.wave, lane);
    for (int kp = F.wave; kp < npairs; kp += NWAVES) {
        const bool more = kp + NWAVES < npairs;
        f32x16 sc0, sc1; idx_scores2(sc0, sc1, qt, QA, hwp, ka);
        PIN16(sc0); PIN16(sc1);
        if (more) idx_kload(ka, KI, 64 * (kp + NWAVES), lane);
        const bool full = (2 * kp + 1 < ntiles - 1);
#pragma unroll
        for (int t = 0; t < 2; ++t) { const int kt = 2 * kp + t;
            if (PASS == 1) {
#pragma unroll
                for (int r = 0; r < 16; ++r) { const int key = 32 * kt + crow(r, hi); const float sv = t ? sc1[r] : sc0[r];
                    if (full || key <= q) { const int b = score_bin(sv, inv64); LDS_ATOMIC_ADD(hist + hb + (b >> 1), 1u + (unsigned)(b & 1) * 0xFFFFu); } }
            } else if (kt < ntiles) {
                u64 mine = 0ull;
#pragma unroll
                for (int r = 0; r < 16; ++r) { const int key = 32 * kt + crow(r, hi); const bool valid = full || key <= q; const float sv = t ? sc1[r] : sc0[r]; const int b = score_bin(sv, inv64);
                    const u64 bal = __ballot(valid && b > bstar); mine = (lane == r) ? bal : mine;
                    const bool isc = valid && b == bstar;
                    if (__any(isc)) { if (isc) { if (mycnt < 16) { const float fr_ = MED3F(__builtin_fmaf(sv, inv64, (float)(NBINS / 2 - b)) * 262144.0f, 0.f, 262143.0f); cand[mycnt] = ((unsigned)fr_ << 14) | (unsigned)(16383 - key); } ++mycnt; } } }
                if (lane < 16) ((LAS u64*)hist)[kt * 16 + lane] = mine;
            }
        }
    }
    if (PASS == 2) ((LAS int*)(F.lds + RING_BYTES + 2048))[ql * 16 + F.wave * 2 + hi] = mycnt < 16 ? mycnt : 16;
}
__device__ __forceinline__ void indexer_unit(Frame& F0, int un) {
    Frame F = F0; F.lane = LANE_ID(); F.tid = F0.wave * 64 + F.lane;
    const bf16_t* QI = (const bf16_t*)(F.ws + WS_MIX + MIX_QI); const bf16_t* KI = (const bf16_t*)(F.ws + WS_MIX + MIX_KI); const float* WI = (const float*)(F.ws + WS_MIX + MIX_WI);
    unsigned* M32 = (unsigned*)(F.ws + WS_XB);
    LAS unsigned* hist = (LAS unsigned*)F.lds; LAS int* qinfo = (LAS int*)(F.lds + RING_BYTES); LAS int* ccnt = (LAS int*)(F.lds + RING_BYTES + 2048);
    LAS float* nrm = (LAS float*)(F.lds + 98304);
    const int lane = F.lane, q0 = 32 * un;
    __syncthreads();
    { const unsigned zz = (unsigned)opaque(0); const u32x4 z4 = (u32x4){zz, zz, zz, zz};
      for (int e = F.tid; e < 32 * NBINS / 2 / 4; e += NTHREADS) ((LAS u32x4*)hist)[e] = z4; }
    if (F.tid < 128) qinfo[F.tid] = 0;
    for (int e = F.tid; e < 32 * 64; e += NTHREADS) { const int row = e >> 6, c = e & 63;
        *(LAS u32x4*)(F.lds + 65536 + row * 1024 + ((c ^ (row & 15)) * 16)) = *(const u32x4*)(QI + (size_t)(q0 + row) * 512 + 8 * c); }
    if (F.tid < 256) { const int row = F.tid & 31, h = F.tid >> 5; const bf16_t* qr = QI + (size_t)(q0 + row) * 512 + h * 64; float ss = 0.f;
        for (int e = 0; e < 64; e += 8) { const u32x4 a = *(const u32x4*)(qr + e); ss += bflo(a.x) * bflo(a.x) + bfhi(a.x) * bfhi(a.x) + bflo(a.y) * bflo(a.y) + bfhi(a.y) * bfhi(a.y) + bflo(a.z) * bflo(a.z) + bfhi(a.z) * bfhi(a.z) + bflo(a.w) * bflo(a.w) + bfhi(a.w) * bfhi(a.w); }
        const float w = WI[(size_t)(q0 + row) * 8 + h]; nrm[row * 8 + h] = w * w * ss; }
    { const int row = F.tid & 31, d4 = (F.tid >> 5) * 4; float a0 = 0.f, a1 = 0.f, a2 = 0.f, a3 = 0.f;
#pragma unroll
      for (int h = 0; h < 8; ++h) { const float w = 0.5f * WI[(size_t)(q0 + row) * 8 + h]; const u32x2 v = *(const u32x2*)(QI + (size_t)(q0 + row) * 512 + h * 64 + d4);
          a0 += w * bflo(v.x); a1 += w * bfhi(v.x); a2 += w * bflo(v.y); a3 += w * bfhi(v.y); }
      u32x2 o; o.x = pk2(a0, a1); o.y = pk2(a2, a3); *(LAS u32x2*)(F.lds + QLIN_OFF + row * 128 + (((d4 >> 3) ^ (row & 7)) * 16) + (d4 & 7) * 2) = o; }
    __syncthreads();
    if (F.tid < 32) { float a = 0.f;
#pragma unroll
        for (int h = 0; h < 8; ++h) a += nrm[F.tid * 8 + h];
        const float inv = a > 1e-30f ? RSQF(0.5f * a) : 1.0f; qinfo[F.tid * 4 + 3] = __builtin_bit_cast(int, inv); }
    __syncthreads();
    idx_pass<1>(F, un, hist, qinfo);
    __syncthreads();
    for (int i = 0; i < 4; ++i) { const int qq = 4 * F.wave + i; const int n = q0 + qq + 1;
        unsigned cnt[16]; unsigned tot = 0;
#pragma unroll
        for (int e = 0; e < 2; ++e) { const u32x4 w = ((const LAS u32x4*)(hist + qq * (NBINS / 2) + lane * 8))[e]; const unsigned ww[4] = {w.x, w.y, w.z, w.w};
#pragma unroll
            for (int t = 0; t < 4; ++t) { cnt[8 * e + 2 * t] = ww[t] & 0xffffu; cnt[8 * e + 2 * t + 1] = ww[t] >> 16; tot += (ww[t] & 0xffffu) + (ww[t] >> 16); } }
        unsigned v = tot;
#pragma unroll
        for (int o = 1; o < 64; o <<= 1) { const unsigned t = __shfl(v, (lane + o) & 63); if (lane + o < 64) v += t; }
        const unsigned above = v - tot;
        if (n > TOPK) { const bool mine = (above < (unsigned)TOPK) && (above + tot >= (unsigned)TOPK);
            if (mine) { unsigned a = above, abest = above; int bb = 15; bool found = false;
#pragma unroll
                for (int t = 15; t >= 0; --t) { const bool hit = !found && (a + cnt[t] >= (unsigned)TOPK); if (hit) { bb = t; abest = a; found = true; } a += cnt[t]; }
                qinfo[qq * 4] = lane * 16 + bb; qinfo[qq * 4 + 1] = TOPK - (int)abest; }
        } else if (lane == 0) { qinfo[qq * 4] = opaque(-1); qinfo[qq * 4 + 1] = opaque(0); }
    }
    __syncthreads();
    idx_pass<2>(F, un, hist, qinfo);
    __syncthreads();
    LAS unsigned* cand = (LAS unsigned*)(F.lds + 98304);
    for (int i = 0; i < 4; ++i) { const int qq = 4 * F.wave + i; const int rneed = qinfo[qq * 4 + 1];
        if (rneed <= 0) continue;
#pragma unroll
        for (int k = 0; k < 4; ++k) { const int sl = lane + 64 * k;
            if ((sl & 15) < ccnt[qq * 16 + (sl >> 4)]) { const unsigned me = cand[qq * 256 + sl]; int rank = 0;
                for (int sb = 0; sb < 16; ++sb) { const int c2 = ccnt[qq * 16 + sb];
                    for (int p2 = 0; p2 < c2; ++p2) rank += (cand[qq * 256 + sb * 16 + p2] > me) ? 1 : 0; }
                if (rank < rneed) { const unsigned key = 16383u - (me & 16383u); const int kk = key & 31, h2 = (kk >> 2) & 1, r = (kk & 3) + 4 * (kk >> 3); LDS_ATOMIC_OR(hist + (key >> 5) * 32 + r * 2 + h2, 1u << qq); } } }
    }
    __syncthreads();
    const int ktz = 8 * (un >> 3) + 8;
    for (int e = F.tid; e < ktz * 32; e += NTHREADS) { const int kt = e >> 5; M32[((size_t)kt * (SEQ / 32) + un) * 32 + (e & 31)] = kt <= un ? hist[e] : 0u; }
}
__device__ __forceinline__ void indexer_phase(Frame& F) {
    constexpr int NU = SEQ / 32;
    for (int p = F.vcu; p < NU / 2; p += F.G) { indexer_unit(F, p); indexer_unit(F, NU - 1 - p); }
    __syncthreads();
}

#ifdef EMU
#define A2_DMA(gsrc, ldsoff) emu_glds16((const void*)(gsrc), (void*)(F.lds + (ldsoff)))
#define A2_WAIT_BAR(N) emu::block_barrier()
#define A2_SBAR()
#define A2_PIN(x)
#define A2_CVTPK(lo, hi) pk2(lo, hi)
struct a2_m8 { u64 v[8]; u64 operator[](int i) const { return v[i]; } };
static inline a2_m8 a2_sload8(const u64* p) { a2_m8 r; for (int i = 0; i < 8; ++i) r.v[i] = p[i]; return r; }
#define A2_SWAIT4(a, b, c, d)
#else
typedef unsigned long long a2_m8 __attribute__((ext_vector_type(8)));
__device__ __forceinline__ a2_m8 a2_sload8(const u64* p) { a2_m8 r; asm volatile("s_load_dwordx16 %0, %1, 0x0 glc" : "=s"(r) : "s"(p)); return r; }
#define A2_SWAIT4(a, b, c, d) asm volatile("s_waitcnt lgkmcnt(0)" : "+s"(a), "+s"(b), "+s"(c), "+s"(d))
__device__ __forceinline__ void a2_glds16(const void* gsrc, unsigned lds_dst) { unsigned keep;
    asm volatile("s_mov_b32 %0, m0\n\ts_mov_b32 m0, %2\n\ts_nop 0\n\tglobal_load_lds_dwordx4 %1, off\n\ts_mov_b32 m0, %0" : "=&s"(keep) : "v"(gsrc), "s"(lds_dst) : "memory"); }
typedef __bf16 a2_bf16x2 __attribute__((ext_vector_type(2)));
__device__ __forceinline__ unsigned a2_cvtpk(float lo, float hi) { f32x2 v = {lo, hi}; a2_bf16x2 b = __builtin_convertvector(v, a2_bf16x2); return __builtin_bit_cast(unsigned, b); }
#define A2_DMA(gsrc, ldsoff) a2_glds16((const void*)(gsrc), (unsigned)__builtin_amdgcn_readfirstlane((int)(lds0 + (unsigned)(ldsoff))))
#define A2_WAIT_BAR(N) asm volatile("s_waitcnt vmcnt(" #N ") lgkmcnt(0)\n\ts_barrier" ::: "memory")
#define A2_SBAR() __builtin_amdgcn_sched_barrier(0)
#define A2_PIN(x) asm volatile("" : "+v"(x))
#define A2_CVTPK(lo, hi) a2_cvtpk(lo, hi)
#endif
constexpr int A2_NSLOT = 3, A2_SLOTB = 8192, A2_K = 0, A2_V = A2_NSLOT * A2_SLOTB, A2_WS = 2 * A2_NSLOT * A2_SLOTB, A2_OST = A2_WS + 8 * 64 * 4, A2_BYTES = A2_OST + 8 * 4096;
static_assert(A2_BYTES <= RING_BYTES, "attention scratch fits the ring");
__device__ __forceinline__ void attn_unit2(Frame& F0, int h, int qb) {
    Frame F = F0; F.lane = LANE_ID(); F.tid = F0.wave * 64 + F.lane;
    bf16_t* Qg = (bf16_t*)(F.ws + WS_R + R_Q); const bf16_t* Kg = (const bf16_t*)(F.ws + WS_R + R_K); const bf16_t* Vg = (const bf16_t*)(F.ws + WS_R + R_V);
    const int lane = F.lane, r32 = lane & 31, hi = lane >> 5, wid = F.wave, q0 = qb * 256;
    const bf16_t* Qw = Qg + (size_t)(q0 + wid * 32) * D_MODEL + h * 64; const bf16_t* Kh = Kg + h * 64; const bf16_t* Vh = Vg + h * 64;
#ifndef EMU
    const unsigned lds0 = (unsigned)(uintptr_t)F.lds;
#endif
    LAS float* wsf = (LAS float*)(F.lds + A2_WS) + wid * 64;
    const bf16_t* ksrc = Kh + (size_t)lane * D_MODEL + wid * 8;
    const bf16_t* vsrc = Vh + (size_t)(16 * (wid & 3) + (lane >> 2)) * D_MODEL + (wid >> 2) * 32 + (lane & 3) * 8;
    const int kdst = A2_K + wid * 1024, vdst = A2_V + wid * 1024;
#define DMA_K(t, slot) A2_DMA(ksrc + (size_t)(t) * 64 * D_MODEL, kdst + (slot))
#define DMA_V(t, slot) A2_DMA(vsrc + (size_t)(t) * 64 * D_MODEL, vdst + (slot))
    const LAS unsigned char* kp0 = F.lds + A2_K + hi * 1024 + r32 * 16;
    const LAS unsigned char* vp0 = F.lds + A2_V + ((lane >> 4) & 1) * 32 + (lane & 3) * 8 + (4 * hi + ((lane & 15) >> 2)) * 64;
    const int NT = (q0 + 256) / 64;
    const u64* MW = (const u64*)(F.ws + WS_XB) + (size_t)(8 * qb + wid) * 16; constexpr size_t MS = (size_t)(SEQ / 32) * 16;
    DMA_K(0, 0); DMA_V(0, 0); DMA_K(1, A2_SLOTB);
    bf16x8 qr[4];
#pragma unroll
    for (int d0 = 0; d0 < 4; ++d0) qr[d0] = *(const bf16x8*)(Qw + (size_t)r32 * D_MODEL + d0 * 16 + hi * 8);
    float l_reg = 0.f; f32x16 o[2]; f32x16 zero16;
#pragma unroll
    for (int r = 0; r < 16; ++r) { o[0][r] = 0.f; o[1][r] = 0.f; zero16[r] = 0.f; }
    f32x16 pA0, pA1, pB0, pB1; bf16x8 kf[8];
    int sl_prev = 0, sl_cur = 0, sl_next = A2_SLOTB;
#define ROT() do { sl_prev = sl_cur; sl_cur = sl_next; sl_next = (sl_next == (A2_NSLOT - 1) * A2_SLOTB) ? 0 : sl_next + A2_SLOTB; } while (0)
#define KLOAD2(kp, j) do { kf[2 * (j)] = *(const LAS bf16x8*)((kp) + (j) * 2048); kf[2 * (j) + 1] = *(const LAS bf16x8*)((kp) + (j) * 2048 + 512); } while (0)
    DMA_K(2, 2 * A2_SLOTB);
    A2_WAIT_BAR(3);
    { const LAS unsigned char* kb = kp0;
      KLOAD2(kb, 0); KLOAD2(kb, 1); KLOAD2(kb, 2); KLOAD2(kb, 3);
      pA0 = MFMA32(kf[0], qr[0], zero16); pA1 = MFMA32(kf[1], qr[0], zero16);
#pragma unroll
      for (int d0 = 1; d0 < 4; ++d0) { pA0 = MFMA32(kf[2 * d0], qr[d0], pA0); pA1 = MFMA32(kf[2 * d0 + 1], qr[d0], pA1); }
      a2_m8 m0 = a2_sload8(MW), m1 = a2_sload8(MW + 8), m2 = a2_sload8(MW + MS), m3 = a2_sload8(MW + MS + 8); A2_SWAIT4(m0, m1, m2, m3);
#pragma unroll
      for (int r = 0; r < 8; ++r) { pA0[r] = INVB(m0[r]) ? EXP2F(pA0[r]) : 0.f; pA0[8 + r] = INVB(m1[r]) ? EXP2F(pA0[8 + r]) : 0.f; pA1[r] = INVB(m2[r]) ? EXP2F(pA1[r]) : 0.f; pA1[8 + r] = INVB(m3[r]) ? EXP2F(pA1[8 + r]) : 0.f; } }
    A2_WAIT_BAR(0);
    DMA_K(3, 0); DMA_V(1, A2_SLOTB);
    ROT();
    { const LAS unsigned char* kb = kp0 + sl_cur; KLOAD2(kb, 0); KLOAD2(kb, 1); KLOAD2(kb, 2); KLOAD2(kb, 3); }
    A2_WAIT_BAR(2);
    s16x4 vlo[8], vhi[8]; u32x4 pw0, pw1, pw2, pw3;
#define PKW(P, B) A2_CVTPK(P[B], P[(B) + 1])
#define PAF(k) __builtin_bit_cast(bf16x8, pw##k)
#define VFR(i) (bf16x8){vlo[i][0], vlo[i][1], vlo[i][2], vlo[i][3], vhi[i][0], vhi[i][1], vhi[i][2], vhi[i][3]}
#define GAPA(MF, A0, A1, A2, A3, W0, W1, PW) do { MF; sacc += A0; sacc += A1; sacc += A2; sacc += A3; A2_PIN(sacc); W0; W1; A2_PIN(PW); A2_SBAR(); } while (0)
#define GAPB(MF, X, B, J, MK) do { MF; X[B] = INVB(MK[J]) ? EXP2F(X[B]) : 0.f; X[(B) + 1] = INVB(MK[(J) + 1]) ? EXP2F(X[(B) + 1]) : 0.f; X[(B) + 2] = INVB(MK[(J) + 2]) ? EXP2F(X[(B) + 2]) : 0.f; X[(B) + 3] = INVB(MK[(J) + 3]) ? EXP2F(X[(B) + 3]) : 0.f; A2_PIN(X); A2_SBAR(); } while (0)
#define VRD(i) do { vlo[i] = DS_TR16(vp_ + (((i) >> 2) * 4096 + ((i) & 3) * 1024)); vhi[i] = DS_TR16(vp_ + (((i) >> 2) * 4096 + ((i) & 3) * 1024 + 512)); } while (0)
#define KRD(G, j) do { if (G) { KLOAD2(kp0 + sl_next, j); A2_SBAR(); } } while (0)
#define STEP(C0, C1, P0, P1, t, GK, GV, GL) do { A2_SBAR(); \
    const LAS unsigned char* vp_ = vp0 + sl_prev; const u64* mka_ = MW + (size_t)(2 * (t)) * MS; const u64* mkb_ = mka_ + MS; \
    a2_m8 ma0_ = a2_sload8(mka_), ma1_ = a2_sload8(mka_ + 8), mb0_ = a2_sload8(mkb_), mb1_ = a2_sload8(mkb_ + 8); \
    VRD(0); A2_SBAR(); float sacc = (P0[0] + P0[1]); \
    GAPA(C0 = MFMA32(kf[0], qr[0], zero16), P0[2], P0[3], P0[4], P0[5],     pw0[0] = PKW(P0, 0), pw0[1] = PKW(P0, 2), pw0); \
    VRD(4); A2_SBAR(); GAPA(C1 = MFMA32(kf[1], qr[0], zero16), P0[6], P0[7], P0[8], P0[9],     pw0[2] = PKW(P0, 4), pw0[3] = PKW(P0, 6), pw0); \
    VRD(1); A2_SBAR(); GAPA(C0 = MFMA32(kf[2], qr[1], C0),   P0[10], P0[11], P0[12], P0[13], pw1[0] = PKW(P0, 8), pw1[1] = PKW(P0, 10), pw1); \
    VRD(5); A2_SBAR(); GAPA(C1 = MFMA32(kf[3], qr[1], C1),   P0[14], P0[15], P1[0], P1[1],   pw1[2] = PKW(P0, 12), pw1[3] = PKW(P0, 14), pw1); \
    VRD(2); A2_SBAR(); GAPA(C0 = MFMA32(kf[4], qr[2], C0),   P1[2], P1[3], P1[4], P1[5],     pw2[0] = PKW(P1, 0), pw2[1] = PKW(P1, 2), pw2); \
    VRD(6); A2_SBAR(); GAPA(C1 = MFMA32(kf[5], qr[2], C1),   P1[6], P1[7], P1[8], P1[9],     pw2[2] = PKW(P1, 4), pw2[3] = PKW(P1, 6), pw2); \
    VRD(3); A2_SBAR(); GAPA(C0 = MFMA32(kf[6], qr[3], C0),   P1[10], P1[11], P1[12], P1[13], pw3[0] = PKW(P1, 8), pw3[1] = PKW(P1, 10), pw3); \
    VRD(7); A2_SBAR(); GAPA(C1 = MFMA32(kf[7], qr[3], C1),   P1[14], P1[15], 0.f, 0.f,       pw3[2] = PKW(P1, 12), pw3[3] = PKW(P1, 14), pw3); \
    l_reg += sacc; \
    if (GK) { DMA_K((t) + 3, sl_cur); } if (GV) { DMA_V((t) + 1, sl_next); } \
    A2_SWAIT4(ma0_, ma1_, mb0_, mb1_); A2_SBAR(); \
    GAPB(o[0] = MFMA32(PAF(0), VFR(0), o[0]), C0, 0, 0, ma0_); \
    GAPB(o[1] = MFMA32(PAF(0), VFR(4), o[1]), C0, 4, 4, ma0_); \
    KRD(GL, 0); GAPB(o[0] = MFMA32(PAF(1), VFR(1), o[0]), C0, 8, 0, ma1_); \
    KRD(GL, 1); GAPB(o[1] = MFMA32(PAF(1), VFR(5), o[1]), C0, 12, 4, ma1_); \
    KRD(GL, 2); GAPB(o[0] = MFMA32(PAF(2), VFR(2), o[0]), C1, 0, 0, mb0_); \
    KRD(GL, 3); GAPB(o[1] = MFMA32(PAF(2), VFR(6), o[1]), C1, 4, 4, mb0_); \
    GAPB(o[0] = MFMA32(PAF(3), VFR(3), o[0]), C1, 8, 0, mb1_); \
    GAPB(o[1] = MFMA32(PAF(3), VFR(7), o[1]), C1, 12, 4, mb1_); \
    } while (0)
    int t = 1;
    for (; t + 5 < NT; t += 2) {
        STEP(pB0, pB1, pA0, pA1, t, true, true, true);     A2_WAIT_BAR(2); ROT();
        STEP(pA0, pA1, pB0, pB1, t + 1, true, true, true); A2_WAIT_BAR(2); ROT();
    }
#define ENDW(tt) do { if ((tt) + 3 < NT) { A2_WAIT_BAR(2); } else if ((tt) + 2 < NT) { A2_WAIT_BAR(1); } else { A2_WAIT_BAR(0); } } while (0)
    for (; t + 1 < NT; t += 2) {
        STEP(pB0, pB1, pA0, pA1, t, (t + 3 < NT), (t + 1 < NT), (t + 1 < NT));         ENDW(t);     ROT();
        STEP(pA0, pA1, pB0, pB1, t + 1, (t + 4 < NT), (t + 2 < NT), (t + 2 < NT));     ENDW(t + 1); ROT();
    }
    STEP(pB0, pB1, pA0, pA1, NT - 1, false, false, false);
    { float sacc = pB0[0] + pB0[1];
#pragma unroll
      for (int r = 2; r < 16; ++r) sacc += pB0[r];
#pragma unroll
      for (int r = 0; r < 16; ++r) sacc += pB1[r];
      l_reg += sacc;
      pw0 = (u32x4){PKW(pB0, 0), PKW(pB0, 2), PKW(pB0, 4), PKW(pB0, 6)}; pw1 = (u32x4){PKW(pB0, 8), PKW(pB0, 10), PKW(pB0, 12), PKW(pB0, 14)};
      pw2 = (u32x4){PKW(pB1, 0), PKW(pB1, 2), PKW(pB1, 4), PKW(pB1, 6)}; pw3 = (u32x4){PKW(pB1, 8), PKW(pB1, 10), PKW(pB1, 12), PKW(pB1, 14)};
      A2_SBAR();
      const LAS unsigned char* vp_ = vp0 + sl_cur;
#pragma unroll
      for (int d0 = 0; d0 < 2; ++d0) {
#pragma unroll
          for (int ks = 0; ks < 4; ++ks) { VRD(d0 * 4 + ks); }
          o[d0] = MFMA32(PAF(0), VFR(d0 * 4 + 0), o[d0]); o[d0] = MFMA32(PAF(1), VFR(d0 * 4 + 1), o[d0]); o[d0] = MFMA32(PAF(2), VFR(d0 * 4 + 2), o[d0]); o[d0] = MFMA32(PAF(3), VFR(d0 * 4 + 3), o[d0]); } }
    l_reg += __shfl_xor(l_reg, 32);
    if (hi == 0) wsf[32 + r32] = l_reg;
    WAIT_L(0);
    float rli[16];
#pragma unroll
    for (int r = 0; r < 16; ++r) rli[r] = RCPF(wsf[32 + crow(r, hi)]);
    bf16_t* Ow = Qg + (size_t)(q0 + wid * 32) * D_MODEL + h * 64;
    { LAS bf16_t* stg = (LAS bf16_t*)(F.lds + A2_OST) + wid * 2048;
#pragma unroll
      for (int r = 0; r < 16; ++r) { const int orow = crow(r, hi);
#pragma unroll
          for (int d0 = 0; d0 < 2; ++d0) stg[orow * 64 + d0 * 32 + r32] = (bf16_t)f2bf(o[d0][r] * rli[r]); }
      WAIT_L(0);
#pragma unroll
      for (int i = 0; i < 4; ++i) { const int row = i * 8 + (lane >> 3), ch = lane & 7; const u32x4 v = *(const LAS u32x4*)(stg + row * 64 + ch * 8); *(u32x4*)(Ow + (size_t)row * D_MODEL + ch * 8) = v; } }
    A2_WAIT_BAR(0);
#undef DMA_K
#undef DMA_V
#undef ROT
#undef KLOAD2
#undef PKW
#undef PAF
#undef VFR
#undef GAPA
#undef GAPB
#undef VRD
#undef KRD
#undef STEP
#undef ENDW
}
__device__ __forceinline__ void attn_phase(Frame& F) {
    constexpr int NQB = SEQ / 256, NP = N_HEADS * (NQB / 2);
    for (int p = F.vcu; p < NP; p += F.G) { const int head = p / (NQB / 2), s = p % (NQB / 2); attn_unit2(F, head, s); attn_unit2(F, head, NQB - 1 - s); }
    __syncthreads();
}

#ifdef EMU
#define CG_SYNC() emu::grid_barrier()
#define LDS_DECL(name) unsigned char* name = emu::lds_ptr()
#else
namespace cg = cooperative_groups;
#define CG_SYNC() cg::this_grid().sync()
#define LDS_DECL(name) extern __shared__ __attribute__((aligned(16))) unsigned char name[]
#endif

#ifdef EMU
static int g_emu_max_layers = DEPTH;
#define MAX_LAYERS g_emu_max_layers
static int g_emu_stop = 0;
#define EMU_STOP(k) do { if (g_emu_stop == (k)) return; } while (0)
#else
#define MAX_LAYERS DEPTH
#define EMU_SNAPSHOT() do {} while (0)
#define EMU_STOP(k) do {} while (0)
#endif
__global__ void __launch_bounds__(NTHREADS, 2) mega_fwd(Args args) {
    LDS_DECL(lds_raw);
    Frame F;
    F.lds = (LAS unsigned char*)lds_raw; F.tid = threadIdx.x; F.lane = F.tid & 63; F.wave = RFL(F.tid >> 6);
    F.G = gridDim.x; { const int bx = blockIdx.x; F.vcu = (F.G % 8 == 0) ? (bx % 8) * (F.G / 8) + bx / 8 : bx; }
#pragma unroll
    for (int i = 0; i < 18; ++i) F.in[i] = args.in[i];
    F.out = args.out; F.ws = args.ws;
    volatile LAS unsigned* MISC = (volatile LAS unsigned*)(F.lds + LDSCTL_OFF + 1024);
    if (F.tid < 64) MISC[F.tid] = 0u;
    __syncthreads();
    XcdBarrier bar = xcd_barrier_post((unsigned*)(F.ws + WS_CTL) + 4096, MISC + 8);
#define GRID_BAR() xcd_barrier(bar)
    u64* rowss = (u64*)(F.ws + WS_ROWSS); bf16_t* XB = (bf16_t*)(F.ws + WS_XB);
    LAS unsigned char* ring = F.lds;

#ifndef KN
#define KN 0xffff
#endif
    if (KN & 1) { s5_pre(F);
    WAIT_VM0(); __syncthreads();
    s5_setup(F);
    convert_weights(F);
    prologue_rows(F); }
    EMU_STOP(1);
    CG_SYNC();

    for (int layer = 0; layer < MAX_LAYERS; ++layer) {
        const int j = layer >> 1;
#define XIN (opaque_s(layer) == 0 ? F.in[0] : F.out)
        u64* rs_mix = rowss + (size_t)(2 * layer) * SEQ; u64* rs_ffn = rowss + (size_t)(2 * layer + 1) * SEQ; u64* rs_next = rowss + (size_t)(2 * layer + 2) * SEQ;
        if ((layer & 1) == 0) {
            if (KN & 2) s5_build_ux(F, XIN, rs_mix, F.in[16] + (size_t)layer * D_MODEL);
            GRID_BAR(); EMU_STOP(2);
            if (KN & 4) { pg8::Gemm g{(const bf16_t*)(F.ws + WS_R + R_UX), (const bf16_t*)(F.ws + WS_S5TAB + (size_t)j * SZ_S5TAB + MIX_W1), UXW, 256, 256}; pg8::GroupOrder S{F.G, (int)blockIdx.x};
              EpiS5State E{(float*)(F.ws + WS_R + R_S)}; pg8::gemm_phase(ring, F.wave, g, S, E); }
            GRID_BAR(); EMU_STOP(3);
            if (KN & 8) s5_scan(F, j);
            GRID_BAR(); EMU_STOP(4);
            if (KN & 16) { pg8::Gemm g{(const bf16_t*)(F.ws + WS_R + R_UX), (const bf16_t*)(F.ws + WS_S5TAB + (size_t)j * SZ_S5TAB + MIX_AM), UXW, UXW, UXW}; pg8::GroupOrder S{F.G, (int)blockIdx.x};
              EpiS5Out E{(bf16_t*)(F.ws + WS_R + R_Y), (const bf16_t*)(F.ws + WS_R + R_UX), F.in[8] + (size_t)j * D_MODEL}; pg8::gemm_phase(ring, F.wave, g, S, E); }
            GRID_BAR(); EMU_STOP(5);
            if (KN & 32) { pg8::Gemm g{(const bf16_t*)(F.ws + WS_R + R_Y), (const bf16_t*)(F.ws + WS_WGLU + j * SZ_WGLU), D_MODEL, D_MODEL, D_MODEL}; pg8::StaticOrder S; S.init(SEQ, 2 * D_MODEL, F.G, (int)blockIdx.x);
              EpiRes<true> E{XIN, F.out, XB, rs_ffn}; pg8::gemm_phase(ring, F.wave, g, S, E); }
            GRID_BAR();
        } else {
            if (KN & 64) { pg8::Gemm g{XB, (const bf16_t*)(F.ws + WS_WIN + j * SZ_WIN), D_MODEL, D_MODEL, D_MODEL}; pg8::StaticOrder S; S.init(SEQ, NIN_PAD, F.G, (int)blockIdx.x);
              EpiInProj E{(bf16_t*)(F.ws + WS_R + R_Q), (bf16_t*)(F.ws + WS_R + R_K), (bf16_t*)(F.ws + WS_R + R_V), (bf16_t*)(F.ws + WS_MIX + MIX_QI), (bf16_t*)(F.ws + WS_MIX + MIX_KI), (float*)(F.ws + WS_MIX + MIX_WI),
                          rs_mix, (const float*)(F.ws + WS_ROPE), F.in[11] + (size_t)j * 64, F.in[12] + (size_t)j * 64};
              pg8::gemm_phase(ring, F.wave, g, S, E); }
            GRID_BAR(); EMU_STOP(7);
            if (KN & 128) indexer_phase(F);
            GRID_BAR(); EMU_STOP(8);
            if (KN & 256) attn_phase(F);
            GRID_BAR(); EMU_STOP(9);
            if (KN & 512) { pg8::Gemm g{(const bf16_t*)(F.ws + WS_R + R_Q), (const bf16_t*)(F.ws + WS_WO + j * SZ_WO), D_MODEL, D_MODEL, D_MODEL}; pg8::StaticOrder S; S.init(SEQ, D_MODEL, F.G, (int)blockIdx.x);
              EpiRes<false> E{F.out, F.out, XB, rs_ffn}; pg8::gemm_phase(ring, F.wave, g, S, E); }
            GRID_BAR();
        }
        EMU_SNAPSHOT();
        if (KN & 1024) { pg8::Gemm g{XB, (const bf16_t*)(F.ws + WS_WGU + layer * SZ_WGU), D_MODEL, D_MODEL, D_MODEL}; pg8::StaticOrder S; S.init(SEQ, 2 * D_FF, F.G, (int)blockIdx.x);
          EpiSwiGLU E{(bf16_t*)(F.ws + WS_R + R_ACT), rs_ffn}; pg8::gemm_phase(ring, F.wave, g, S, E); }
        GRID_BAR();
        if (KN & 2048) { pg8::Gemm g{(const bf16_t*)(F.ws + WS_R + R_ACT), (const bf16_t*)(F.ws + WS_WDN + layer * SZ_WDN), D_FF, D_FF, D_FF}; pg8::StaticOrder S; S.init(SEQ, D_MODEL, F.G, (int)blockIdx.x);
          EpiRes<false> E{F.out, F.out, XB, rs_next}; pg8::gemm_phase(ring, F.wave, g, S, E); }
        if (opaque_s(layer) + 1 < DEPTH) GRID_BAR();
#ifdef EMU
        else GRID_BAR();
        EMU_SNAPSHOT();
#endif
    }
}

#ifndef EMU
extern "C" void kernel_launch(void* const* d_in, const int* in_sizes, int n_in, void* d_out, int out_size, void* d_ws, size_t ws_size, hipStream_t stream) {
    static int grid = 0;
    if (grid == 0) {
        if (n_in != 18 || out_size != SEQ * D_MODEL || ws_size < WS_END) { fprintf(stderr, "kernel_launch: unexpected shapes (n_in %d out %d ws %zu need %zu)\n", n_in, out_size, ws_size, (size_t)WS_END); grid = -1; return; }
        int dev = 0, cus = 0, per_cu = 0;
        hipGetDevice(&dev); hipDeviceGetAttribute(&cus, hipDeviceAttributeMultiprocessorCount, dev);
        hipFuncSetAttribute((const void*)mega_fwd, hipFuncAttributeMaxDynamicSharedMemorySize, LDS_BYTES);
        hipOccupancyMaxActiveBlocksPerMultiprocessor(&per_cu, (const void*)mega_fwd, NTHREADS, LDS_BYTES);
        if (per_cu < 1) { fprintf(stderr, "kernel_launch: occupancy query says %d blocks/CU\n", per_cu); grid = -1; return; }
        grid = cus;
        (void)hipGetLastError();
    }
    if (grid < 0) return;
    hipMemsetAsync((char*)d_ws + WS_CTL, 0, CTL_BYTES, stream);
    Args a{};
    for (int i = 0; i < 18; ++i) a.in[i] = (const float*)d_in[i];
    a.out = (float*)d_out; a.ws = (unsigned char*)d_ws;
    void* params[] = {&a};
    hipError_t e = hipLaunchCooperativeKernel((const void*)mega_fwd, dim3(grid), dim3(NTHREADS), params, LDS_BYTES, stream);
    if (e != hipSuccess) fprintf(stderr, "cooperative launch failed: %s (grid %d)\n", hipGetErrorString(e), grid);
}
#endif
```

```cpp
#ifndef EMU
#include <hip/hip_runtime.h>
#include <hip/hip_cooperative_groups.h>
#include <cstdio>
#include <cstdint>
#include <cmath>
#endif

#ifdef CFG_SMALL
constexpr int D_MODEL = 256, SEQ = 4096, DEPTH = 2, N_HEADS = 4;
#else
constexpr int D_MODEL = 1024, SEQ = 16384, DEPTH = 4, N_HEADS = 16;
#endif
constexpr int S5_GROUPS = D_MODEL / 16, S5_STATE = 64, HEAD_DIM = 64, IDX_HEADS = 8, TOPK = 256;
constexpr int D_FF = ((8 * D_MODEL / 3 + 255) / 256) * 256;
constexpr int N_S5 = (DEPTH + 1) / 2, N_DSA = DEPTH / 2;
constexpr int DSA_PROJ = 3 * D_MODEL + 512 + 64 + 8;
constexpr int NH4 = D_MODEL / 256;
constexpr int NIN_TILES = 3 * NH4 + 3, NIN_PAD = NIN_TILES * 256;
constexpr int NCH = SEQ / 16, NCHT = NCH / 256;
constexpr int UXW = 384;
constexpr int NSEG = 16, SEGL = NCH / NSEG;
constexpr float EPS = 1e-6f;
constexpr float C2 = 0.125f * 1.4426950408889634f;
constexpr int NWAVES = 8, NTHREADS = 512;
constexpr int NB = 512; constexpr float BIN_SCALE = 32.f, BIN_MAGIC = 8388608.f;
constexpr int CAND_CAP = 256;

constexpr size_t MiB = 1u << 20;
constexpr size_t WS_CTL = 0, CTL_BYTES = 3 * MiB;
constexpr size_t WS_ROWSS = 1 * MiB;
constexpr size_t SZ_WGLU = (size_t)2 * D_MODEL * D_MODEL * 2, SZ_WIN = (size_t)NIN_PAD * D_MODEL * 2, SZ_WO = (size_t)D_MODEL * D_MODEL * 2,
                 SZ_WGU = (size_t)2 * D_FF * D_MODEL * 2, SZ_WDN = (size_t)D_MODEL * D_FF * 2;
constexpr size_t WS_WGLU = CTL_BYTES, WS_WIN = WS_WGLU + N_S5 * SZ_WGLU, WS_WO = WS_WIN + N_DSA * SZ_WIN, WS_WGU = WS_WO + N_DSA * SZ_WO,
                 WS_WDN = WS_WGU + DEPTH * SZ_WGU, WS_ROPE = WS_WDN + DEPTH * SZ_WDN;
constexpr size_t SZ_ROPE = (size_t)SEQ * 64 * 4;
constexpr size_t S5PRE_STRIDE = 18432;
constexpr size_t WS_S5PRE = WS_ROPE + SZ_ROPE, SZ_S5PRE = (size_t)N_S5 * S5_GROUPS * S5PRE_STRIDE;
constexpr size_t WS_MIX = WS_S5PRE + SZ_S5PRE;
constexpr size_t SZ_AM = (size_t)S5_GROUPS * 256 * UXW * 2, SZ_W1 = (size_t)S5_GROUPS * 256 * 256 * 2, SZ_APOW = (size_t)S5_GROUPS * 64 * 16;
constexpr size_t MIX_AM = 0, MIX_W1 = MIX_AM + SZ_AM;
constexpr size_t MIX_QI = 0, SZ_QI = (size_t)SEQ * 512 * 2, MIX_KI = MIX_QI + SZ_QI, SZ_KI = (size_t)SEQ * 64 * 2, MIX_WI = MIX_KI + SZ_KI, SZ_WI = (size_t)SEQ * 8 * 4;
constexpr size_t SZ_S5TAB = MIX_W1 + SZ_W1, SZ_MIX_DSA = MIX_WI + SZ_WI;
constexpr size_t SZ_MIX = (SZ_MIX_DSA + 4095) / 4096 * 4096;
constexpr size_t WS_XB = WS_MIX + SZ_MIX, SZ_XB = (size_t)SEQ * D_MODEL * 2;
constexpr size_t SZ_MASK = (size_t)(SEQ / 32) * SEQ * 4;
constexpr size_t SZ_XBM = SZ_XB > SZ_MASK ? SZ_XB : SZ_MASK;
constexpr size_t WS_R = WS_XB + SZ_XBM;
constexpr size_t R_Q = 0, R_K = SZ_XB, R_V = 2 * SZ_XB;
constexpr size_t R_ACT = 0, SZ_ACT = (size_t)SEQ * D_FF * 2;
constexpr size_t R_UX = 0, SZ_UX = (size_t)S5_GROUPS * NCH * UXW * 2, R_S = ((SZ_UX + 4095) / 4096) * 4096, SZ_S = (size_t)S5_GROUPS * NCH * 128 * 4, R_Y = R_S;
constexpr size_t SZ_R0 = 3 * SZ_XB > SZ_ACT ? 3 * SZ_XB : SZ_ACT, SZ_R1 = R_S + SZ_S, SZ_R = SZ_R0 > SZ_R1 ? SZ_R0 : SZ_R1;
constexpr size_t WS_S5TAB = ((WS_R + SZ_R + 4095) / 4096) * 4096;
constexpr size_t WS_END = WS_S5TAB + N_S5 * SZ_S5TAB;
static_assert(SZ_S >= (size_t)SEQ * D_MODEL * 2, "Y fits over S");
static_assert(SEQ <= 16384, "candidate packing holds 14-bit keys");
static_assert((2 * DEPTH + 1) * (size_t)SEQ * 8 <= 2 * MiB, "rowss arrays fit");
typedef unsigned long long u64;
constexpr float SS_FIX = 1048576.0f, SS_INV = 1.0f / 1048576.0f;

typedef unsigned short bf16_t;
typedef short bf16x8 __attribute__((ext_vector_type(8)));
typedef float f32x4 __attribute__((ext_vector_type(4)));
typedef float f32x16 __attribute__((ext_vector_type(16)));
typedef unsigned u32x4 __attribute__((ext_vector_type(4)));
typedef unsigned u32x2 __attribute__((ext_vector_type(2)));
typedef short s16x4 __attribute__((ext_vector_type(4)));
typedef float f32x2 __attribute__((ext_vector_type(2)));

#ifdef EMU
#define LAS
#define GAS
#define MFMA16(a, b, c) emu_mfma16(a, b, c)
#define MFMA32(a, b, c) emu_mfma32(a, b, c)
#define WAIT_V(n)
#define WAIT_L(n) emu::wave_barrier()
#define WAIT_VM0() do {} while (0)
#define S_BARRIER() emu::block_barrier()
#define SCHED_BAR()
#define PIN16(x)
#define PIN1(x)
#define PINS(x)
#define PIN2(x)
#define SETPRIO(x)
#define RFL(x) (x)
#define LANE_ID() ((int)(threadIdx.x & 63))
#define GLDS16B(base, voff, l) emu_glds16((const void*)((const char*)(base) + (voff)), (void*)(l))
#define DS_TR16(p) emu_ds_read_tr16((const void*)(p))
#define EXP2F(x) exp2f(x)
#define RCPF(x) (1.0f / (x))
#define RSQF(x) (1.0f / sqrtf(x))
#define LDS_ATOMIC_ADD(p, v) atomicAdd((unsigned*)(p), (unsigned)(v))
#define LDS_ATOMIC_OR(p, v) atomicOr((unsigned*)(p), (unsigned)(v))
#define INVB(m) ((int)(((m) >> (threadIdx.x & 63)) & 1ull))
#define BALLOT64(p) __ballot(p)
#define WRITELANE64(lo, hi, b, r) do { if ((int)(threadIdx.x & 63) == (r)) { lo = (unsigned)(b); hi = (unsigned)((b) >> 32); } } while (0)
#define MED3F(a, lo, hi) fminf(fmaxf((a), (lo)), (hi))
#define RLX_LOAD(p) (*(p))
#define RLX_STORE(p, v) (*(p) = (v))
#define RLX_ADD(p, v) atomicAdd((unsigned*)(p), (unsigned)(v))
#else
#define LAS __attribute__((address_space(3)))
#define GAS __attribute__((address_space(1)))
#define MFMA16(a, b, c) __builtin_amdgcn_mfma_f32_16x16x32_bf16(a, b, c, 0, 0, 0)
#define MFMA32(a, b, c) __builtin_amdgcn_mfma_f32_32x32x16_bf16(a, b, c, 0, 0, 0)
#define WAIT_V(n) asm volatile("s_waitcnt vmcnt(" #n ")" ::: "memory")
#define WAIT_L(n) asm volatile("s_waitcnt lgkmcnt(" #n ")" ::: "memory")
#define WAIT_VM0() asm volatile("s_waitcnt vmcnt(0)" ::: "memory")
#define S_BARRIER() __builtin_amdgcn_s_barrier()
#define SCHED_BAR() __builtin_amdgcn_sched_barrier(0)
#define PIN16(x) asm volatile("" : "+v"(x))
#define PIN1(x) asm volatile("" : "+v"(x))
#define PINS(x) asm volatile("" : "+s"(x))
#define PIN2(x) asm volatile("" : "+v"(x))
#define SETPRIO(x) __builtin_amdgcn_s_setprio(x)
#define RFL(x) __builtin_amdgcn_readfirstlane(x)
#define LANE_ID() lane_id_now()
__device__ __forceinline__ void glds16b_(const char* base, unsigned voff, unsigned lds_dst) { asm volatile("s_mov_b32 m0, %2\n\ts_nop 0\n\tglobal_load_lds_dwordx4 %0, %1" :: "v"(voff), "s"(base), "s"(lds_dst) : "memory", "m0"); }
#define GLDS16B(base, voff, l) glds16b_((base), (voff), (unsigned)__builtin_amdgcn_readfirstlane((int)(unsigned)(size_t)(l)))
typedef short v4i16_t __attribute__((ext_vector_type(4)));
#define DS_TR16(p) __builtin_bit_cast(s16x4, __builtin_amdgcn_ds_read_tr16_b64_v4i16((LAS v4i16_t*)(p)))
#define EXP2F(x) __builtin_amdgcn_exp2f(x)
#define RCPF(x) __builtin_amdgcn_rcpf(x)
#define RSQF(x) __builtin_amdgcn_rsqf(x)
#define LDS_ATOMIC_ADD(p, v) __hip_atomic_fetch_add((LAS unsigned*)(p), (unsigned)(v), __ATOMIC_RELAXED, __HIP_MEMORY_SCOPE_WORKGROUP)
#define LDS_ATOMIC_OR(p, v) __hip_atomic_fetch_or((LAS unsigned*)(p), (unsigned)(v), __ATOMIC_RELAXED, __HIP_MEMORY_SCOPE_WORKGROUP)
#define INVB(m) __builtin_amdgcn_inverse_ballot_w64(m)
#define BALLOT64(p) __builtin_amdgcn_ballot_w64(p)
#define WRITELANE64(lo, hi, b, r) do { asm("v_writelane_b32 %0, %1, %2" : "+v"(lo) : "s"((unsigned)(b)), "n"(r)); asm("v_writelane_b32 %0, %1, %2" : "+v"(hi) : "s"((unsigned)((b) >> 32)), "n"(r)); } while (0)
#define MED3F(a, lo, hi) __builtin_amdgcn_fmed3f((a), (lo), (hi))
#define RLX_LOAD(p) __hip_atomic_load(p, __ATOMIC_RELAXED, __HIP_MEMORY_SCOPE_AGENT)
#define RLX_STORE(p, v) __hip_atomic_store(p, v, __ATOMIC_RELAXED, __HIP_MEMORY_SCOPE_AGENT)
#define RLX_ADD(p, v) __hip_atomic_fetch_add(p, v, __ATOMIC_RELAXED, __HIP_MEMORY_SCOPE_AGENT)
#endif

__device__ __forceinline__ int opaque(int v) { PIN1(v); return v; }
#ifndef EMU
__device__ __forceinline__ int lane_id_now() { int l; asm volatile("v_mbcnt_lo_u32_b32 %0, -1, 0\n\tv_mbcnt_hi_u32_b32 %0, -1, %0" : "=v"(l)); return l; }
#endif
__device__ __forceinline__ int opaque_s(int v) { PINS(v); return v; }
__device__ __forceinline__ unsigned char* opaque_p(unsigned char* p) { PINS(p); return p; }
#ifdef EMU
__device__ __forceinline__ const char* uni_ptr(const char* p) { return p; }
#else
__device__ __forceinline__ const char* uni_ptr(const char* p) { const unsigned long long v = (unsigned long long)p; const unsigned lo = __builtin_amdgcn_readfirstlane((unsigned)v), hi = __builtin_amdgcn_readfirstlane((unsigned)(v >> 32));
    return (const char*)(((unsigned long long)hi << 32) | lo); }
#endif
__device__ __forceinline__ unsigned f2bf(float f) { unsigned u = __builtin_bit_cast(unsigned, f); return (u + 0x7fffu + ((u >> 16) & 1u)) >> 16; }
__device__ __forceinline__ unsigned pk2(float lo, float hi) { return f2bf(lo) | (f2bf(hi) << 16); }
__device__ __forceinline__ float bf2f(unsigned h) { return __builtin_bit_cast(float, h << 16); }
__device__ __forceinline__ float bflo(unsigned w) { return __builtin_bit_cast(float, w << 16); }
__device__ __forceinline__ float bfhi(unsigned w) { return __builtin_bit_cast(float, w & 0xffff0000u); }
__device__ __forceinline__ float sigmoidf_(float v) { return RCPF(1.0f + EXP2F(-1.4426950408889634f * v)); }
__device__ __forceinline__ float gelu_tanh(float v) { const float z = 0.7978845608028654f * (v + 0.044715f * v * v * v); return v * RCPF(1.0f + EXP2F(-2.885390081777927f * z)); }
__device__ __forceinline__ float row_rs(const u64* rowss, int r) { return RSQF((float)rowss[r] * (SS_INV / D_MODEL) + EPS); }
__device__ __forceinline__ int crow(int r, int hi) { return (r & 3) + 8 * (r >> 2) + 4 * hi; }

#define XB_TMO      128
#define XB_XCNT(j)  (256  + 64 * (j))
#define XB_XSUB(j)  (1280 + 64 * (j))
#define XB_XGEN(j)  (2304 + 64 * (j))
#define XB_TOP      3328
#define XB_TOPGEN   3392
#define XCD_BAR_WORDS 3456
#define XB_SPIN_CAP 0xF0000000u
struct XcdBarrier { unsigned* bar; unsigned x; volatile LAS unsigned* st; };
#ifdef EMU
__device__ __forceinline__ XcdBarrier xcd_barrier_post(unsigned* bar, volatile unsigned* st) { XcdBarrier b; b.bar = bar; b.x = 0; b.st = st; return b; }
__device__ __forceinline__ void xcd_barrier(const XcdBarrier&) { emu::grid_barrier(); }
#else
__device__ __forceinline__ unsigned xb_ld(unsigned* p)              { return __hip_atomic_load(p, __ATOMIC_RELAXED, __HIP_MEMORY_SCOPE_AGENT); }
__device__ __forceinline__ unsigned xb_add(unsigned* p, unsigned v) { return __hip_atomic_fetch_add(p + opaque(0), v, __ATOMIC_RELAXED, __HIP_MEMORY_SCOPE_AGENT); }
__device__ __forceinline__ unsigned xb_xcc_id() { return (unsigned)__builtin_amdgcn_s_getreg((3 << 11) | 20) & 0xFu; }
#define XB_SPIN(cond, bar) do { unsigned _sp = 0; while (cond) { __builtin_amdgcn_s_sleep(1); \
    if ((++_sp & 255u) == 0u) { if (xb_ld(&(bar)[XB_TMO])) break; if (_sp > XB_SPIN_CAP) { atomicAdd(&(bar)[XB_TMO], 1u); break; } } } } while (0)
__device__ __forceinline__ XcdBarrier xcd_barrier_post(unsigned* bar, volatile LAS unsigned* st) {
    XcdBarrier b; b.bar = bar; b.x = (unsigned)__builtin_amdgcn_readfirstlane((int)xb_xcc_id()); b.st = st;
    if (threadIdx.x == 0) (void)xb_add(&bar[XB_XCNT(b.x)], 1u);
    return b;
}
__device__ __forceinline__ void xcd_barrier_complete(unsigned* bar, unsigned x, unsigned& nloc, unsigned& nx) {
    const unsigned G = gridDim.x * gridDim.y * gridDim.z;
    unsigned sum, cnt, mine, sp = 0u;
    for (;;) {
        sum = 0u; cnt = 0u; mine = 0u;
#pragma unroll
        for (unsigned j = 0; j < 16; ++j) { const unsigned c = xb_ld(&bar[XB_XCNT(j)]); sum += c; cnt += (c > 0u) ? 1u : 0u; mine = (j == x) ? c : mine; }
        if (sum == G) break;
        __builtin_amdgcn_s_sleep(1);
        if ((++sp & 255u) == 0u) { if (xb_ld(&bar[XB_TMO])) break; if (sp > XB_SPIN_CAP) { atomicAdd(&bar[XB_TMO], 1u); break; } }
    }
    nloc = mine > 0u ? mine : 1u; nx = cnt > 0u ? cnt : 1u;
}
__device__ __forceinline__ void xcd_barrier(const XcdBarrier& b) {
    asm volatile("s_waitcnt vmcnt(0)" ::: "memory");
    __syncthreads();
    if (threadIdx.x == 0) {
        unsigned* bar = b.bar; const unsigned bx = (unsigned)__builtin_amdgcn_readfirstlane(opaque((int)b.x));
        __builtin_amdgcn_s_waitcnt(0);
        unsigned nloc = b.st[0], nx = b.st[1];
        if (nloc == 0u) { xcd_barrier_complete(bar, bx, nloc, nx); b.st[0] = nloc; b.st[1] = nx; }
        const unsigned old = xb_add(&bar[XB_XSUB(bx)], 1u);
        const unsigned gen = old / nloc;
        if (old + 1u == (gen + 1u) * nloc) {
            __builtin_amdgcn_fence(__ATOMIC_RELEASE, "agent");
            asm volatile("s_waitcnt vmcnt(0)" ::: "memory");
            const unsigned og = xb_add(&bar[XB_TOP], 1u);
            const unsigned tg = og / nx;
            if (og + 1u == (tg + 1u) * nx) xb_add(&bar[XB_TOPGEN], 1u);
            else XB_SPIN(xb_ld(&bar[XB_TOPGEN]) == tg, bar);
            __builtin_amdgcn_fence(__ATOMIC_ACQUIRE, "agent");
            xb_add(&bar[XB_XGEN(bx)], 1u);
            asm volatile("s_waitcnt vmcnt(0)" ::: "memory");
        } else {
            XB_SPIN(xb_ld(&bar[XB_XGEN(bx)]) == gen, bar);
            __builtin_amdgcn_fence(__ATOMIC_ACQUIRE, "agent");
            asm volatile("s_waitcnt vmcnt(0)" ::: "memory");
        }
    }
    __syncthreads();
}
#endif

namespace pg8 {
constexpr int BM = 256, BK = 64, HALF = 128, HTB = HALF * BK * 2, STAGE_BYTES = 8 * HTB, NXCD = 8, WGM = 8;
__host__ __device__ __forceinline__ int lds_byte(int r, int c) { const int st = (r >> 4) * 2 + (c >> 5), rr = r & 15, cc = c & 31, ob = rr * 64 + cc * 2; return st * 1024 + (ob ^ (((ob >> 9) & 1) << 5)); }
__host__ __device__ __forceinline__ void stage_rc(int b, int& R, int& C) { const int st = b / 1024, sb = b % 1024, swz = sb ^ (((sb >> 9) & 1) << 5); R = (st >> 1) * 16 + swz / 64; C = (st & 1) * 32 + (swz % 64) / 2; }
__host__ __device__ __forceinline__ int perm32(int rho) { const int n = rho >> 4, i = rho & 15; return 8 * (i >> 2) + 4 * n + (i & 3); }
struct Unit { int pm, pn; };
struct Gemm { const bf16_t* A; const bf16_t* Bt; int lda, ldb, K; };
struct StaticOrder {
    int nM, nN, nwg, G, c;
    __host__ __device__ void init(int M, int N, int G_, int c_) { nM = M / BM; nN = N / BM; nwg = nM * nN; G = G_; c = c_; }
    __host__ __device__ bool next(int i, Unit& u) const {
        const long L = (long)i * G + c; if (L >= nwg) return false;
        int wgid = (int)L; { const int q = nwg / NXCD, r = nwg % NXCD, xcd = wgid % NXCD, off = wgid / NXCD; wgid = (xcd < r ? xcd * (q + 1) : r * (q + 1) + (xcd - r) * q) + off; }
        const int nig = WGM * nN, gid = wgid / nig, fm = gid * WGM, gsz = (nM - fm) < WGM ? (nM - fm) : WGM;
        u.pm = fm + ((wgid % nig) % gsz); u.pn = (wgid % nig) / gsz; return true;
    }
};
struct GroupOrder {
    int G, c;
    __host__ __device__ bool next(int i, Unit& u) const { const int idx = i * G + c; if (idx >= S5_GROUPS * NCHT) return false; const int g = idx / NCHT; u.pm = idx; u.pn = g; return true; }
};

template <class Epi, class Sched>
__device__ __forceinline__ void gemm_phase(LAS unsigned char* lds, const int wave_id, const Gemm g, const Sched& S, const Epi& E) {
    const int lane = LANE_ID(), wid = opaque_s(wave_id), tid = wid * 64 + lane, wr = wid >> 2, wc = wid & 3, fr = lane & 15, fq = lane >> 4;
    const int K = g.K, nt = K / BK;
    unsigned voffA[2], voffB[2];
#pragma unroll
    for (int i = 0; i < 2; ++i) { int R, C; stage_rc(tid * 16 + i * 8192, R, C); const int Rb = Epi::PERM ? ((R & ~31) + perm32(R & 31)) : R;
        voffA[i] = (unsigned)(R * g.lda + C) * 2u; voffB[i] = (unsigned)(Rb * g.ldb + C) * 2u; }
    const size_t kstep = (size_t)(BK * 2);
    const size_t hstepA = (size_t)HALF * g.lda * 2, hstepB = (size_t)HALF * g.ldb * 2;
    const size_t tstepA = 2 * hstepA, tstepB = 2 * hstepB;
    const unsigned ldsw = (unsigned)wid * 1024u;
    const int aoff = lds_byte(wr * 64 + fr, fq * 8), boff = lds_byte(wc * 32 + fr, fq * 8);
#define PG8_SA(b, h) (((b) * 2 + (h)) * HTB)
#define PG8_SB(b, h) ((4 + (b) * 2 + (h)) * HTB)
#define PG8_STAGE(bufoff, gbase, voff) do { const char* _gb = uni_ptr((const char*)(gbase));     \
    _Pragma("unroll") for (int _i = 0; _i < 2; ++_i) \
        GLDS16B(_gb, (voff)[_i], lds + (bufoff) + ldsw + _i * 8192); } while (0)
#define PG8_LDA(dst, b, h) do { _Pragma("unroll") for (int m = 0; m < 4; ++m) _Pragma("unroll") for (int k = 0; k < 2; ++k) dst[m][k] = *(const LAS bf16x8*)(lds + PG8_SA(b, h) + aoff + m * 2048 + k * 1024); } while (0)
#define PG8_LDB(dst, b, h) do { _Pragma("unroll") for (int n = 0; n < 2; ++n) _Pragma("unroll") for (int k = 0; k < 2; ++k) dst[n][k] = *(const LAS bf16x8*)(lds + PG8_SB(b, h) + boff + n * 2048 + k * 1024); } while (0)
#define PG8_MMA(ai, bj, At, Bt) do { SETPRIO(1); _Pragma("unroll") for (int m = 0; m < 4; ++m) _Pragma("unroll") for (int n = 0; n < 2; ++n) _Pragma("unroll") for (int k = 0; k < 2; ++k) \
        acc[ai][bj][m][n] = MFMA16(Bt[n][k], At[m][k], acc[ai][bj][m][n]); SETPRIO(0); } while (0)
#define PG8_BAR S_BARRIER()
    Unit cur, nxt; int ui = 0;
    if (!S.next(0, cur)) return;
    f32x4 acc[2][2][4][2];
#pragma unroll
    for (int a = 0; a < 2; ++a)
#pragma unroll
        for (int b = 0; b < 2; ++b)
#pragma unroll
            for (int m = 0; m < 4; ++m)
#pragma unroll
                for (int n = 0; n < 2; ++n) acc[a][b][m][n] = (f32x4){0.f, 0.f, 0.f, 0.f};
    bf16x8 At[4][2], B0[2][2], B1[2][2];
    const char* cA = (const char*)g.A + (size_t)cur.pm * tstepA; const char* cB = (const char*)g.Bt + (size_t)cur.pn * tstepB;
    PG8_STAGE(PG8_SB(0, 0), cB, voffB); PG8_STAGE(PG8_SB(0, 1), cB + hstepB, voffB); PG8_STAGE(PG8_SA(0, 0), cA, voffA); PG8_STAGE(PG8_SA(0, 1), cA + hstepA, voffA);
    if (wr == 1) PG8_BAR;
    WAIT_V(2); PG8_BAR;
    PG8_STAGE(PG8_SB(1, 0), cB + kstep, voffB); PG8_STAGE(PG8_SA(1, 0), cA + kstep, voffA); PG8_STAGE(PG8_SB(1, 1), cB + hstepB + kstep, voffB);
    WAIT_V(6); PG8_BAR;
    for (;;) {
        const bool has_next = S.next(ui + 1, nxt);
        const char* nA = has_next ? (const char*)g.A + (size_t)nxt.pm * tstepA : cA; const char* nB = has_next ? (const char*)g.Bt + (size_t)nxt.pn * tstepB : cB;
        for (int t = 0; t < nt; t += 2) {
            const bool last = (t == nt - 2);
            const char* a1 = cA + (size_t)(t + 1) * kstep;
            const char* a2 = last ? nA : cA + (size_t)(t + 2) * kstep; const char* b2 = last ? nB : cB + (size_t)(t + 2) * kstep;
            const char* a3 = a2 + kstep; const char* b3 = b2 + kstep;
            PG8_LDB(B0, 0, 0); PG8_LDB(B1, 0, 1); SCHED_BAR(); PG8_LDA(At, 0, 0); PG8_STAGE(PG8_SA(1, 1), a1 + hstepA, voffA);
            WAIT_V(8); WAIT_L(0); PG8_BAR; PG8_MMA(0, 0, At, B0); PG8_MMA(0, 1, At, B1); PG8_BAR; SCHED_BAR();
            PG8_LDA(At, 0, 1); PG8_STAGE(PG8_SB(0, 0), b2, voffB); PG8_STAGE(PG8_SB(0, 1), b2 + hstepB, voffB); PG8_STAGE(PG8_SA(0, 0), a2, voffA);
            WAIT_V(8); WAIT_L(0); PG8_BAR; PG8_MMA(1, 0, At, B0); PG8_MMA(1, 1, At, B1); PG8_BAR; SCHED_BAR();
            PG8_LDB(B0, 1, 0); PG8_LDB(B1, 1, 1); SCHED_BAR(); PG8_LDA(At, 1, 0); PG8_STAGE(PG8_SA(0, 1), a2 + hstepA, voffA);
            WAIT_V(8); WAIT_L(0); PG8_BAR; PG8_MMA(0, 0, At, B0); PG8_MMA(0, 1, At, B1); PG8_BAR; SCHED_BAR();
            PG8_LDA(At, 1, 1); PG8_STAGE(PG8_SB(1, 0), b3, voffB); PG8_STAGE(PG8_SB(1, 1), b3 + hstepB, voffB); PG8_STAGE(PG8_SA(1, 0), a3, voffA);
            WAIT_V(8); WAIT_L(0); PG8_BAR; PG8_MMA(1, 0, At, B0); PG8_MMA(1, 1, At, B1); PG8_BAR; SCHED_BAR();
        }
        if (wr == 0) PG8_BAR;
        { const int le = LANE_ID(); E(acc, cur, wr, wc, le & 15, le >> 4); }
        if (!has_next) break;
#pragma unroll
        for (int a = 0; a < 2; ++a)
#pragma unroll
            for (int b = 0; b < 2; ++b)
#pragma unroll
                for (int m = 0; m < 4; ++m)
#pragma unroll
                    for (int n = 0; n < 2; ++n) acc[a][b][m][n] = (f32x4){0.f, 0.f, 0.f, 0.f};
        cur = nxt; cA = nA; cB = nB; ++ui;
        if (wr == 1) PG8_BAR;
    }
    WAIT_V(0);
    PG8_BAR;
#undef PG8_SA
#undef PG8_SB
#undef PG8_STAGE
#undef PG8_LDA
#undef PG8_LDB
#undef PG8_MMA
#undef PG8_BAR
}
}
using pg8::Unit;

#ifdef EMU
#define SHFL_XOR_F(v, m) __shfl_xor(v, m)
#define SHFL_IDX_U(v, i) __shfl(v, i)
__device__ __forceinline__ float sum_x16(float s) { return s + __shfl_xor(s, 16); }
__device__ __forceinline__ float sum_x32(float s) { return s + __shfl_xor(s, 32); }
#else
#define SHFL_XOR_F(v, m) __builtin_bit_cast(float, __builtin_amdgcn_ds_swizzle(__builtin_bit_cast(int, (float)(v)), (((m) << 10) | 0x1F)))
#define SHFL_IDX_U(v, i) ((unsigned)__builtin_amdgcn_ds_bpermute((i) << 2, (int)(v)))
__device__ __forceinline__ float sum_x16(float s) { float a = s, b = s; asm("s_nop 1\n\tv_permlane16_swap_b32 %0, %1" : "+v"(a), "+v"(b)); return a + b; }
__device__ __forceinline__ float sum_x32(float s) { float a = s, b = s; asm("s_nop 1\n\tv_permlane32_swap_b32 %0, %1" : "+v"(a), "+v"(b)); return a + b; }
#endif
__device__ __forceinline__ float quad_sum(float s) { return sum_x32(sum_x16(s)); }

template <bool GLU> struct EpiRes {
    static constexpr bool PERM = true;
    const float* xin; float* xout; bf16_t* xb; u64* rowss;
    __device__ __forceinline__ void operator()(const f32x4 (&acc)[2][2][4][2], const Unit& u, int wr, int wc, int fr, int fq) const {
        PIN1(fr); PIN1(fq);
        constexpr int NB = GLU ? 1 : 2;
#pragma unroll
        for (int ai = 0; ai < 2; ++ai) {
            f32x4 xo[4][NB][2];
#pragma unroll
            for (int m = 0; m < 4; ++m) { const int r = u.pm * 256 + ai * 128 + wr * 64 + m * 16 + fr;
#pragma unroll
                for (int bj = 0; bj < NB; ++bj) { const size_t off = (size_t)r * D_MODEL + (GLU ? u.pn * 128 : u.pn * 256 + bj * 128) + wc * 32 + 8 * fq;
                    xo[m][bj][0] = *(const f32x4*)(xin + off); xo[m][bj][1] = *(const f32x4*)(xin + off + 4); } }
#pragma unroll
            for (int m = 0; m < 4; ++m) { const int r = u.pm * 256 + ai * 128 + wr * 64 + m * 16 + fr; float ss = 0.f;
#pragma unroll
                for (int bj = 0; bj < NB; ++bj) { const size_t off = (size_t)r * D_MODEL + (GLU ? u.pn * 128 : u.pn * 256 + bj * 128) + wc * 32 + 8 * fq; f32x4 o[2];
#pragma unroll
                    for (int n = 0; n < 2; ++n) {
#pragma unroll
                        for (int i = 0; i < 4; ++i) { const float t = xo[m][bj][n][i] + (GLU ? acc[ai][0][m][n][i] * sigmoidf_(acc[ai][1][m][n][i]) : acc[ai][bj][m][n][i]); o[n][i] = t; ss += t * t; }
                        *(f32x4*)(xout + off + 4 * n) = o[n]; }
                    u32x4 w; w.x = pk2(o[0][0], o[0][1]); w.y = pk2(o[0][2], o[0][3]); w.z = pk2(o[1][0], o[1][1]); w.w = pk2(o[1][2], o[1][3]);
                    *(u32x4*)(xb + off) = w; }
                ss = quad_sum(ss);
                if (fq == 0) atomicAdd(rowss + r, (u64)(ss * SS_FIX)); }
        }
    }
};
struct EpiSwiGLU {
    static constexpr bool PERM = true;
    bf16_t* act; const u64* rowss;
    __device__ __forceinline__ void operator()(const f32x4 (&acc)[2][2][4][2], const Unit& u, int wr, int wc, int fr, int fq) const {
        PIN1(fr); PIN1(fq);
        float rsv[2][4];
#pragma unroll
        for (int ai = 0; ai < 2; ++ai)
#pragma unroll
            for (int m = 0; m < 4; ++m) rsv[ai][m] = row_rs(rowss, u.pm * 256 + ai * 128 + wr * 64 + m * 16 + fr);
#pragma unroll
        for (int ai = 0; ai < 2; ++ai)
#pragma unroll
            for (int m = 0; m < 4; ++m) {
                const int r = u.pm * 256 + ai * 128 + wr * 64 + m * 16 + fr; const float rs = rsv[ai][m];
                float o[8];
#pragma unroll
                for (int n = 0; n < 2; ++n)
#pragma unroll
                    for (int i = 0; i < 4; ++i) { const float gt = rs * acc[ai][0][m][n][i], up = rs * acc[ai][1][m][n][i]; o[4 * n + i] = gt * sigmoidf_(gt) * up; }
                u32x4 w; w.x = pk2(o[0], o[1]); w.y = pk2(o[2], o[3]); w.z = pk2(o[4], o[5]); w.w = pk2(o[6], o[7]);
                *(u32x4*)(act + (size_t)r * D_FF + u.pn * 128 + wc * 32 + 8 * fq) = w;
            }
    }
};
struct EpiInProj {
    static constexpr bool PERM = true;
    bf16_t *Q, *Kb, *V, *QI, *KI; float* WI; const u64* rowss; const float* rope; const float* qg; const float* kg;
    __device__ __forceinline__ void operator()(const f32x4 (&acc)[2][2][4][2], const Unit& u, int wr, int wc, int fr, int fq) const {
        PIN1(fr); PIN1(fq);
        const int pn = u.pn;
#pragma unroll
        for (int ai = 0; ai < 2; ++ai)
#pragma unroll
            for (int m = 0; m < 4; ++m) {
                const int r = u.pm * 256 + ai * 128 + wr * 64 + m * 16 + fr; const float rs = row_rs(rowss, r);
                float t1[8], t2[8];
#pragma unroll
                for (int n = 0; n < 2; ++n)
#pragma unroll
                    for (int i = 0; i < 4; ++i) { t1[4 * n + i] = rs * acc[ai][0][m][n][i]; t2[4 * n + i] = rs * acc[ai][1][m][n][i]; }
                if (pn >= 2 * NH4 && pn < 3 * NH4) {
                    const size_t off = (size_t)r * D_MODEL + (pn - 2 * NH4) * 256 + wc * 32 + 8 * fq;
                    u32x4 w; w.x = pk2(t1[0], t1[1]); w.y = pk2(t1[2], t1[3]); w.z = pk2(t1[4], t1[5]); w.w = pk2(t1[6], t1[7]); *(u32x4*)(V + off) = w;
                    w.x = pk2(t2[0], t2[1]); w.y = pk2(t2[2], t2[3]); w.z = pk2(t2[4], t2[5]); w.w = pk2(t2[6], t2[7]); *(u32x4*)(V + off + 128) = w;
                    continue;
                }
                const bool last = (pn == 3 * NH4 + 2);
                if (last && wc == 1) { if (fq == 0) { const float sc = 0.35355339059327373f * 0.125f;
                        *(f32x4*)(WI + (size_t)r * 8) = (f32x4){t1[0] * sc, t1[1] * sc, t1[2] * sc, t1[3] * sc}; *(f32x4*)(WI + (size_t)r * 8 + 4) = (f32x4){t1[4] * sc, t1[5] * sc, t1[6] * sc, t1[7] * sc}; }
                    continue; }
                if (last && wc != 0) continue;
                const bool isq = pn < NH4, isk = (pn >= NH4 && pn < 2 * NH4);
                if (isq || isk || last) {
                    float ss = 0.f;
#pragma unroll
                    for (int i = 0; i < 8; ++i) ss += t1[i] * t1[i] + t2[i] * t2[i];
                    ss = quad_sum(ss); const float rn = RSQF(ss * (1.0f / 64.0f) + EPS);
                    const float* gn = isq ? qg : kg;
#pragma unroll
                    for (int i = 0; i < 8; ++i) { const float g1 = last ? 1.0f : gn[8 * fq + i], g2 = last ? 1.0f : gn[32 + 8 * fq + i]; t1[i] *= rn * g1; t2[i] *= rn * g2; }
                }
                const float* cs = rope + (size_t)r * 64 + 8 * fq; float o1[8], o2[8]; const float qs = isq ? C2 : 1.0f;
#pragma unroll
                for (int i = 0; i < 8; ++i) { const float c = cs[i], s = cs[32 + i]; o1[i] = (t1[i] * c - t2[i] * s) * qs; o2[i] = (t2[i] * c + t1[i] * s) * qs; }
                bf16_t* dst;
                if (isq) dst = Q + (size_t)r * D_MODEL + (pn * 4 + wc) * 64; else if (isk) dst = Kb + (size_t)r * D_MODEL + ((pn - NH4) * 4 + wc) * 64;
                else if (last) dst = KI + (size_t)r * 64; else dst = QI + (size_t)r * 512 + ((pn - 3 * NH4) * 4 + wc) * 64;
                u32x4 w; w.x = pk2(o1[0], o1[1]); w.y = pk2(o1[2], o1[3]); w.z = pk2(o1[4], o1[5]); w.w = pk2(o1[6], o1[7]); *(u32x4*)(dst + 8 * fq) = w;
                w.x = pk2(o2[0], o2[1]); w.y = pk2(o2[2], o2[3]); w.z = pk2(o2[4], o2[5]); w.w = pk2(o2[6], o2[7]); *(u32x4*)(dst + 32 + 8 * fq) = w;
            }
    }
};
struct EpiS5State {
    static constexpr bool PERM = true;
    float* S;
    __device__ __forceinline__ void operator()(const f32x4 (&acc)[2][2][4][2], const Unit& u, int wr, int wc, int fr, int fq) const {
        PIN1(fr); PIN1(fq);
#pragma unroll
        for (int ai = 0; ai < 2; ++ai)
#pragma unroll
            for (int m = 0; m < 4; ++m) { const size_t row = (size_t)u.pm * 256 + ai * 128 + wr * 64 + m * 16 + fr;
                float* p = S + row * 128 + wc * 32 + 8 * fq; *(f32x4*)p = acc[ai][0][m][0]; *(f32x4*)(p + 4) = acc[ai][0][m][1]; }
    }
};
struct EpiS5Out {
    static constexpr bool PERM = true;
    bf16_t* Y; const bf16_t* UX; const float* dskip;
    __device__ __forceinline__ void operator()(const f32x4 (&acc)[2][2][4][2], const Unit& u, int wr, int wc, int fr, int fq) const {
        PIN1(fr); PIN1(fq);
        const int g = u.pn;
        float dk[8];
        { const float* dp = dskip + 16 * g + ((wc * 32 + 8 * fq) & 15);
#pragma unroll
          for (int e = 0; e < 8; ++e) dk[e] = dp[e]; }
#pragma unroll
        for (int ai = 0; ai < 2; ++ai)
#pragma unroll
            for (int mp = 0; mp < 2; ++mp) {
                u32x4 uw[2][2];
#pragma unroll
                for (int mm = 0; mm < 2; ++mm) { const size_t row = (size_t)u.pm * 256 + ai * 128 + wr * 64 + (2 * mp + mm) * 16 + fr;
#pragma unroll
                    for (int bj = 0; bj < 2; ++bj) uw[mm][bj] = *(const u32x4*)(UX + row * UXW + bj * 128 + wc * 32 + 8 * fq); }
#pragma unroll
                for (int mm = 0; mm < 2; ++mm) { const int m = 2 * mp + mm; const size_t row = (size_t)u.pm * 256 + ai * 128 + wr * 64 + m * 16 + fr; const int c = (int)(row - (size_t)g * NCH);
#pragma unroll
                    for (int bj = 0; bj < 2; ++bj) { const int col = bj * 128 + wc * 32 + 8 * fq, i = col >> 4, ho = col & 15;
                        float o[8]; const unsigned uu[4] = {uw[mm][bj].x, uw[mm][bj].y, uw[mm][bj].z, uw[mm][bj].w};
#pragma unroll
                        for (int n = 0; n < 2; ++n)
#pragma unroll
                            for (int j = 0; j < 4; ++j) { const int e = 4 * n + j; const float uv = (e & 1) ? bfhi(uu[e >> 1]) : bflo(uu[e >> 1]); o[e] = gelu_tanh(acc[ai][bj][m][n][j] + dk[e] * uv); }
                        u32x4 w; w.x = pk2(o[0], o[1]); w.y = pk2(o[2], o[3]); w.z = pk2(o[4], o[5]); w.w = pk2(o[6], o[7]);
                        *(u32x4*)(Y + (size_t)(16 * c + i) * D_MODEL + 16 * g + ho) = w; } }
            }
    }
};

constexpr int RING_BYTES = 131072, LDSCTL_OFF = RING_BYTES, LDS_BYTES = 147456;
struct Args { const float* in[18]; float* out; unsigned char* ws; };
struct Frame {
    LAS unsigned char* lds; int tid, lane, wave, vcu, G;
    const float* in[18]; float* out; unsigned char* ws;
};
__device__ __forceinline__ float wave_sum(float v) {
    v += SHFL_XOR_F(v, 1); v += SHFL_XOR_F(v, 2); v += SHFL_XOR_F(v, 4); v += SHFL_XOR_F(v, 8); v += SHFL_XOR_F(v, 16);
    return sum_x32(v);
}
__device__ __forceinline__ int win_src(int np) {
    const int pn = np >> 8, y = np & 255, bj = y >> 7, hh = (y >> 5) & 3, dd = y & 31;
    if (pn < 2 * NH4) { const int base = pn < NH4 ? 0 : D_MODEL, t = pn < NH4 ? pn : pn - NH4; return base + (4 * t + hh) * 64 + 32 * bj + dd; }
    if (pn < 3 * NH4) return np;
    if (pn < 3 * NH4 + 2) return 3 * D_MODEL + (4 * (pn - 3 * NH4) + hh) * 64 + 32 * bj + dd;
    if (hh == 0) return 3 * D_MODEL + 512 + 32 * bj + dd;
    if (hh == 1 && bj == 0 && dd < 8) return 3 * D_MODEL + 512 + 64 + dd;
    return -1;
}
__device__ __forceinline__ int glu_src(int np, int HW) { const int pn = np >> 8, y = np & 255; return (y >> 7) * HW + pn * 128 + (y & 127); }

template <int MODE> __device__ __forceinline__ void transpose_item(const float* W, int K, int N, int HW, const float* gain, bf16_t* WT, LAS float* scr, int item, int NP, int lane) {
    const int nblk = NP / 32, kb = item / nblk, nb = item % nblk, k0 = 64 * kb, n0 = 32 * nb;
    const int np = n0 + (lane & 31); const int src = MODE == 0 ? np : (MODE == 1 ? glu_src(np, HW) : win_src(np));
    float v[32];
#pragma unroll
    for (int i = 0; i < 32; ++i) { const int kk = 2 * i + (lane >> 5); v[i] = (src >= 0) ? W[(size_t)(k0 + kk) * N + src] : 0.f; }
    if (gain) {
#pragma unroll
        for (int i = 0; i < 32; ++i) v[i] *= gain[k0 + 2 * i + (lane >> 5)]; }
#pragma unroll
    for (int i = 0; i < 32; ++i) scr[(2 * i + (lane >> 5)) * 33 + (lane & 31)] = v[i];
    WAIT_L(0);
    const int c = lane & 7;
#pragma unroll
    for (int j = 0; j < 4; ++j) { const int n = (lane >> 3) + 8 * j; const LAS float* s = scr + (8 * c) * 33 + n;
        u32x4 o; o.x = pk2(s[0 * 33], s[1 * 33]); o.y = pk2(s[2 * 33], s[3 * 33]); o.z = pk2(s[4 * 33], s[5 * 33]); o.w = pk2(s[6 * 33], s[7 * 33]);
        *(u32x4*)(WT + (size_t)(n0 + n) * K + k0 + 8 * c) = o; }
    WAIT_L(0);
}

__device__ __forceinline__ void s5_pre(Frame& F0) {
    Frame F = F0; F.lane = LANE_ID(); F.tid = F0.wave * 64 + F.lane;
    for (int jg = blockIdx.x; jg < N_S5 * S5_GROUPS; jg += F.G) {
        const float* lre = F.in[1] + (size_t)jg * 64; const float* lim = F.in[2] + (size_t)jg * 64; const float* bre = F.in[4] + (size_t)jg * 1024; const float* bim = F.in[5] + (size_t)jg * 1024;
        float* pre = (float*)(F.ws + WS_S5PRE + (size_t)jg * S5PRE_STRIDE);
        const double dt = exp((double)F.in[3][jg]);
        for (int e = F.tid; e < 18 * 64; e += NTHREADS) { const int tau = e >> 6, p = e & 63; const double zr = (double)lre[p] * dt * tau, zi = (double)lim[p] * dt * tau, m = exp(zr);
            pre[e * 2] = (float)(m * cos(zi)); pre[e * 2 + 1] = (float)(m * sin(zi)); }
        for (int e = F.tid; e < 1024; e += NTHREADS) { const int p = e >> 4; const double lr = lre[p], li = lim[p], m = exp(lr * dt), ar = m * cos(li * dt) - 1.0, ai = m * sin(li * dt);
            const double den = lr * lr + li * li, qr = (ar * lr + ai * li) / den, qi = (ai * lr - ar * li) / den;
            const double br = bre[e], bi = bim[e];
            pre[2304 + e * 2] = (float)(qr * br - qi * bi); pre[2304 + e * 2 + 1] = (float)(qr * bi + qi * br); }
        if (F.tid < 64) { const int p = F.tid; const double lr = lre[p], li = lim[p]; const double m1 = exp(lr * dt * 16), m2 = exp(lr * dt * 16 * SEGL);
            f32x4 v; v.x = (float)(m1 * cos(li * dt * 16)); v.y = (float)(m1 * sin(li * dt * 16)); v.z = (float)(m2 * cos(li * dt * 16 * SEGL)); v.w = (float)(m2 * sin(li * dt * 16 * SEGL));
            *(f32x4*)(pre + 4352 + p * 4) = v; }
    }
}
__device__ __forceinline__ void s5_setup(Frame& F0) {
    Frame F = F0; F.lane = LANE_ID(); F.tid = F0.wave * 64 + F.lane;
    LAS float* ap = (LAS float*)F.lds;
    LAS float* bb = ap + 18 * 128;
    LAS float* cc = bb + 2048;
    LAS float* kt = cc + 2048;
    for (int jg = blockIdx.x; jg < N_S5 * S5_GROUPS; jg += F.G) {
        const int j = jg / S5_GROUPS, g = jg % S5_GROUPS;
        const float* cre = F.in[6] + (size_t)j * S5_GROUPS * 1024; const float* cim = F.in[7] + (size_t)j * S5_GROUPS * 1024;
        bf16_t* AM = (bf16_t*)(F.ws + WS_S5TAB + (size_t)j * SZ_S5TAB + MIX_AM); bf16_t* W1 = (bf16_t*)(F.ws + WS_S5TAB + (size_t)j * SZ_S5TAB + MIX_W1);
        __syncthreads();
        const float* pre = (const float*)(F.ws + WS_S5PRE + ((size_t)j * S5_GROUPS + g) * S5PRE_STRIDE);
        for (int e = F.tid; e < 4352; e += NTHREADS) ap[e] = pre[e];
        for (int e = F.tid; e < 1024; e += NTHREADS) { cc[e * 2] = cre[(size_t)g * 1024 + e]; cc[e * 2 + 1] = cim[(size_t)g * 1024 + e]; }
        __syncthreads();
        for (int e = F.tid; e < 4096; e += NTHREADS) { const int tau = e >> 8, ho = (e >> 4) & 15, hi = e & 15; float s = 0.f;
            for (int p = 0; p < 64; ++p) { const float cr = cc[(ho * 64 + p) * 2], ci = cc[(ho * 64 + p) * 2 + 1], ar = ap[(tau * 64 + p) * 2], ai = ap[(tau * 64 + p) * 2 + 1];
                const float xr = cr * ar - ci * ai, xi = cr * ai + ci * ar; s += xr * bb[(p * 16 + hi) * 2] - xi * bb[(p * 16 + hi) * 2 + 1]; }
            kt[e] = s; }
        __syncthreads();
        bf16_t* am = AM + (size_t)g * 256 * UXW;
        for (int e = F.tid; e < 256 * (UXW / 2); e += NTHREADS) { const int np = e / (UXW / 2), k = 2 * (e % (UXW / 2)), i = np >> 4, ho = np & 15; float v0, v1;
            if (k < 256) { const int jj = k >> 4, hi = k & 15; v0 = (jj <= i) ? kt[((i - jj) * 16 + ho) * 16 + hi] : 0.f; v1 = (jj <= i) ? kt[((i - jj) * 16 + ho) * 16 + hi + 1] : 0.f; }
            else { const int p = (k - 256) >> 1; const float cr = cc[(ho * 64 + p) * 2], ci = cc[(ho * 64 + p) * 2 + 1], ar = ap[((i + 1) * 64 + p) * 2], ai = ap[((i + 1) * 64 + p) * 2 + 1];
                v0 = cr * ar - ci * ai; v1 = -(cr * ai + ci * ar); }
            *(unsigned*)(am + (size_t)np * UXW + k) = pk2(v0, v1); }
        bf16_t* w1 = W1 + (size_t)g * 256 * 256;
        for (int e = F.tid; e < 256 * 128; e += NTHREADS) { const int np = e >> 7, k = 2 * (e & 127); float v[2] = {0.f, 0.f};
            if (np < 128) { const int p = np >> 1, comp = np & 1, jj = k >> 4;
#pragma unroll
                for (int t = 0; t < 2; ++t) { const int h = (k & 15) + t; const float ar = ap[((15 - jj) * 64 + p) * 2], ai = ap[((15 - jj) * 64 + p) * 2 + 1], br = bb[(p * 16 + h) * 2], bi = bb[(p * 16 + h) * 2 + 1];
                    v[t] = comp ? (ar * bi + ai * br) : (ar * br - ai * bi); } }
            *(unsigned*)(w1 + (size_t)np * 256 + k) = pk2(v[0], v[1]); }
    }
    __syncthreads();
}

__device__ __forceinline__ void convert_weights(Frame& F0) {
    Frame F = F0; F.lane = LANE_ID(); F.tid = F0.wave * 64 + F.lane;
    LAS float* scr = (LAS float*)(F.lds + 32768 + F.wave * 8704);
    const int nbusy = N_S5 * S5_GROUPS < F.G ? N_S5 * S5_GROUPS : F.G, bx = (int)blockIdx.x;
    const int NGW = nbusy * 4 + (F.G - nbusy) * NWAVES; const int gw = bx < nbusy ? (F.wave < 4 ? bx * 4 + F.wave : NGW) : nbusy * 4 + (bx - nbusy) * NWAVES + F.wave;
    constexpr int I_GLU = (D_MODEL / 64) * (2 * D_MODEL / 32), I_IN = (D_MODEL / 64) * (NIN_PAD / 32), I_O = (D_MODEL / 64) * (D_MODEL / 32), I_GU = (D_MODEL / 64) * (2 * D_FF / 32), I_DN = (D_FF / 64) * (D_MODEL / 32);
    constexpr int NITEMS = N_S5 * I_GLU + N_DSA * (I_IN + I_O) + DEPTH * (I_GU + I_DN);
    for (int it = gw; it < NITEMS; it += NGW) {
        int r = it;
        if (r < N_S5 * I_GLU) { const int j = r / I_GLU; transpose_item<1>(F.in[9] + (size_t)j * D_MODEL * 2 * D_MODEL, D_MODEL, 2 * D_MODEL, D_MODEL, nullptr, (bf16_t*)(F.ws + WS_WGLU + j * SZ_WGLU), scr, r % I_GLU, 2 * D_MODEL, F.lane); continue; } r -= N_S5 * I_GLU;
        if (r < N_DSA * I_IN) { const int j = r / I_IN; transpose_item<2>(F.in[10] + (size_t)j * D_MODEL * DSA_PROJ, D_MODEL, DSA_PROJ, 0, F.in[16] + (size_t)(2 * j + 1) * D_MODEL, (bf16_t*)(F.ws + WS_WIN + j * SZ_WIN), scr, r % I_IN, NIN_PAD, F.lane); continue; } r -= N_DSA * I_IN;
        if (r < N_DSA * I_O) { const int j = r / I_O; transpose_item<0>(F.in[13] + (size_t)j * D_MODEL * D_MODEL, D_MODEL, D_MODEL, 0, nullptr, (bf16_t*)(F.ws + WS_WO + j * SZ_WO), scr, r % I_O, D_MODEL, F.lane); continue; } r -= N_DSA * I_O;
        if (r < DEPTH * I_GU) { const int j = r / I_GU; transpose_item<1>(F.in[14] + (size_t)j * D_MODEL * 2 * D_FF, D_MODEL, 2 * D_FF, D_FF, F.in[17] + (size_t)j * D_MODEL, (bf16_t*)(F.ws + WS_WGU + j * SZ_WGU), scr, r % I_GU, 2 * D_FF, F.lane); continue; } r -= DEPTH * I_GU;
        { const int j = r / I_DN; transpose_item<0>(F.in[15] + (size_t)j * D_FF * D_MODEL, D_FF, D_MODEL, 0, nullptr, (bf16_t*)(F.ws + WS_WDN + j * SZ_WDN), scr, r % I_DN, D_MODEL, F.lane); }
    }
}
__device__ __forceinline__ void prologue_rows(Frame& F0) {
    Frame F = F0; F.lane = LANE_ID(); F.tid = F0.wave * 64 + F.lane;
    const int gw = F.vcu * NWAVES + F.wave, NGW = F.G * NWAVES;
    u64* rowss0 = (u64*)(F.ws + WS_ROWSS); float* rope = (float*)(F.ws + WS_ROPE); bf16_t* XB = (bf16_t*)(F.ws + WS_XB);
    for (int m = gw; m < SEQ; m += NGW) {
        const float* xr = F.in[0] + (size_t)m * D_MODEL; float s = 0.f;
        for (int c = F.lane * 4; c < D_MODEL; c += 256) { const f32x4 v = *(const f32x4*)(xr + c); s += (v.x * v.x + v.y * v.y) + (v.z * v.z + v.w * v.w);
            u32x2 w; w.x = pk2(v.x, v.y); w.y = pk2(v.z, v.w); *(u32x2*)(XB + (size_t)m * D_MODEL + c) = w; }
        s = wave_sum(s); if (F.lane == 0) rowss0[m] = (u64)(s * SS_FIX);
        if (F.lane < 32) { const float inv = powf(10000.0f, -(float)(2 * F.lane) / 64.0f); const float ang = (float)m * inv; rope[(size_t)m * 64 + F.lane] = (float)cos((double)ang); rope[(size_t)m * 64 + 32 + F.lane] = (float)sin((double)ang); }
    }
}

__device__ __forceinline__ void s5_build_ux(Frame& F0, const float* x, const u64* rowss, const float* gain) {
    Frame F = F0; F.lane = LANE_ID(); F.tid = F0.wave * 64 + F.lane;
    bf16_t* UX = (bf16_t*)(F.ws + WS_R + R_UX);
    const int gw = F.vcu * NWAVES + F.wave, NGW = F.G * NWAVES; const int j = F.lane >> 2, p = F.lane & 3;
    for (int it = gw; it < NCH * (S5_GROUPS / 4); it += NGW) { const int c = it / (S5_GROUPS / 4), gq = it % (S5_GROUPS / 4), g = 4 * gq + p, t = 16 * c + j;
        const float rs = row_rs(rowss, t); const float* xr = x + (size_t)t * D_MODEL + 16 * g; const float* gn = gain + 16 * g; float v[16];
#pragma unroll
        for (int q = 0; q < 4; ++q) { const f32x4 a = *(const f32x4*)(xr + 4 * q), gg = *(const f32x4*)(gn + 4 * q); v[4 * q] = a.x * rs * gg.x; v[4 * q + 1] = a.y * rs * gg.y; v[4 * q + 2] = a.z * rs * gg.z; v[4 * q + 3] = a.w * rs * gg.w; }
        bf16_t* dst = UX + ((size_t)g * NCH + c) * UXW + 16 * j;
        u32x4 w; w.x = pk2(v[0], v[1]); w.y = pk2(v[2], v[3]); w.z = pk2(v[4], v[5]); w.w = pk2(v[6], v[7]); *(u32x4*)dst = w;
        w.x = pk2(v[8], v[9]); w.y = pk2(v[10], v[11]); w.z = pk2(v[12], v[13]); w.w = pk2(v[14], v[15]); *(u32x4*)(dst + 8) = w; }
}
__device__ __forceinline__ void s5_scan(Frame& F0, int j) {
    Frame F = F0; F.lane = LANE_ID(); F.tid = F0.wave * 64 + F.lane;
    bf16_t* UX = (bf16_t*)(F.ws + WS_R + R_UX); const float* S = (const float*)(F.ws + WS_R + R_S);
    LAS float* E = (LAS float*)F.lds;
    const int pl = F.tid & 31, seg = F.tid >> 5;
    for (int b = blockIdx.x; b < S5_GROUPS * 2; b += F.G) { const int g = b >> 1, p = (b & 1) * 32 + pl;
        __syncthreads();
        const f32x4 av = *(const f32x4*)((const float*)(F.ws + WS_S5PRE + ((size_t)j * S5_GROUPS + g) * S5PRE_STRIDE) + 4352 + p * 4); const float ar = av.x, ai = av.y, sr = av.z, si = av.w;
        const float* sp = S + ((size_t)g * NCH + (size_t)seg * SEGL) * 128 + 2 * p; float xr = 0.f, xi = 0.f;
#pragma unroll 16
        for (int c = 0; c < SEGL; ++c) { const float br = sp[(size_t)c * 128], bi = sp[(size_t)c * 128 + 1]; const float nr = ar * xr - ai * xi + br, ni = ar * xi + ai * xr + bi; xr = nr; xi = ni; }
        E[(seg * 32 + pl) * 2] = xr; E[(seg * 32 + pl) * 2 + 1] = xi;
        __syncthreads();
        xr = 0.f; xi = 0.f;
        for (int s = 0; s < seg; ++s) { const float er = E[(s * 32 + pl) * 2], ei = E[(s * 32 + pl) * 2 + 1]; const float nr = sr * xr - si * xi + er, ni = sr * xi + si * xr + ei; xr = nr; xi = ni; }
        bf16_t* up = UX + ((size_t)g * NCH + (size_t)seg * SEGL) * UXW + 256 + 2 * p;
#pragma unroll 16
        for (int c = 0; c < SEGL; ++c) { *(unsigned*)(up + (size_t)c * UXW) = pk2(xr, xi); const float br = sp[(size_t)c * 128], bi = sp[(size_t)c * 128 + 1]; const float nr = ar * xr - ai * xi + br, ni = ar * xi + ai * xr + bi; xr = nr; xi = ni; }
    }
    __syncthreads();
}

__device__ __forceinline__ void idx_kload(bf16x8 (&ka)[2][4], const bf16_t* KI, int k0, int lane) {
    const bf16_t* kp = KI + (size_t)(k0 + (lane & 31)) * 64 + 8 * (lane >> 5);
#pragma unroll
    for (int t = 0; t < 2; ++t)
#pragma unroll
        for (int ks = 0; ks < 4; ++ks) ka[t][ks] = *(const bf16x8*)(kp + (size_t)t * 32 * 64 + 16 * ks);
}
struct QAddr { int e[4], o[4], l[4]; };
constexpr int QLIN_OFF = 135168;
__device__ __forceinline__ QAddr idx_qaddr(int lane) { QAddr A; const int ql = lane & 31, hi = lane >> 5, s3 = (ql >> 3) & 1;
#pragma unroll
    for (int ks = 0; ks < 4; ++ks) { const int lo = ql * 1024 + (((2 * ks + hi) ^ (ql & 7)) * 16); A.e[ks] = opaque(lo + (s3 ? 128 : 0)); A.o[ks] = opaque(lo - (s3 ? 128 : 0)); A.l[ks] = opaque(QLIN_OFF - 65536 + ql * 128 + (((2 * ks + hi) ^ (ql & 7)) * 16)); }
    return A; }
__device__ __forceinline__ void idx_qload(bf16x8 (&qf)[4], const LAS unsigned char* qt, const QAddr& A, int h) {
#pragma unroll
    for (int ks = 0; ks < 4; ++ks) qf[ks] = (h == 8) ? *(const LAS bf16x8*)(qt + A.l[ks]) : *(const LAS bf16x8*)(qt + ((h & 1) ? A.o[ks] : A.e[ks]) + 128 * h);
}
__device__ __forceinline__ void idx_mma(f32x16& d0, f32x16& d1, const bf16x8 (&ka)[2][4], const bf16x8 (&qf)[4]) {
#pragma unroll
    for (int r = 0; r < 16; ++r) { d0[r] = 0.f; d1[r] = 0.f; }
#pragma unroll
    for (int ks = 0; ks < 4; ++ks) { d0 = MFMA32(ka[0][ks], qf[ks], d0); d1 = MFMA32(ka[1][ks], qf[ks], d1); }
}
#ifdef EMU
#define MFMA_SETTLE(x, y)
#define FMA_ABS(s, d, w) (s) = fmaf(fabsf(d), (w), (s))
#else
#define MFMA_SETTLE(x, y) asm volatile("s_nop 11" : "+v"(x), "+v"(y))
#define FMA_ABS(s, d, w) asm("v_fma_f32 %0, |%1|, %2, %0" : "+v"(s) : "v"(d), "v"(w))
#endif
__device__ __forceinline__ void idx_acc(f32x16& S, const f32x16& D, const float hw) {
#pragma unroll
    for (int i = 0; i < 16; ++i) { float t = S[i]; const float d = D[i]; FMA_ABS(t, d, hw); S[i] = t; }
}
__device__ __forceinline__ void idx_scores2(f32x16& s0, f32x16& s1, const LAS unsigned char* qt, const QAddr& A, const float (&hw)[8], const bf16x8 (&ka)[2][4]) {
    bf16x8 qa[4], qb[4]; f32x16 a0, a1, b0, b1;
    idx_qload(qa, qt, A, 8); idx_qload(qb, qt, A, 0); SCHED_BAR();
    idx_mma(s0, s1, ka, qa); idx_qload(qa, qt, A, 1); SCHED_BAR();
    idx_mma(a0, a1, ka, qb); idx_qload(qb, qt, A, 2); SCHED_BAR();
#pragma unroll
    for (int h = 0; h < 8; h += 2) {
        idx_mma(b0, b1, ka, qa); if (h + 3 < 8) idx_qload(qa, qt, A, h + 3); SCHED_BAR();
        idx_acc(s0, a0, hw[h]); idx_acc(s1, a1, hw[h]); SCHED_BAR();
        if (h + 2 < 8) { idx_mma(a0, a1, ka, qb); if (h + 4 < 8) idx_qload(qb, qt, A, h + 4); SCHED_BAR(); } else { MFMA_SETTLE(b0, b1); }
        idx_acc(s0, b0, hw[h + 1]); idx_acc(s1, b1, hw[h + 1]); SCHED_BAR();
    }
}
__device__ __forceinline__ float score_u(float s, float inv32) { return __builtin_fmaf(s, inv32, (float)(NB / 2) + BIN_MAGIC); }
#ifdef EMU
#define HIST_ADD(hq, hadj, m) LDS_ATOMIC_ADD((hq) + (__float_as_uint(m) - 0x4B000000u), 1u)
#else
#define HIST_ADD(hq, hadj, m) LDS_ATOMIC_ADD((LAS unsigned*)(size_t)((__float_as_uint(m) << 2) + (hadj)), 1u)
#endif

template <int PASS> __device__ __forceinline__ void idx_pass(Frame& F0, int un, LAS unsigned* hist, LAS int* qinfo) {
    Frame F = F0; F.lane = LANE_ID(); F.tid = F0.wave * 64 + F.lane;
    const bf16_t* KI = (const bf16_t*)(F.ws + WS_MIX + MIX_KI); const float* WI = (const float*)(F.ws + WS_MIX + MIX_WI);
    const int lane = F.lane, ql = lane & 31, hi = lane >> 5, q = 32 * un + ql, ntiles = un + 1, npairs = (ntiles + 1) >> 1;
    const LAS unsigned char* qt = F.lds + 65536;
    float hwp[8];
#pragma unroll
    for (int h = 0; h < 8; ++h) hwp[h] = 0.5f * WI[(size_t)q * 8 + h];
    const int bstar = PASS == 2 ? qinfo[ql * 4] : 0; const float inv32 = __builtin_bit_cast(float, qinfo[ql * 4 + 3]) * BIN_SCALE;
    const float thr_hi = bstar < 0 ? -__builtin_inff() : (bstar >= NB - 1 ? __builtin_inff() : BIN_MAGIC + (float)bstar);
    const float thr_lo = bstar <= 0 ? -__builtin_inff() : BIN_MAGIC + (float)bstar;
    const float cpos = (float)(NB / 2) + 0.5f - (float)bstar;
    LAS unsigned* cand = (LAS unsigned*)(F.lds + 98304) + (ql * 16 + F.wave * 2 + hi) * 16; int mycnt = 0;
    const float cmax = __builtin_bit_cast(float, opaque_s(__builtin_bit_cast(int, BIN_MAGIC + (float)(NB - 1))));
    LAS unsigned* hq = hist + ql * NB; const unsigned hadj = (unsigned)(size_t)hq - (0x4B000000u << 2); (void)hadj; (void)hq;
    const QAddr QA = idx_qaddr(lane);
    bf16x8 ka[2][4];
    if (F.wave < npairs) idx_kload(ka, KI, 64 * F.wave, lane);
    for (int kp = F.wave; kp < npairs; kp += NWAVES) {
        const bool more = kp + NWAVES < npairs;
        f32x16 sc0, sc1; idx_scores2(sc0, sc1, qt, QA, hwp, ka);
        PIN16(sc0); PIN16(sc1);
        if (more) idx_kload(ka, KI, 64 * (kp + NWAVES), lane);
        const bool full = (2 * kp + 1 < ntiles - 1);
#pragma unroll
        for (int t = 0; t < 2; ++t) { const int kt = 2 * kp + t;
            if (PASS == 1) {
                if (full) {
#pragma unroll
                    for (int r = 0; r < 16; ++r) { const float m = MED3F(score_u(t ? sc1[r] : sc0[r], inv32), BIN_MAGIC, cmax); HIST_ADD(hq, hadj, m); }
                } else {
#pragma unroll
                    for (int r = 0; r < 16; ++r) { const int key = 32 * kt + crow(r, hi); const float m = MED3F(score_u(t ? sc1[r] : sc0[r], inv32), BIN_MAGIC, cmax);
                        if (key <= q) HIST_ADD(hq, hadj, m); }
                }
            } else if (kt < ntiles) {
                unsigned mlo = 0u, mhi = 0u;
#pragma unroll
                for (int r = 0; r < 16; ++r) { const int key = 32 * kt + crow(r, hi); const float sv = t ? sc1[r] : sc0[r]; float u = score_u(sv, inv32);
                    if (!full) u = key <= q ? u : __builtin_nanf("");
                    const u64 above = BALLOT64(u > thr_hi); WRITELANE64(mlo, mhi, above, r);
                    const u64 cm = BALLOT64(u >= thr_lo) & ~above;
                    if (cm != 0ull) { if (u >= thr_lo && !(u > thr_hi)) { if (mycnt < 16) { const float fr_ = MED3F(__builtin_fmaf(sv, inv32, cpos) * 262144.0f, 0.f, 262143.0f); cand[mycnt] = ((unsigned)fr_ << 14) | (unsigned)(16383 - key); } ++mycnt; } } }
                if (lane < 16) { u32x2 w; w.x = mlo; w.y = mhi; ((LAS u32x2*)hist)[kt * 16 + lane] = w; }
            }
        }
    }
    if (PASS == 2) ((LAS int*)(F.lds + RING_BYTES + 2048))[ql * 16 + F.wave * 2 + hi] = mycnt < 16 ? mycnt : 16;
}
__device__ __forceinline__ void indexer_unit(Frame& F0, int un) {
    Frame F = F0; F.lane = LANE_ID(); F.tid = F0.wave * 64 + F.lane;
    const bf16_t* QI = (const bf16_t*)(F.ws + WS_MIX + MIX_QI); const bf16_t* KI = (const bf16_t*)(F.ws + WS_MIX + MIX_KI); const float* WI = (const float*)(F.ws + WS_MIX + MIX_WI);
    unsigned* M32 = (unsigned*)(F.ws + WS_XB);
    LAS unsigned* hist = (LAS unsigned*)F.lds; LAS int* qinfo = (LAS int*)(F.lds + RING_BYTES); LAS int* ccnt = (LAS int*)(F.lds + RING_BYTES + 2048);
    LAS float* nrm = (LAS float*)(F.lds + 98304);
    const int lane = F.lane, q0 = 32 * un;
    __syncthreads();
    { const unsigned zz = (unsigned)opaque(0); const u32x4 z4 = (u32x4){zz, zz, zz, zz};
      for (int e = F.tid; e < 32 * NB / 4; e += NTHREADS) ((LAS u32x4*)hist)[e] = z4; }
    if (F.tid < 128) qinfo[F.tid] = 0;
    for (int e = F.tid; e < 32 * 64; e += NTHREADS) { const int row = e >> 6, c = e & 63;
        *(LAS u32x4*)(F.lds + 65536 + row * 1024 + ((c ^ (row & 15)) * 16)) = *(const u32x4*)(QI + (size_t)(q0 + row) * 512 + 8 * c); }
    if (F.tid < 256) { const int row = F.tid & 31, h = F.tid >> 5; const bf16_t* qr = QI + (size_t)(q0 + row) * 512 + h * 64; float ss = 0.f;
        for (int e = 0; e < 64; e += 8) { const u32x4 a = *(const u32x4*)(qr + e); ss += bflo(a.x) * bflo(a.x) + bfhi(a.x) * bfhi(a.x) + bflo(a.y) * bflo(a.y) + bfhi(a.y) * bfhi(a.y) + bflo(a.z) * bflo(a.z) + bfhi(a.z) * bfhi(a.z) + bflo(a.w) * bflo(a.w) + bfhi(a.w) * bfhi(a.w); }
        const float w = WI[(size_t)(q0 + row) * 8 + h]; nrm[row * 8 + h] = w * w * ss; }
    { const int row = F.tid & 31, d4 = (F.tid >> 5) * 4; float a0 = 0.f, a1 = 0.f, a2 = 0.f, a3 = 0.f;
#pragma unroll
      for (int h = 0; h < 8; ++h) { const float w = 0.5f * WI[(size_t)(q0 + row) * 8 + h]; const u32x2 v = *(const u32x2*)(QI + (size_t)(q0 + row) * 512 + h * 64 + d4);
          a0 += w * bflo(v.x); a1 += w * bfhi(v.x); a2 += w * bflo(v.y); a3 += w * bfhi(v.y); }
      u32x2 o; o.x = pk2(a0, a1); o.y = pk2(a2, a3); *(LAS u32x2*)(F.lds + QLIN_OFF + row * 128 + (((d4 >> 3) ^ (row & 7)) * 16) + (d4 & 7) * 2) = o; }
    __syncthreads();
    if (F.tid < 32) { float a = 0.f;
#pragma unroll
        for (int h = 0; h < 8; ++h) a += nrm[F.tid * 8 + h];
        const float inv = a > 1e-30f ? RSQF(0.5f * a) : 1.0f; qinfo[F.tid * 4 + 3] = __builtin_bit_cast(int, inv); }
    __syncthreads();
    idx_pass<1>(F, un, hist, qinfo);
    __syncthreads();
    for (int i = 0; i < 4; ++i) { const int qq = 4 * F.wave + i; const int n = q0 + qq + 1;
        unsigned cnt[8]; unsigned tot = 0;
#pragma unroll
        for (int e = 0; e < 2; ++e) { const u32x4 w = ((const LAS u32x4*)(hist + qq * NB + lane * 8))[e]; cnt[4 * e] = w.x; cnt[4 * e + 1] = w.y; cnt[4 * e + 2] = w.z; cnt[4 * e + 3] = w.w; tot += w.x + w.y + w.z + w.w; }
        unsigned v = tot;
#pragma unroll
        for (int o = 1; o < 64; o <<= 1) { const unsigned t = SHFL_IDX_U(v, (lane + o) & 63); if (lane + o < 64) v += t; }
        const unsigned above = v - tot;
        if (n > TOPK) { const bool mine = (above < (unsigned)TOPK) && (above + tot >= (unsigned)TOPK);
            if (mine) { unsigned a = above, abest = above; int bb = 7; bool found = false;
#pragma unroll
                for (int t = 7; t >= 0; --t) { const bool hit = !found && (a + cnt[t] >= (unsigned)TOPK); if (hit) { bb = t; abest = a; found = true; } a += cnt[t]; }
                qinfo[qq * 4] = lane * 8 + bb; qinfo[qq * 4 + 1] = TOPK - (int)abest; }
        } else if (lane == 0) { qinfo[qq * 4] = opaque(-1); qinfo[qq * 4 + 1] = opaque(0); }
    }
    __syncthreads();
    idx_pass<2>(F, un, hist, qinfo);
    __syncthreads();
    LAS unsigned* cand = (LAS unsigned*)(F.lds + 98304);
    for (int i = 0; i < 4; ++i) { const int qq = 4 * F.wave + i; const int rneed = qinfo[qq * 4 + 1];
        if (rneed <= 0) continue;
#pragma unroll
        for (int k = 0; k < 4; ++k) { const int sl = lane + 64 * k;
            if ((sl & 15) < ccnt[qq * 16 + (sl >> 4)]) { const unsigned me = cand[qq * 256 + sl]; int rank = 0;
                for (int sb = 0; sb < 16; ++sb) { const int c2 = ccnt[qq * 16 + sb];
                    for (int p2 = 0; p2 < c2; ++p2) rank += (cand[qq * 256 + sb * 16 + p2] > me) ? 1 : 0; }
                if (rank < rneed) { const unsigned key = 16383u - (me & 16383u); const int kk = key & 31, h2 = (kk >> 2) & 1, r = (kk & 3) + 4 * (kk >> 3); LDS_ATOMIC_OR(hist + (key >> 5) * 32 + r * 2 + h2, 1u << qq); } } }
    }
    __syncthreads();
    const int ktz = 8 * (un >> 3) + 8;
    for (int e = F.tid; e < ktz * 32; e += NTHREADS) { const int kt = e >> 5; M32[((size_t)kt * (SEQ / 32) + un) * 32 + (e & 31)] = kt <= un ? hist[e] : 0u; }
}
__device__ __forceinline__ void indexer_phase(Frame& F) {
    constexpr int NU = SEQ / 32;
    for (int p = F.vcu; p < NU / 2; p += F.G) { indexer_unit(F, p); indexer_unit(F, NU - 1 - p); }
    __syncthreads();
}

#ifdef EMU
#define A2_DMA(gsrc, ldsoff) emu_glds16((const void*)(gsrc), (void*)(F.lds + (ldsoff)))
#define A2_WAIT_BAR(N) emu::block_barrier()
#define A2_SBAR()
#define A2_PIN(x)
#define A2_CVTPK(lo, hi) pk2(lo, hi)
struct a2_m8 { u64 v[8]; u64 operator[](int i) const { return v[i]; } };
static inline a2_m8 a2_sload8(const u64* p) { a2_m8 r; for (int i = 0; i < 8; ++i) r.v[i] = p[i]; return r; }
#define A2_SWAIT4(a, b, c, d)
#else
typedef unsigned long long a2_m8 __attribute__((ext_vector_type(8)));
__device__ __forceinline__ a2_m8 a2_sload8(const u64* p) { a2_m8 r; asm volatile("s_load_dwordx16 %0, %1, 0x0 glc" : "=s"(r) : "s"(p)); return r; }
#define A2_SWAIT4(a, b, c, d) asm volatile("s_waitcnt lgkmcnt(0)" : "+s"(a), "+s"(b), "+s"(c), "+s"(d))
__device__ __forceinline__ void a2_glds16(const void* gsrc, unsigned lds_dst) { unsigned keep;
    asm volatile("s_mov_b32 %0, m0\n\ts_mov_b32 m0, %2\n\ts_nop 0\n\tglobal_load_lds_dwordx4 %1, off\n\ts_mov_b32 m0, %0" : "=&s"(keep) : "v"(gsrc), "s"(lds_dst) : "memory"); }
typedef __bf16 a2_bf16x2 __attribute__((ext_vector_type(2)));
__device__ __forceinline__ unsigned a2_cvtpk(float lo, float hi) { f32x2 v = {lo, hi}; a2_bf16x2 b = __builtin_convertvector(v, a2_bf16x2); return __builtin_bit_cast(unsigned, b); }
#define A2_DMA(gsrc, ldsoff) a2_glds16((const void*)(gsrc), (unsigned)__builtin_amdgcn_readfirstlane((int)(lds0 + (unsigned)(ldsoff))))
#define A2_WAIT_BAR(N) asm volatile("s_waitcnt vmcnt(" #N ") lgkmcnt(0)\n\ts_barrier" ::: "memory")
#define A2_SBAR() __builtin_amdgcn_sched_barrier(0)
#define A2_PIN(x) asm volatile("" : "+v"(x))
#define A2_CVTPK(lo, hi) a2_cvtpk(lo, hi)
#endif
constexpr int A2_NSLOT = 3, A2_SLOTB = 8192, A2_K = 0, A2_V = A2_NSLOT * A2_SLOTB, A2_WS = 2 * A2_NSLOT * A2_SLOTB, A2_OST = A2_WS + 8 * 64 * 4, A2_BYTES = A2_OST + 8 * 4096;
static_assert(A2_BYTES <= RING_BYTES, "attention scratch fits the ring");
__device__ __forceinline__ void attn_unit2(Frame& F0, int h, int qb) {
    Frame F = F0; F.lane = LANE_ID(); F.tid = F0.wave * 64 + F.lane;
    bf16_t* Qg = (bf16_t*)(F.ws + WS_R + R_Q); const bf16_t* Kg = (const bf16_t*)(F.ws + WS_R + R_K); const bf16_t* Vg = (const bf16_t*)(F.ws + WS_R + R_V);
    const int lane = F.lane, r32 = lane & 31, hi = lane >> 5, wid = F.wave, q0 = qb * 256;
    const bf16_t* Qw = Qg + (size_t)(q0 + wid * 32) * D_MODEL + h * 64; const bf16_t* Kh = Kg + h * 64; const bf16_t* Vh = Vg + h * 64;
#ifndef EMU
    const unsigned lds0 = (unsigned)(uintptr_t)F.lds;
#endif
    LAS float* wsf = (LAS float*)(F.lds + A2_WS) + wid * 64;
    const bf16_t* ksrc = Kh + (size_t)lane * D_MODEL + wid * 8;
    const bf16_t* vsrc = Vh + (size_t)(16 * (wid & 3) + (lane >> 2)) * D_MODEL + (wid >> 2) * 32 + (lane & 3) * 8;
    const int kdst = A2_K + wid * 1024, vdst = A2_V + wid * 1024;
#define DMA_K(t, slot) A2_DMA(ksrc + (size_t)(t) * 64 * D_MODEL, kdst + (slot))
#define DMA_V(t, slot) A2_DMA(vsrc + (size_t)(t) * 64 * D_MODEL, vdst + (slot))
    const LAS unsigned char* kp0 = F.lds + A2_K + hi * 1024 + r32 * 16;
    const LAS unsigned char* vp0 = F.lds + A2_V + ((lane >> 4) & 1) * 32 + (lane & 3) * 8 + (4 * hi + ((lane & 15) >> 2)) * 64;
    const int NT = (q0 + 256) / 64;
    const u64* MW = (const u64*)(F.ws + WS_XB) + (size_t)(8 * qb + wid) * 16; constexpr size_t MS = (size_t)(SEQ / 32) * 16;
    DMA_K(0, 0); DMA_V(0, 0); DMA_K(1, A2_SLOTB);
    bf16x8 qr[4];
#pragma unroll
    for (int d0 = 0; d0 < 4; ++d0) qr[d0] = *(const bf16x8*)(Qw + (size_t)r32 * D_MODEL + d0 * 16 + hi * 8);
    float l_reg = 0.f; f32x16 o[2]; f32x16 zero16;
#pragma unroll
    for (int r = 0; r < 16; ++r) { o[0][r] = 0.f; o[1][r] = 0.f; zero16[r] = 0.f; }
    f32x16 pA0, pA1, pB0, pB1; bf16x8 kf[8];
    int sl_prev = 0, sl_cur = 0, sl_next = A2_SLOTB;
#define ROT() do { sl_prev = sl_cur; sl_cur = sl_next; sl_next = (sl_next == (A2_NSLOT - 1) * A2_SLOTB) ? 0 : sl_next + A2_SLOTB; } while (0)
#define KLOAD2(kp, j) do { kf[2 * (j)] = *(const LAS bf16x8*)((kp) + (j) * 2048); kf[2 * (j) + 1] = *(const LAS bf16x8*)((kp) + (j) * 2048 + 512); } while (0)
    DMA_K(2, 2 * A2_SLOTB);
    A2_WAIT_BAR(3);
    { const LAS unsigned char* kb = kp0;
      KLOAD2(kb, 0); KLOAD2(kb, 1); KLOAD2(kb, 2); KLOAD2(kb, 3);
      pA0 = MFMA32(kf[0], qr[0], zero16); pA1 = MFMA32(kf[1], qr[0], zero16);
#pragma unroll
      for (int d0 = 1; d0 < 4; ++d0) { pA0 = MFMA32(kf[2 * d0], qr[d0], pA0); pA1 = MFMA32(kf[2 * d0 + 1], qr[d0], pA1); }
      a2_m8 m0 = a2_sload8(MW), m1 = a2_sload8(MW + 8), m2 = a2_sload8(MW + MS), m3 = a2_sload8(MW + MS + 8); A2_SWAIT4(m0, m1, m2, m3);
#pragma unroll
      for (int r = 0; r < 8; ++r) { pA0[r] = INVB(m0[r]) ? EXP2F(pA0[r]) : 0.f; pA0[8 + r] = INVB(m1[r]) ? EXP2F(pA0[8 + r]) : 0.f; pA1[r] = INVB(m2[r]) ? EXP2F(pA1[r]) : 0.f; pA1[8 + r] = INVB(m3[r]) ? EXP2F(pA1[8 + r]) : 0.f; } }
    A2_WAIT_BAR(0);
    DMA_K(3, 0); DMA_V(1, A2_SLOTB);
    ROT();
    { const LAS unsigned char* kb = kp0 + sl_cur; KLOAD2(kb, 0); KLOAD2(kb, 1); KLOAD2(kb, 2); KLOAD2(kb, 3); }
    A2_WAIT_BAR(2);
    s16x4 vlo[8], vhi[8]; u32x4 pw0, pw1, pw2, pw3;
#define PKW(P, B) A2_CVTPK(P[B], P[(B) + 1])
#define PAF(k) __builtin_bit_cast(bf16x8, pw##k)
#define VFR(i) (bf16x8){vlo[i][0], vlo[i][1], vlo[i][2], vlo[i][3], vhi[i][0], vhi[i][1], vhi[i][2], vhi[i][3]}
#define GAPA(MF, A0, A1, A2, A3, W0, W1, PW) do { MF; sacc += A0; sacc += A1; sacc += A2; sacc += A3; A2_PIN(sacc); W0; W1; A2_PIN(PW); A2_SBAR(); } while (0)
#define GAPB(MF, X, B, J, MK) do { MF; X[B] = INVB(MK[J]) ? EXP2F(X[B]) : 0.f; X[(B) + 1] = INVB(MK[(J) + 1]) ? EXP2F(X[(B) + 1]) : 0.f; X[(B) + 2] = INVB(MK[(J) + 2]) ? EXP2F(X[(B) + 2]) : 0.f; X[(B) + 3] = INVB(MK[(J) + 3]) ? EXP2F(X[(B) + 3]) : 0.f; A2_PIN(X); A2_SBAR(); } while (0)
#define VRD(i) do { vlo[i] = DS_TR16(vp_ + (((i) >> 2) * 4096 + ((i) & 3) * 1024)); vhi[i] = DS_TR16(vp_ + (((i) >> 2) * 4096 + ((i) & 3) * 1024 + 512)); } while (0)
#define KRD(G, j) do { if (G) { KLOAD2(kp0 + sl_next, j); A2_SBAR(); } } while (0)
#define STEP(C0, C1, P0, P1, t, GK, GV, GL) do { A2_SBAR(); \
    const LAS unsigned char* vp_ = vp0 + sl_prev; const u64* mka_ = MW + (size_t)(2 * (t)) * MS; const u64* mkb_ = mka_ + MS; \
    a2_m8 ma0_ = a2_sload8(mka_), ma1_ = a2_sload8(mka_ + 8), mb0_ = a2_sload8(mkb_), mb1_ = a2_sload8(mkb_ + 8); \
    VRD(0); A2_SBAR(); float sacc = (P0[0] + P0[1]); \
    GAPA(C0 = MFMA32(kf[0], qr[0], zero16), P0[2], P0[3], P0[4], P0[5],     pw0[0] = PKW(P0, 0), pw0[1] = PKW(P0, 2), pw0); \
    VRD(4); A2_SBAR(); GAPA(C1 = MFMA32(kf[1], qr[0], zero16), P0[6], P0[7], P0[8], P0[9],     pw0[2] = PKW(P0, 4), pw0[3] = PKW(P0, 6), pw0); \
    VRD(1); A2_SBAR(); GAPA(C0 = MFMA32(kf[2], qr[1], C0),   P0[10], P0[11], P0[12], P0[13], pw1[0] = PKW(P0, 8), pw1[1] = PKW(P0, 10), pw1); \
    VRD(5); A2_SBAR(); GAPA(C1 = MFMA32(kf[3], qr[1], C1),   P0[14], P0[15], P1[0], P1[1],   pw1[2] = PKW(P0, 12), pw1[3] = PKW(P0, 14), pw1); \
    VRD(2); A2_SBAR(); GAPA(C0 = MFMA32(kf[4], qr[2], C0),   P1[2], P1[3], P1[4], P1[5],     pw2[0] = PKW(P1, 0), pw2[1] = PKW(P1, 2), pw2); \
    VRD(6); A2_SBAR(); GAPA(C1 = MFMA32(kf[5], qr[2], C1),   P1[6], P1[7], P1[8], P1[9],     pw2[2] = PKW(P1, 4), pw2[3] = PKW(P1, 6), pw2); \
    VRD(3); A2_SBAR(); GAPA(C0 = MFMA32(kf[6], qr[3], C0),   P1[10], P1[11], P1[12], P1[13], pw3[0] = PKW(P1, 8), pw3[1] = PKW(P1, 10), pw3); \
    VRD(7); A2_SBAR(); GAPA(C1 = MFMA32(kf[7], qr[3], C1),   P1[14], P1[15], 0.f, 0.f,       pw3[2] = PKW(P1, 12), pw3[3] = PKW(P1, 14), pw3); \
    l_reg += sacc; \
    if (GK) { DMA_K((t) + 3, sl_cur); } if (GV) { DMA_V((t) + 1, sl_next); } \
    A2_SWAIT4(ma0_, ma1_, mb0_, mb1_); A2_SBAR(); \
    GAPB(o[0] = MFMA32(PAF(0), VFR(0), o[0]), C0, 0, 0, ma0_); \
    GAPB(o[1] = MFMA32(PAF(0), VFR(4), o[1]), C0, 4, 4, ma0_); \
    KRD(GL, 0); GAPB(o[0] = MFMA32(PAF(1), VFR(1), o[0]), C0, 8, 0, ma1_); \
    KRD(GL, 1); GAPB(o[1] = MFMA32(PAF(1), VFR(5), o[1]), C0, 12, 4, ma1_); \
    KRD(GL, 2); GAPB(o[0] = MFMA32(PAF(2), VFR(2), o[0]), C1, 0, 0, mb0_); \
    KRD(GL, 3); GAPB(o[1] = MFMA32(PAF(2), VFR(6), o[1]), C1, 4, 4, mb0_); \
    GAPB(o[0] = MFMA32(PAF(3), VFR(3), o[0]), C1, 8, 0, mb1_); \
    GAPB(o[1] = MFMA32(PAF(3), VFR(7), o[1]), C1, 12, 4, mb1_); \
    } while (0)
    int t = 1;
    for (; t + 5 < NT; t += 2) {
        STEP(pB0, pB1, pA0, pA1, t, true, true, true);     A2_WAIT_BAR(2); ROT();
        STEP(pA0, pA1, pB0, pB1, t + 1, true, true, true); A2_WAIT_BAR(2); ROT();
    }
#define ENDW(tt) do { if ((tt) + 3 < NT) { A2_WAIT_BAR(2); } else if ((tt) + 2 < NT) { A2_WAIT_BAR(1); } else { A2_WAIT_BAR(0); } } while (0)
    for (; t + 1 < NT; t += 2) {
        STEP(pB0, pB1, pA0, pA1, t, (t + 3 < NT), (t + 1 < NT), (t + 1 < NT));         ENDW(t);     ROT();
        STEP(pA0, pA1, pB0, pB1, t + 1, (t + 4 < NT), (t + 2 < NT), (t + 2 < NT));     ENDW(t + 1); ROT();
    }
    STEP(pB0, pB1, pA0, pA1, NT - 1, false, false, false);
    { float sacc = pB0[0] + pB0[1];
#pragma unroll
      for (int r = 2; r < 16; ++r) sacc += pB0[r];
#pragma unroll
      for (int r = 0; r < 16; ++r) sacc += pB1[r];
      l_reg += sacc;
      pw0 = (u32x4){PKW(pB0, 0), PKW(pB0, 2), PKW(pB0, 4), PKW(pB0, 6)}; pw1 = (u32x4){PKW(pB0, 8), PKW(pB0, 10), PKW(pB0, 12), PKW(pB0, 14)};
      pw2 = (u32x4){PKW(pB1, 0), PKW(pB1, 2), PKW(pB1, 4), PKW(pB1, 6)}; pw3 = (u32x4){PKW(pB1, 8), PKW(pB1, 10), PKW(pB1, 12), PKW(pB1, 14)};
      A2_SBAR();
      const LAS unsigned char* vp_ = vp0 + sl_cur;
#pragma unroll
      for (int d0 = 0; d0 < 2; ++d0) {
#pragma unroll
          for (int ks = 0; ks < 4; ++ks) { VRD(d0 * 4 + ks); }
          o[d0] = MFMA32(PAF(0), VFR(d0 * 4 + 0), o[d0]); o[d0] = MFMA32(PAF(1), VFR(d0 * 4 + 1), o[d0]); o[d0] = MFMA32(PAF(2), VFR(d0 * 4 + 2), o[d0]); o[d0] = MFMA32(PAF(3), VFR(d0 * 4 + 3), o[d0]); } }
    l_reg = sum_x32(l_reg);
    if (hi == 0) wsf[32 + r32] = l_reg;
    WAIT_L(0);
    float rli[16];
#pragma unroll
    for (int r = 0; r < 16; ++r) rli[r] = RCPF(wsf[32 + crow(r, hi)]);
    bf16_t* Ow = Qg + (size_t)(q0 + wid * 32) * D_MODEL + h * 64;
    { LAS bf16_t* stg = (LAS bf16_t*)(F.lds + A2_OST) + wid * 2048;
#pragma unroll
      for (int r = 0; r < 16; ++r) { const int orow = crow(r, hi);
#pragma unroll
          for (int d0 = 0; d0 < 2; ++d0) stg[orow * 64 + d0 * 32 + r32] = (bf16_t)f2bf(o[d0][r] * rli[r]); }
      WAIT_L(0);
#pragma unroll
      for (int i = 0; i < 4; ++i) { const int row = i * 8 + (lane >> 3), ch = lane & 7; const u32x4 v = *(const LAS u32x4*)(stg + row * 64 + ch * 8); *(u32x4*)(Ow + (size_t)row * D_MODEL + ch * 8) = v; } }
    A2_WAIT_BAR(0);
#undef DMA_K
#undef DMA_V
#undef ROT
#undef KLOAD2
#undef PKW
#undef PAF
#undef VFR
#undef GAPA
#undef GAPB
#undef VRD
#undef KRD
#undef STEP
#undef ENDW
}
__device__ __forceinline__ void attn_phase(Frame& F) {
    constexpr int NQB = SEQ / 256, NP = N_HEADS * (NQB / 2);
    for (int p = F.vcu; p < NP; p += F.G) { const int head = p / (NQB / 2), s = p % (NQB / 2); attn_unit2(F, head, s); attn_unit2(F, head, NQB - 1 - s); }
    __syncthreads();
}

#ifdef EMU
#define CG_SYNC() emu::grid_barrier()
#define LDS_DECL(name) unsigned char* name = emu::lds_ptr()
#else
namespace cg = cooperative_groups;
#define CG_SYNC() cg::this_grid().sync()
#define LDS_DECL(name) extern __shared__ __attribute__((aligned(16))) unsigned char name[]
#endif

#ifdef EMU
static int g_emu_max_layers = DEPTH;
#define MAX_LAYERS g_emu_max_layers
static int g_emu_stop = 0;
#define EMU_STOP(k) do { if (g_emu_stop == (k)) return; } while (0)
#else
#define MAX_LAYERS DEPTH
#define EMU_SNAPSHOT() do {} while (0)
#define EMU_STOP(k) do {} while (0)
#endif
__global__ void __launch_bounds__(NTHREADS, 2) mega_fwd(Args args) {
    LDS_DECL(lds_raw);
    Frame F;
    F.lds = (LAS unsigned char*)lds_raw; F.tid = threadIdx.x; F.lane = F.tid & 63; F.wave = RFL(F.tid >> 6);
    F.G = gridDim.x; { const int bx = blockIdx.x; F.vcu = (F.G % 8 == 0) ? (bx % 8) * (F.G / 8) + bx / 8 : bx; }
#pragma unroll
    for (int i = 0; i < 18; ++i) F.in[i] = args.in[i];
    F.out = args.out; F.ws = args.ws;
    volatile LAS unsigned* MISC = (volatile LAS unsigned*)(F.lds + LDSCTL_OFF + 1024);
    if (F.tid < 64) MISC[F.tid] = 0u;
    __syncthreads();
    XcdBarrier bar = xcd_barrier_post((unsigned*)(F.ws + WS_CTL) + 4096, MISC + 8);
#define GRID_BAR() xcd_barrier(bar)
    u64* rowss = (u64*)(F.ws + WS_ROWSS); bf16_t* XB = (bf16_t*)(F.ws + WS_XB);
    LAS unsigned char* ring = F.lds;

#ifndef KN
#define KN 0xffff
#endif
    if (KN & 1) { s5_pre(F);
    WAIT_VM0(); __syncthreads();
    s5_setup(F);
    convert_weights(F);
    prologue_rows(F); }
    EMU_STOP(1);
    CG_SYNC();

    const Frame F_ = F;
    for (int layer = 0; layer < MAX_LAYERS; ++layer) {
        const int j = layer >> 1;
        Frame F = F_; F.ws = opaque_p(F_.ws); u64* rowss = (u64*)(F.ws + WS_ROWSS); bf16_t* XB = (bf16_t*)(F.ws + WS_XB);
#define XIN (opaque_s(layer) == 0 ? F.in[0] : F.out)
        u64* rs_mix = rowss + (size_t)(2 * layer) * SEQ; u64* rs_ffn = rowss + (size_t)(2 * layer + 1) * SEQ; u64* rs_next = rowss + (size_t)(2 * layer + 2) * SEQ;
        if ((layer & 1) == 0) {
            if (KN & 2) s5_build_ux(F, XIN, rs_mix, F.in[16] + (size_t)layer * D_MODEL);
            GRID_BAR(); EMU_STOP(2);
            if (KN & 4) { pg8::Gemm g{(const bf16_t*)(F.ws + WS_R + R_UX), (const bf16_t*)(F.ws + WS_S5TAB + (size_t)j * SZ_S5TAB + MIX_W1), UXW, 256, 256}; pg8::GroupOrder S{F.G, (int)blockIdx.x};
              EpiS5State E{(float*)(F.ws + WS_R + R_S)}; pg8::gemm_phase(ring, F.wave, g, S, E); }
            GRID_BAR(); EMU_STOP(3);
            if (KN & 8) s5_scan(F, j);
            GRID_BAR(); EMU_STOP(4);
            if (KN & 16) { pg8::Gemm g{(const bf16_t*)(F.ws + WS_R + R_UX), (const bf16_t*)(F.ws + WS_S5TAB + (size_t)j * SZ_S5TAB + MIX_AM), UXW, UXW, UXW}; pg8::GroupOrder S{F.G, (int)blockIdx.x};
              EpiS5Out E{(bf16_t*)(F.ws + WS_R + R_Y), (const bf16_t*)(F.ws + WS_R + R_UX), F.in[8] + (size_t)j * D_MODEL}; pg8::gemm_phase(ring, F.wave, g, S, E); }
            GRID_BAR(); EMU_STOP(5);
            if (KN & 32) { pg8::Gemm g{(const bf16_t*)(F.ws + WS_R + R_Y), (const bf16_t*)(F.ws + WS_WGLU + j * SZ_WGLU), D_MODEL, D_MODEL, D_MODEL}; pg8::StaticOrder S; S.init(SEQ, 2 * D_MODEL, F.G, (int)blockIdx.x);
              EpiRes<true> E{XIN, F.out, XB, rs_ffn}; pg8::gemm_phase(ring, F.wave, g, S, E); }
            GRID_BAR();
        } else {
            if (KN & 64) { pg8::Gemm g{XB, (const bf16_t*)(F.ws + WS_WIN + j * SZ_WIN), D_MODEL, D_MODEL, D_MODEL}; pg8::StaticOrder S; S.init(SEQ, NIN_PAD, F.G, (int)blockIdx.x);
              EpiInProj E{(bf16_t*)(F.ws + WS_R + R_Q), (bf16_t*)(F.ws + WS_R + R_K), (bf16_t*)(F.ws + WS_R + R_V), (bf16_t*)(F.ws + WS_MIX + MIX_QI), (bf16_t*)(F.ws + WS_MIX + MIX_KI), (float*)(F.ws + WS_MIX + MIX_WI),
                          rs_mix, (const float*)(F.ws + WS_ROPE), F.in[11] + (size_t)j * 64, F.in[12] + (size_t)j * 64};
              pg8::gemm_phase(ring, F.wave, g, S, E); }
            GRID_BAR(); EMU_STOP(7);
            if (KN & 128) indexer_phase(F);
            GRID_BAR(); EMU_STOP(8);
            if (KN & 256) attn_phase(F);
            GRID_BAR(); EMU_STOP(9);
            if (KN & 512) { pg8::Gemm g{(const bf16_t*)(F.ws + WS_R + R_Q), (const bf16_t*)(F.ws + WS_WO + j * SZ_WO), D_MODEL, D_MODEL, D_MODEL}; pg8::StaticOrder S; S.init(SEQ, D_MODEL, F.G, (int)blockIdx.x);
              EpiRes<false> E{F.out, F.out, XB, rs_ffn}; pg8::gemm_phase(ring, F.wave, g, S, E); }
            GRID_BAR();
        }
        EMU_SNAPSHOT();
        if (KN & 1024) { pg8::Gemm g{XB, (const bf16_t*)(F.ws + WS_WGU + layer * SZ_WGU), D_MODEL, D_MODEL, D_MODEL}; pg8::StaticOrder S; S.init(SEQ, 2 * D_FF, F.G, (int)blockIdx.x);
          EpiSwiGLU E{(bf16_t*)(F.ws + WS_R + R_ACT), rs_ffn}; pg8::gemm_phase(ring, F.wave, g, S, E); }
        GRID_BAR();
        if (KN & 2048) { pg8::Gemm g{(const bf16_t*)(F.ws + WS_R + R_ACT), (const bf16_t*)(F.ws + WS_WDN + layer * SZ_WDN), D_FF, D_FF, D_FF}; pg8::StaticOrder S; S.init(SEQ, D_MODEL, F.G, (int)blockIdx.x);
          EpiRes<false> E{F.out, F.out, XB, rs_next}; pg8::gemm_phase(ring, F.wave, g, S, E); }
        if (opaque_s(layer) + 1 < DEPTH) GRID_BAR();
#ifdef EMU
        else GRID_BAR();
        EMU_SNAPSHOT();
#endif
    }
}

#ifndef EMU
extern "C" void kernel_launch(void* const* d_in, const int* in_sizes, int n_in, void* d_out, int out_size, void* d_ws, size_t ws_size, hipStream_t stream) {
    static int grid = 0;
    if (grid == 0) {
        if (n_in != 18 || out_size != SEQ * D_MODEL || ws_size < WS_END) { fprintf(stderr, "kernel_launch: unexpected shapes (n_in %d out %d ws %zu need %zu)\n", n_in, out_size, ws_size, (size_t)WS_END); grid = -1; return; }
        int dev = 0, cus = 0, per_cu = 0;
        hipGetDevice(&dev); hipDeviceGetAttribute(&cus, hipDeviceAttributeMultiprocessorCount, dev);
        hipFuncSetAttribute((const void*)mega_fwd, hipFuncAttributeMaxDynamicSharedMemorySize, LDS_BYTES);
        hipOccupancyMaxActiveBlocksPerMultiprocessor(&per_cu, (const void*)mega_fwd, NTHREADS, LDS_BYTES);
        if (per_cu < 1) { fprintf(stderr, "kernel_launch: occupancy query says %d blocks/CU\n", per_cu); grid = -1; return; }
        grid = cus;
        (void)hipGetLastError();
    }
    if (grid < 0) return;
    hipMemsetAsync((char*)d_ws + WS_CTL, 0, CTL_BYTES, stream);
    Args a{};
    for (int i = 0; i < 18; ++i) a.in[i] = (const float*)d_in[i];
    a.out = (float*)d_out; a.ws = (unsigned char*)d_ws;
    void* params[] = {&a};
    hipError_t e = hipLaunchCooperativeKernel((const void*)mega_fwd, dim3(grid), dim3(NTHREADS), params, LDS_BYTES, stream);
    if (e != hipSuccess) fprintf(stderr, "cooperative launch failed: %s (grid %d)\n", hipGetErrorString(e), grid);
}
#endif
```

```cpp
#ifndef EMU
#include <hip/hip_runtime.h>
#include <hip/hip_cooperative_groups.h>
#include <cstdio>
#include <cstdint>
#include <cmath>
#endif

#ifdef CFG_SMALL
constexpr int D_MODEL = 256, SEQ = 4096, DEPTH = 2, N_HEADS = 4;
#else
constexpr int D_MODEL = 1024, SEQ = 16384, DEPTH = 4, N_HEADS = 16;
#endif
constexpr int S5_GROUPS = D_MODEL / 16, S5_STATE = 64, HEAD_DIM = 64, IDX_HEADS = 8, TOPK = 256;
constexpr int D_FF = ((8 * D_MODEL / 3 + 255) / 256) * 256;
constexpr int N_S5 = (DEPTH + 1) / 2, N_DSA = DEPTH / 2;
constexpr int DSA_PROJ = 3 * D_MODEL + 512 + 64 + 8;
constexpr int NH4 = D_MODEL / 256;
constexpr int NIN_TILES = 3 * NH4 + 3, NIN_PAD = NIN_TILES * 256;
constexpr int NCH = SEQ / 16, NCHT = NCH / 256;
constexpr int UXW = 384;
constexpr int NSEG = 32, SEGL = NCH / NSEG;
constexpr float EPS = 1e-6f;
constexpr float C2 = 0.125f * 1.4426950408889634f;
constexpr int NWAVES = 8, NTHREADS = 512;
#ifndef PROBE_DUP
#define PROBE_DUP 0
#endif
constexpr int NB = 512; constexpr float BIN_SCALE = 32.f, BIN_MAGIC = 8388608.f;
constexpr int CAND_CAP = 256;

constexpr size_t MiB = 1u << 20;
constexpr size_t WS_CTL = 0, CTL_BYTES = 3 * MiB;
constexpr size_t WS_ROWSS = 1 * MiB;
constexpr size_t SZ_WGLU = (size_t)2 * D_MODEL * D_MODEL * 2, SZ_WIN = (size_t)NIN_PAD * D_MODEL * 2, SZ_WO = (size_t)D_MODEL * D_MODEL * 2,
                 SZ_WGU = (size_t)2 * D_FF * D_MODEL * 2, SZ_WDN = (size_t)D_MODEL * D_FF * 2;
constexpr size_t WS_WGLU = CTL_BYTES, WS_WIN = WS_WGLU + N_S5 * SZ_WGLU, WS_WO = WS_WIN + N_DSA * SZ_WIN, WS_WGU = WS_WO + N_DSA * SZ_WO,
                 WS_WDN = WS_WGU + DEPTH * SZ_WGU, WS_ROPE = WS_WDN + DEPTH * SZ_WDN;
constexpr size_t SZ_ROPE = (size_t)SEQ * 64 * 4;
constexpr size_t S5PRE_STRIDE = 18432;
constexpr size_t WS_S5PRE = WS_ROPE + SZ_ROPE, SZ_S5PRE = (size_t)N_S5 * S5_GROUPS * S5PRE_STRIDE;
constexpr size_t WS_MIX = WS_S5PRE + SZ_S5PRE;
constexpr size_t SZ_AM = (size_t)S5_GROUPS * 256 * UXW * 2, SZ_W1 = (size_t)S5_GROUPS * 256 * 256 * 2, SZ_APOW = (size_t)S5_GROUPS * 64 * 16;
constexpr size_t MIX_AM = 0, MIX_W1 = MIX_AM + SZ_AM;
constexpr size_t MIX_QI = 0, SZ_QI = (size_t)SEQ * 512 * 2, MIX_KI = MIX_QI + SZ_QI, SZ_KI = (size_t)SEQ * 64 * 2, MIX_WI = MIX_KI + SZ_KI, SZ_WI = (size_t)SEQ * 8 * 4;
constexpr size_t SZ_S5TAB = MIX_W1 + SZ_W1, SZ_MIX_DSA = MIX_WI + SZ_WI;
constexpr size_t SZ_MIX = (SZ_MIX_DSA + 4095) / 4096 * 4096;
constexpr size_t WS_XB = WS_MIX + SZ_MIX, SZ_XB = (size_t)SEQ * D_MODEL * 2;
constexpr size_t WS_MASK = WS_XB + SZ_XB, SZ_MASK = (size_t)(SEQ / 32) * SEQ * 4;
constexpr size_t WS_R = WS_MASK + SZ_MASK;
constexpr size_t R_Q = 0, R_K = SZ_XB, R_V = 2 * SZ_XB;
constexpr size_t R_ACT = 0, SZ_ACT = (size_t)SEQ * D_FF * 2;
constexpr size_t R_UX = 0, SZ_UX = (size_t)S5_GROUPS * NCH * UXW * 2, R_S = ((SZ_UX + 4095) / 4096) * 4096, SZ_S = (size_t)S5_GROUPS * NCH * 128 * 4, R_Y = R_S;
constexpr size_t SZ_R0 = 3 * SZ_XB > SZ_ACT ? 3 * SZ_XB : SZ_ACT, SZ_R1 = R_S + SZ_S, SZ_R = SZ_R0 > SZ_R1 ? SZ_R0 : SZ_R1;
constexpr size_t WS_S5TAB = ((WS_R + SZ_R + 4095) / 4096) * 4096;
constexpr size_t WS_END = WS_S5TAB + N_S5 * SZ_S5TAB;
static_assert(SZ_S >= (size_t)SEQ * D_MODEL * 2, "Y fits over S");
static_assert(SEQ <= 16384, "candidate packing holds 14-bit keys");
static_assert((2 * DEPTH + 1) * (size_t)SEQ * 8 <= 2 * MiB, "rowss arrays fit");
typedef unsigned long long u64;
constexpr float SS_FIX = 1048576.0f, SS_INV = 1.0f / 1048576.0f;

typedef unsigned short bf16_t;
typedef short bf16x8 __attribute__((ext_vector_type(8)));
typedef float f32x4 __attribute__((ext_vector_type(4)));
typedef float f32x16 __attribute__((ext_vector_type(16)));
typedef unsigned u32x4 __attribute__((ext_vector_type(4)));
typedef unsigned u32x2 __attribute__((ext_vector_type(2)));
typedef short s16x4 __attribute__((ext_vector_type(4)));
typedef float f32x2 __attribute__((ext_vector_type(2)));

#ifdef EMU
#define LAS
#define GAS
#define MFMA16(a, b, c) emu_mfma16(a, b, c)
#define MFMA32(a, b, c) emu_mfma32(a, b, c)
#define WAIT_V(n)
#define WAIT_L(n) emu::wave_barrier()
#define WAIT_VM0() do {} while (0)
#define S_BARRIER() emu::block_barrier()
#define SCHED_BAR()
#define PIN16(x)
#define PIN1(x)
#define PINS(x)
#define PIN2(x)
#define SETPRIO(x)
#define RFL(x) (x)
#define LANE_ID() ((int)(threadIdx.x & 63))
#define GLDS16B(base, voff, l) emu_glds16((const void*)((const char*)(base) + (voff)), (void*)(l))
#define DS_TR16(p) emu_ds_read_tr16((const void*)(p))
#define EXP2F(x) exp2f(x)
#define RCPF(x) (1.0f / (x))
#define RSQF(x) (1.0f / sqrtf(x))
#define LDS_ATOMIC_ADD(p, v) atomicAdd((unsigned*)(p), (unsigned)(v))
#define LDS_ATOMIC_OR(p, v) atomicOr((unsigned*)(p), (unsigned)(v))
#define INVB(m) ((int)(((m) >> (threadIdx.x & 63)) & 1ull))
#define BALLOT64(p) __ballot(p)
#define WRITELANE64(lo, hi, b, r) do { if ((int)(threadIdx.x & 63) == (r)) { lo = (unsigned)(b); hi = (unsigned)((b) >> 32); } } while (0)
#define MED3F(a, lo, hi) fminf(fmaxf((a), (lo)), (hi))
#define RLX_LOAD(p) (*(p))
#define RLX_STORE(p, v) (*(p) = (v))
#define RLX_ADD(p, v) atomicAdd((unsigned*)(p), (unsigned)(v))
#else
#define LAS __attribute__((address_space(3)))
#define GAS __attribute__((address_space(1)))
#define MFMA16(a, b, c) __builtin_amdgcn_mfma_f32_16x16x32_bf16(a, b, c, 0, 0, 0)
#define MFMA32(a, b, c) __builtin_amdgcn_mfma_f32_32x32x16_bf16(a, b, c, 0, 0, 0)
#define WAIT_V(n) asm volatile("s_waitcnt vmcnt(" #n ")" ::: "memory")
#define WAIT_L(n) asm volatile("s_waitcnt lgkmcnt(" #n ")" ::: "memory")
#define WAIT_VM0() asm volatile("s_waitcnt vmcnt(0)" ::: "memory")
#define S_BARRIER() __builtin_amdgcn_s_barrier()
#define SCHED_BAR() __builtin_amdgcn_sched_barrier(0)
#define PIN16(x) asm volatile("" : "+v"(x))
#define PIN1(x) asm volatile("" : "+v"(x))
#define PINS(x) asm volatile("" : "+s"(x))
#define PIN2(x) asm volatile("" : "+v"(x))
#define SETPRIO(x) __builtin_amdgcn_s_setprio(x)
#define RFL(x) __builtin_amdgcn_readfirstlane(x)
#define LANE_ID() lane_id_now()
__device__ __forceinline__ void glds16b_(const char* base, unsigned voff, unsigned lds_dst) { asm volatile("s_mov_b32 m0, %2\n\ts_nop 0\n\tglobal_load_lds_dwordx4 %0, %1" :: "v"(voff), "s"(base), "s"(lds_dst) : "memory", "m0"); }
#define GLDS16B(base, voff, l) glds16b_((base), (voff), (unsigned)__builtin_amdgcn_readfirstlane((int)(unsigned)(size_t)(l)))
typedef short v4i16_t __attribute__((ext_vector_type(4)));
#define DS_TR16(p) __builtin_bit_cast(s16x4, __builtin_amdgcn_ds_read_tr16_b64_v4i16((LAS v4i16_t*)(p)))
#define EXP2F(x) __builtin_amdgcn_exp2f(x)
#define RCPF(x) __builtin_amdgcn_rcpf(x)
#define RSQF(x) __builtin_amdgcn_rsqf(x)
#define LDS_ATOMIC_ADD(p, v) __hip_atomic_fetch_add((LAS unsigned*)(p), (unsigned)(v), __ATOMIC_RELAXED, __HIP_MEMORY_SCOPE_WORKGROUP)
#define LDS_ATOMIC_OR(p, v) __hip_atomic_fetch_or((LAS unsigned*)(p), (unsigned)(v), __ATOMIC_RELAXED, __HIP_MEMORY_SCOPE_WORKGROUP)
#define INVB(m) __builtin_amdgcn_inverse_ballot_w64(m)
#define BALLOT64(p) __builtin_amdgcn_ballot_w64(p)
#define WRITELANE64(lo, hi, b, r) do { asm("v_writelane_b32 %0, %1, %2" : "+v"(lo) : "s"((unsigned)(b)), "n"(r)); asm("v_writelane_b32 %0, %1, %2" : "+v"(hi) : "s"((unsigned)((b) >> 32)), "n"(r)); } while (0)
#define MED3F(a, lo, hi) __builtin_amdgcn_fmed3f((a), (lo), (hi))
#define RLX_LOAD(p) __hip_atomic_load(p, __ATOMIC_RELAXED, __HIP_MEMORY_SCOPE_AGENT)
#define RLX_STORE(p, v) __hip_atomic_store(p, v, __ATOMIC_RELAXED, __HIP_MEMORY_SCOPE_AGENT)
#define RLX_ADD(p, v) __hip_atomic_fetch_add(p, v, __ATOMIC_RELAXED, __HIP_MEMORY_SCOPE_AGENT)
#endif

__device__ __forceinline__ int opaque(int v) { PIN1(v); return v; }
#ifndef EMU
__device__ __forceinline__ int lane_id_now() { int l; asm volatile("v_mbcnt_lo_u32_b32 %0, -1, 0\n\tv_mbcnt_hi_u32_b32 %0, -1, %0" : "=v"(l)); return l; }
#endif
__device__ __forceinline__ int opaque_s(int v) { PINS(v); return v; }
#ifdef EMU
__device__ __forceinline__ unsigned char* opaque_p(unsigned char* p) { PINS(p); return p; }
#else
__device__ __forceinline__ unsigned char* opaque_p(unsigned char* p) { unsigned long long v = (unsigned long long)p; PINS(v); return (unsigned char*)(__attribute__((address_space(1))) unsigned char*)v; }
#endif
#ifdef EMU
__device__ __forceinline__ const char* uni_ptr(const char* p) { return p; }
#else
__device__ __forceinline__ const char* uni_ptr(const char* p) { const unsigned long long v = (unsigned long long)p; const unsigned lo = __builtin_amdgcn_readfirstlane((unsigned)v), hi = __builtin_amdgcn_readfirstlane((unsigned)(v >> 32));
    return (const char*)(((unsigned long long)hi << 32) | lo); }
#endif
#ifdef EMU
__device__ __forceinline__ unsigned f2bf(float f) { unsigned u = __builtin_bit_cast(unsigned, f); return (u + 0x7fffu + ((u >> 16) & 1u)) >> 16; }
#else
__device__ __forceinline__ unsigned f2bf(float f) { return (unsigned)__builtin_bit_cast(unsigned short, (__bf16)f); }
#endif
#ifdef EMU
__device__ __forceinline__ unsigned pk2(float lo, float hi) { return f2bf(lo) | (f2bf(hi) << 16); }
#else
typedef __bf16 hw_bf16x2 __attribute__((ext_vector_type(2)));
__device__ __forceinline__ unsigned pk2(float lo, float hi) { f32x2 v = {lo, hi}; hw_bf16x2 b = __builtin_convertvector(v, hw_bf16x2); return __builtin_bit_cast(unsigned, b); }
#endif
__device__ __forceinline__ float bf2f(unsigned h) { return __builtin_bit_cast(float, h << 16); }
__device__ __forceinline__ float bflo(unsigned w) { return __builtin_bit_cast(float, w << 16); }
__device__ __forceinline__ float bfhi(unsigned w) { return __builtin_bit_cast(float, w & 0xffff0000u); }
__device__ __forceinline__ float sigmoidf_(float v) { return RCPF(1.0f + EXP2F(-1.4426950408889634f * v)); }
__device__ __forceinline__ float gelu_tanh(float v) { const float p = __builtin_fmaf(-0.10294322f, v * v, -2.30220819f); return v * RCPF(1.0f + EXP2F(v * p)); }
__device__ __forceinline__ float rs_of(u64 ss) { const float f = __builtin_fmaf((float)(unsigned)(ss >> 32), 4294967296.0f, (float)(unsigned)ss); return RSQF(f * (SS_INV / D_MODEL) + EPS); }
__device__ __forceinline__ float row_rs(const u64* rowss, int r) { return rs_of(rowss[r]); }
#ifdef EMU
#define PIN64(x)
#else
#define PIN64(x) asm volatile("" : "+v"(x))
#endif
__device__ __forceinline__ void row_rs8(float (&rs)[8], const u64* rowss, int r0) { u64 raw[8];
#pragma unroll
    for (int it = 0; it < 8; ++it) raw[it] = rowss[r0 + (it >> 2) * 128 + (it & 3) * 16];
#pragma unroll
    for (int it = 0; it < 8; ++it) PIN64(raw[it]);
#pragma unroll
    for (int it = 0; it < 8; ++it) rs[it] = rs_of(raw[it]); }
__device__ __forceinline__ int crow(int r, int hi) { return (r & 3) + 8 * (r >> 2) + 4 * hi; }

#define XB_TMO      128
#define XB_XCNT(j)  (256  + 64 * (j))
#define XB_XSUB(j)  (1280 + 64 * (j))
#define XB_XGEN(j)  (2304 + 64 * (j))
#define XB_TOP      3328
#define XB_TOPGEN   3392
#define XCD_BAR_WORDS 3456
#define XB_SPIN_CAP 0xF0000000u
struct XcdBarrier { unsigned* bar; unsigned x; volatile LAS unsigned* st; };
#ifdef EMU
__device__ __forceinline__ XcdBarrier xcd_barrier_post(unsigned* bar, volatile unsigned* st) { XcdBarrier b; b.bar = bar; b.x = 0; b.st = st; return b; }
__device__ __forceinline__ void xcd_barrier(const XcdBarrier&) { emu::grid_barrier(); }
#else
__device__ __forceinline__ unsigned xb_ld(unsigned* p)              { return __hip_atomic_load(p, __ATOMIC_RELAXED, __HIP_MEMORY_SCOPE_AGENT); }
__device__ __forceinline__ unsigned xb_add(unsigned* p, unsigned v) { return __hip_atomic_fetch_add(p + opaque(0), v, __ATOMIC_RELAXED, __HIP_MEMORY_SCOPE_AGENT); }
__device__ __forceinline__ unsigned xb_xcc_id() { return (unsigned)__builtin_amdgcn_s_getreg((3 << 11) | 20) & 0xFu; }
#define XB_SPIN(cond, bar) do { unsigned _sp = 0; while (cond) { __builtin_amdgcn_s_sleep(1); \
    if ((++_sp & 255u) == 0u) { if (xb_ld(&(bar)[XB_TMO])) break; if (_sp > XB_SPIN_CAP) { atomicAdd(&(bar)[XB_TMO], 1u); break; } } } } while (0)
__device__ __forceinline__ XcdBarrier xcd_barrier_post(unsigned* bar, volatile LAS unsigned* st) {
    XcdBarrier b; b.bar = bar; b.x = (unsigned)__builtin_amdgcn_readfirstlane((int)xb_xcc_id()); b.st = st;
    if (threadIdx.x == 0) (void)xb_add(&bar[XB_XCNT(b.x)], 1u);
    return b;
}
__device__ __forceinline__ void xcd_barrier_complete(unsigned* bar, unsigned x, unsigned& nloc, unsigned& nx) {
    const unsigned G = gridDim.x * gridDim.y * gridDim.z;
    unsigned sum, cnt, mine, sp = 0u;
    for (;;) {
        sum = 0u; cnt = 0u; mine = 0u;
#pragma unroll
        for (unsigned j = 0; j < 16; ++j) { const unsigned c = xb_ld(&bar[XB_XCNT(j)]); sum += c; cnt += (c > 0u) ? 1u : 0u; mine = (j == x) ? c : mine; }
        if (sum == G) break;
        __builtin_amdgcn_s_sleep(1);
        if ((++sp & 255u) == 0u) { if (xb_ld(&bar[XB_TMO])) break; if (sp > XB_SPIN_CAP) { atomicAdd(&bar[XB_TMO], 1u); break; } }
    }
    nloc = mine > 0u ? mine : 1u; nx = cnt > 0u ? cnt : 1u;
}
__device__ __forceinline__ void xcd_barrier(const XcdBarrier& b) {
    asm volatile("s_waitcnt vmcnt(0)" ::: "memory");
    __syncthreads();
    if (threadIdx.x == 0) {
        unsigned* bar = b.bar; const unsigned bx = (unsigned)__builtin_amdgcn_readfirstlane(opaque((int)b.x));
        __builtin_amdgcn_s_waitcnt(0);
        unsigned nloc = b.st[0], nx = b.st[1];
        if (nloc == 0u) { xcd_barrier_complete(bar, bx, nloc, nx); b.st[0] = nloc; b.st[1] = nx; }
        const unsigned old = xb_add(&bar[XB_XSUB(bx)], 1u);
        const unsigned gen = old / nloc;
        if (old + 1u == (gen + 1u) * nloc) {
            __builtin_amdgcn_fence(__ATOMIC_RELEASE, "agent");
            asm volatile("s_waitcnt vmcnt(0)" ::: "memory");
            const unsigned og = xb_add(&bar[XB_TOP], 1u);
            const unsigned tg = og / nx;
            if (og + 1u == (tg + 1u) * nx) xb_add(&bar[XB_TOPGEN], 1u);
            else XB_SPIN(xb_ld(&bar[XB_TOPGEN]) == tg, bar);
            __builtin_amdgcn_fence(__ATOMIC_ACQUIRE, "agent");
            xb_add(&bar[XB_XGEN(bx)], 1u);
            asm volatile("s_waitcnt vmcnt(0)" ::: "memory");
        } else {
            XB_SPIN(xb_ld(&bar[XB_XGEN(bx)]) == gen, bar);
            __builtin_amdgcn_fence(__ATOMIC_ACQUIRE, "agent");
            asm volatile("s_waitcnt vmcnt(0)" ::: "memory");
        }
    }
    __syncthreads();
}
#endif

namespace pg8 {
constexpr int BM = 256, BK = 64, HALF = 128, HTB = HALF * BK * 2, STAGE_BYTES = 8 * HTB, NXCD = 8, WGM = 8;
__host__ __device__ __forceinline__ int lds_byte(int r, int c) { const int st = (r >> 4) * 2 + (c >> 5), rr = r & 15, cc = c & 31, ob = rr * 64 + cc * 2; return st * 1024 + (ob ^ (((ob >> 9) & 1) << 5)); }
__host__ __device__ __forceinline__ void stage_rc(int b, int& R, int& C) { const int st = b / 1024, sb = b % 1024, swz = sb ^ (((sb >> 9) & 1) << 5); R = (st >> 1) * 16 + swz / 64; C = (st & 1) * 32 + (swz % 64) / 2; }
__host__ __device__ __forceinline__ int perm32(int rho) { const int n = rho >> 4, i = rho & 15; return 8 * (i >> 2) + 4 * n + (i & 3); }
struct Unit { int pm, pn; };
struct Gemm { const bf16_t* A; const bf16_t* Bt; int lda, ldb, K; };
struct StaticOrder {
    int nM, nN, nwg, G, c;
    __host__ __device__ void init(int M, int N, int G_, int c_) { nM = M / BM; nN = N / BM; nwg = nM * nN; G = G_; c = c_; }
    __host__ __device__ bool next(int i, Unit& u) const {
        const long L = (long)i * G + c; if (L >= nwg) return false;
        int wgid = (int)L; { const int q = nwg / NXCD, r = nwg % NXCD, xcd = wgid % NXCD, off = wgid / NXCD; wgid = (xcd < r ? xcd * (q + 1) : r * (q + 1) + (xcd - r) * q) + off; }
        const int nig = WGM * nN, gid = wgid / nig, fm = gid * WGM, gsz = (nM - fm) < WGM ? (nM - fm) : WGM;
        u.pm = fm + ((wgid % nig) % gsz); u.pn = (wgid % nig) / gsz; return true;
    }
};
struct GroupOrder {
    int G, c;
    __host__ __device__ bool next(int i, Unit& u) const { const int idx = i * G + c; if (idx >= S5_GROUPS * NCHT) return false; const int g = idx / NCHT; u.pm = idx; u.pn = g; return true; }
};

template <class Epi, class Sched>
__device__ __forceinline__ void gemm_phase(LAS unsigned char* lds, const int wave_id, const Gemm g, const Sched& S, const Epi& E) {
    const int lane = LANE_ID(), wid = opaque_s(wave_id), tid = wid * 64 + lane, wr = wid >> 2, wc = wid & 3, fr = lane & 15, fq = lane >> 4;
    const int K = g.K, nt = K / BK;
    unsigned voffA[2], voffB[2];
#pragma unroll
    for (int i = 0; i < 2; ++i) { int R, C; stage_rc(tid * 16 + i * 8192, R, C); const int Rb = Epi::PERM ? ((R & ~31) + perm32(R & 31)) : R;
        voffA[i] = (unsigned)(R * g.lda + C) * 2u; voffB[i] = (unsigned)(Rb * g.ldb + C) * 2u; }
    const size_t kstep = (size_t)(BK * 2);
    const size_t hstepA = (size_t)HALF * g.lda * 2, hstepB = (size_t)HALF * g.ldb * 2;
    const size_t tstepA = 2 * hstepA, tstepB = 2 * hstepB;
    const unsigned ldsw = (unsigned)wid * 1024u;
    const int aoff = lds_byte(wr * 64 + fr, fq * 8), boff = lds_byte(wc * 32 + fr, fq * 8);
#define PG8_SA(b, h) (((b) * 2 + (h)) * HTB)
#define PG8_SB(b, h) ((4 + (b) * 2 + (h)) * HTB)
#define PG8_STAGE(bufoff, gbase, voff) do { const char* _gb = uni_ptr((const char*)(gbase));     \
    _Pragma("unroll") for (int _i = 0; _i < 2; ++_i) \
        GLDS16B(_gb, (voff)[_i], lds + (bufoff) + ldsw + _i * 8192); } while (0)
#define PG8_LDA(dst, b, h) do { _Pragma("unroll") for (int m = 0; m < 4; ++m) _Pragma("unroll") for (int k = 0; k < 2; ++k) dst[m][k] = *(const LAS bf16x8*)(lds + PG8_SA(b, h) + aoff + m * 2048 + k * 1024); } while (0)
#define PG8_LDB(dst, b, h) do { _Pragma("unroll") for (int n = 0; n < 2; ++n) _Pragma("unroll") for (int k = 0; k < 2; ++k) dst[n][k] = *(const LAS bf16x8*)(lds + PG8_SB(b, h) + boff + n * 2048 + k * 1024); } while (0)
#define PG8_MMA(ai, bj, At, Bt) do { SETPRIO(1); _Pragma("unroll") for (int m = 0; m < 4; ++m) _Pragma("unroll") for (int n = 0; n < 2; ++n) _Pragma("unroll") for (int k = 0; k < 2; ++k) \
        acc[ai][bj][m][n] = MFMA16(Bt[n][k], At[m][k], acc[ai][bj][m][n]); SETPRIO(0); } while (0)
#define PG8_BAR S_BARRIER()
    Unit cur, nxt; int ui = 0;
    if (!S.next(0, cur)) return;
    f32x4 acc[2][2][4][2];
#pragma unroll
    for (int a = 0; a < 2; ++a)
#pragma unroll
        for (int b = 0; b < 2; ++b)
#pragma unroll
            for (int m = 0; m < 4; ++m)
#pragma unroll
                for (int n = 0; n < 2; ++n) acc[a][b][m][n] = (f32x4){0.f, 0.f, 0.f, 0.f};
    bf16x8 At[4][2], B0[2][2], B1[2][2];
    const char* cA = (const char*)g.A + (size_t)cur.pm * tstepA; const char* cB = (const char*)g.Bt + (size_t)cur.pn * tstepB;
    PG8_STAGE(PG8_SB(0, 0), cB, voffB); PG8_STAGE(PG8_SB(0, 1), cB + hstepB, voffB); PG8_STAGE(PG8_SA(0, 0), cA, voffA); PG8_STAGE(PG8_SA(0, 1), cA + hstepA, voffA);
    if (wr == 1) PG8_BAR;
    WAIT_V(2); PG8_BAR;
    PG8_STAGE(PG8_SB(1, 0), cB + kstep, voffB); PG8_STAGE(PG8_SA(1, 0), cA + kstep, voffA); PG8_STAGE(PG8_SB(1, 1), cB + hstepB + kstep, voffB);
    WAIT_V(6); PG8_BAR;
    for (;;) {
        const bool has_next = S.next(ui + 1, nxt);
        const char* nA = has_next ? (const char*)g.A + (size_t)nxt.pm * tstepA : cA; const char* nB = has_next ? (const char*)g.Bt + (size_t)nxt.pn * tstepB : cB;
        for (int t = 0; t < nt; t += 2) {
            const bool last = (t == nt - 2);
            const char* a1 = cA + (size_t)(t + 1) * kstep;
            const char* a2 = last ? nA : cA + (size_t)(t + 2) * kstep; const char* b2 = last ? nB : cB + (size_t)(t + 2) * kstep;
            const char* a3 = a2 + kstep; const char* b3 = b2 + kstep;
            PG8_LDB(B0, 0, 0); PG8_LDB(B1, 0, 1); SCHED_BAR(); PG8_LDA(At, 0, 0); PG8_STAGE(PG8_SA(1, 1), a1 + hstepA, voffA);
            WAIT_V(8); WAIT_L(0); PG8_BAR; PG8_MMA(0, 0, At, B0); PG8_MMA(0, 1, At, B1); PG8_BAR; SCHED_BAR();
            PG8_LDA(At, 0, 1); PG8_STAGE(PG8_SB(0, 0), b2, voffB); PG8_STAGE(PG8_SB(0, 1), b2 + hstepB, voffB); PG8_STAGE(PG8_SA(0, 0), a2, voffA);
            WAIT_V(8); WAIT_L(0); PG8_BAR; PG8_MMA(1, 0, At, B0); PG8_MMA(1, 1, At, B1); PG8_BAR; SCHED_BAR();
            PG8_LDB(B0, 1, 0); PG8_LDB(B1, 1, 1); SCHED_BAR(); PG8_LDA(At, 1, 0); PG8_STAGE(PG8_SA(0, 1), a2 + hstepA, voffA);
            WAIT_V(8); WAIT_L(0); PG8_BAR; PG8_MMA(0, 0, At, B0); PG8_MMA(0, 1, At, B1); PG8_BAR; SCHED_BAR();
            PG8_LDA(At, 1, 1); PG8_STAGE(PG8_SB(1, 0), b3, voffB); PG8_STAGE(PG8_SB(1, 1), b3 + hstepB, voffB); PG8_STAGE(PG8_SA(1, 0), a3, voffA);
            WAIT_V(8); WAIT_L(0); PG8_BAR; PG8_MMA(1, 0, At, B0); PG8_MMA(1, 1, At, B1); PG8_BAR; SCHED_BAR();
        }
        if (wr == 0) PG8_BAR;
        { const int le = LANE_ID(); E(acc, cur, wr, wc, le & 15, le >> 4); }
        if (!has_next) break;
#pragma unroll
        for (int a = 0; a < 2; ++a)
#pragma unroll
            for (int b = 0; b < 2; ++b)
#pragma unroll
                for (int m = 0; m < 4; ++m)
#pragma unroll
                    for (int n = 0; n < 2; ++n) acc[a][b][m][n] = (f32x4){0.f, 0.f, 0.f, 0.f};
        cur = nxt; cA = nA; cB = nB; ++ui;
        if (wr == 1) PG8_BAR;
    }
    WAIT_V(0);
    PG8_BAR;
#undef PG8_SA
#undef PG8_SB
#undef PG8_STAGE
#undef PG8_LDA
#undef PG8_LDB
#undef PG8_MMA
#undef PG8_BAR
}
}
using pg8::Unit;

#ifdef EMU
#define SHFL_XOR_F(v, m) __shfl_xor(v, m)
#define SHFL_IDX_U(v, i) __shfl(v, i)
__device__ __forceinline__ float sum_x16(float s) { return s + __shfl_xor(s, 16); }
__device__ __forceinline__ float sum_x32(float s) { return s + __shfl_xor(s, 32); }
#else
#define SHFL_XOR_F(v, m) __builtin_bit_cast(float, __builtin_amdgcn_ds_swizzle(__builtin_bit_cast(int, (float)(v)), (((m) << 10) | 0x1F)))
#define SHFL_IDX_U(v, i) ((unsigned)__builtin_amdgcn_ds_bpermute((i) << 2, (int)(v)))
__device__ __forceinline__ float sum_x16(float s) { float a = s, b = s; asm("s_nop 1\n\tv_permlane16_swap_b32 %0, %1" : "+v"(a), "+v"(b)); return a + b; }
__device__ __forceinline__ float sum_x32(float s) { float a = s, b = s; asm("s_nop 1\n\tv_permlane32_swap_b32 %0, %1" : "+v"(a), "+v"(b)); return a + b; }
#endif
__device__ __forceinline__ float quad_sum(float s) { return sum_x32(sum_x16(s)); }

template <bool GLU> struct EpiRes {
    static constexpr bool PERM = true;
    bf16_t* xb; float* xout; u64* rowss;
    __device__ __forceinline__ void operator()(const f32x4 (&acc)[2][2][4][2], const Unit& u, int wr, int wc, int fr, int fq) const {
        PIN1(fr); PIN1(fq);
        constexpr int NB = GLU ? 1 : 2;
        const bool last = xout != nullptr;
#pragma unroll
        for (int ai = 0; ai < 2; ++ai) {
            u32x4 xo[4][NB];
#pragma unroll
            for (int m = 0; m < 4; ++m) { const int r = u.pm * 256 + ai * 128 + wr * 64 + m * 16 + fr;
#pragma unroll
                for (int bj = 0; bj < NB; ++bj) { const size_t off = (size_t)r * D_MODEL + (GLU ? u.pn * 128 : u.pn * 256 + bj * 128) + wc * 32 + 8 * fq; xo[m][bj] = *(const u32x4*)(xb + off); } }
#pragma unroll
            for (int m = 0; m < 4; ++m) { const int r = u.pm * 256 + ai * 128 + wr * 64 + m * 16 + fr; float ss = 0.f;
#pragma unroll
                for (int bj = 0; bj < NB; ++bj) { const size_t off = (size_t)r * D_MODEL + (GLU ? u.pn * 128 : u.pn * 256 + bj * 128) + wc * 32 + 8 * fq; f32x4 o[2];
                    const unsigned xw[4] = {xo[m][bj].x, xo[m][bj].y, xo[m][bj].z, xo[m][bj].w};
#pragma unroll
                    for (int n = 0; n < 2; ++n)
#pragma unroll
                        for (int i = 0; i < 4; ++i) { const unsigned w2 = xw[2 * n + (i >> 1)]; const float xv = (i & 1) ? bfhi(w2) : bflo(w2);
                            const float t = xv + (GLU ? acc[ai][0][m][n][i] * sigmoidf_(acc[ai][1][m][n][i]) : acc[ai][bj][m][n][i]); o[n][i] = t; ss += t * t; }
                    if (last) { *(f32x4*)(xout + off) = o[0]; *(f32x4*)(xout + off + 4) = o[1]; }
                    else { u32x4 w; w.x = pk2(o[0][0], o[0][1]); w.y = pk2(o[0][2], o[0][3]); w.z = pk2(o[1][0], o[1][1]); w.w = pk2(o[1][2], o[1][3]); *(u32x4*)(xb + off) = w; } }
                if (!last) { ss = quad_sum(ss); if (fq == 0) atomicAdd(rowss + r, (u64)(ss * SS_FIX)); } }
        }
    }
};
struct EpiSwiGLU {
    static constexpr bool PERM = true;
    bf16_t* act; const u64* rowss;
    __device__ __forceinline__ void operator()(const f32x4 (&acc)[2][2][4][2], const Unit& u, int wr, int wc, int fr, int fq) const {
        PIN1(fr); PIN1(fq);
        float rsv8[8]; row_rs8(rsv8, rowss, u.pm * 256 + wr * 64 + fr);
#pragma unroll
        for (int ai = 0; ai < 2; ++ai)
#pragma unroll
            for (int m = 0; m < 4; ++m) {
                const int r = u.pm * 256 + ai * 128 + wr * 64 + m * 16 + fr; const float rs = rsv8[ai * 4 + m], rs2 = rs * rs, nrs = -1.4426950408889634f * rs;
                float o[8];
#pragma unroll
                for (int n = 0; n < 2; ++n)
#pragma unroll
                    for (int i = 0; i < 4; ++i) { const float g_ = acc[ai][0][m][n][i], u_ = acc[ai][1][m][n][i]; o[4 * n + i] = (g_ * u_) * (rs2 * RCPF(1.0f + EXP2F(nrs * g_))); }
                u32x4 w; w.x = pk2(o[0], o[1]); w.y = pk2(o[2], o[3]); w.z = pk2(o[4], o[5]); w.w = pk2(o[6], o[7]);
                *(u32x4*)(act + (size_t)r * D_FF + u.pn * 128 + wc * 32 + 8 * fq) = w;
            }
    }
};
struct EpiInProj {
    static constexpr bool PERM = true;
    bf16_t *Q, *Kb, *V, *QI, *KI; float* WI; const u64* rowss; const float* rope; const float* qg; const float* kg;
    __device__ __forceinline__ void operator()(const f32x4 (&acc)[2][2][4][2], const Unit& u, int wr, int wc, int fr, int fq) const {
        PIN1(fr); PIN1(fq);
        const int pn = u.pn; const int r0 = u.pm * 256 + wr * 64 + fr;
        if (pn >= 2 * NH4 && pn < 3 * NH4) {
            float rsv[8]; row_rs8(rsv, rowss, r0);
#pragma unroll
            for (int it = 0; it < 8; ++it) { const int ai = it >> 2, m = it & 3; const int r = r0 + ai * 128 + m * 16; const float rs = rsv[it];
                const size_t off = (size_t)r * D_MODEL + (pn - 2 * NH4) * 256 + wc * 32 + 8 * fq; u32x4 w;
                w.x = pk2(rs * acc[ai][0][m][0][0], rs * acc[ai][0][m][0][1]); w.y = pk2(rs * acc[ai][0][m][0][2], rs * acc[ai][0][m][0][3]); w.z = pk2(rs * acc[ai][0][m][1][0], rs * acc[ai][0][m][1][1]); w.w = pk2(rs * acc[ai][0][m][1][2], rs * acc[ai][0][m][1][3]); *(u32x4*)(V + off) = w;
                w.x = pk2(rs * acc[ai][1][m][0][0], rs * acc[ai][1][m][0][1]); w.y = pk2(rs * acc[ai][1][m][0][2], rs * acc[ai][1][m][0][3]); w.z = pk2(rs * acc[ai][1][m][1][0], rs * acc[ai][1][m][1][1]); w.w = pk2(rs * acc[ai][1][m][1][2], rs * acc[ai][1][m][1][3]); *(u32x4*)(V + off + 128) = w; }
            return;
        }
        const bool last = (pn == 3 * NH4 + 2);
        if (last && wc == 1) {
#pragma unroll
            for (int it = 0; it < 8; ++it) { const int ai = it >> 2, m = it & 3; const int r = r0 + ai * 128 + m * 16; const float sc = row_rs(rowss, r) * (0.35355339059327373f * 0.125f);
                if (fq == 0) { *(f32x4*)(WI + (size_t)r * 8) = (f32x4){acc[ai][0][m][0][0] * sc, acc[ai][0][m][0][1] * sc, acc[ai][0][m][0][2] * sc, acc[ai][0][m][0][3] * sc};
                               *(f32x4*)(WI + (size_t)r * 8 + 4) = (f32x4){acc[ai][0][m][1][0] * sc, acc[ai][0][m][1][1] * sc, acc[ai][0][m][1][2] * sc, acc[ai][0][m][1][3] * sc}; } }
            return;
        }
        if (last && wc != 0) return;
        const bool isq = pn < NH4, isk = (pn >= NH4 && pn < 2 * NH4), nrm = isq || isk || last;
        float g1[8], g2[8];
        { const float* gn = isq ? qg : kg;
#pragma unroll
          for (int i = 0; i < 8; ++i) { g1[i] = (isq || isk) ? gn[8 * fq + i] : 1.0f; g2[i] = (isq || isk) ? gn[32 + 8 * fq + i] : 1.0f; } }
        const float qs = isq ? C2 : 1.0f;
        bf16_t* dst0;
        if (isq) dst0 = Q + (size_t)r0 * D_MODEL + (pn * 4 + wc) * 64; else if (isk) dst0 = Kb + (size_t)r0 * D_MODEL + ((pn - NH4) * 4 + wc) * 64;
        else if (last) dst0 = KI + (size_t)r0 * 64; else dst0 = QI + (size_t)r0 * 512 + ((pn - 3 * NH4) * 4 + wc) * 64;
        const size_t dstride = (isq || isk) ? (size_t)D_MODEL : (last ? (size_t)64 : (size_t)512);
        f32x4 cn[4]; float rsn;
        { const float* cs = rope + (size_t)r0 * 64 + 8 * fq; rsn = row_rs(rowss, r0); cn[0] = *(const f32x4*)cs; cn[1] = *(const f32x4*)(cs + 4); cn[2] = *(const f32x4*)(cs + 32); cn[3] = *(const f32x4*)(cs + 36); }
#pragma unroll
        for (int it = 0; it < 8; ++it) { const int ai = it >> 2, m = it & 3; const int rofs = ai * 128 + m * 16;
            const f32x4 c0 = cn[0], c1 = cn[1], s0 = cn[2], s1 = cn[3]; const float rs = rsn;
            if (it < 7) { const int rn_ = r0 + ((it + 1) >> 2) * 128 + ((it + 1) & 3) * 16; const float* cs = rope + (size_t)rn_ * 64 + 8 * fq; rsn = row_rs(rowss, rn_);
                cn[0] = *(const f32x4*)cs; cn[1] = *(const f32x4*)(cs + 4); cn[2] = *(const f32x4*)(cs + 32); cn[3] = *(const f32x4*)(cs + 36); }
            float t1[8], t2[8];
#pragma unroll
            for (int n = 0; n < 2; ++n)
#pragma unroll
                for (int i = 0; i < 4; ++i) { t1[4 * n + i] = acc[ai][0][m][n][i]; t2[4 * n + i] = acc[ai][1][m][n][i]; }
            float f = rs * qs;
            if (nrm) {
                float ss = 0.f;
#pragma unroll
                for (int i = 0; i < 8; ++i) ss += t1[i] * t1[i] + t2[i] * t2[i];
                ss = quad_sum(ss); f *= RSQF(rs * rs * ss * (1.0f / 64.0f) + EPS);
            }
#pragma unroll
            for (int i = 0; i < 8; ++i) { t1[i] *= f * g1[i]; t2[i] *= f * g2[i]; }
            const float cc[8] = {c0[0], c0[1], c0[2], c0[3], c1[0], c1[1], c1[2], c1[3]}, sv[8] = {s0[0], s0[1], s0[2], s0[3], s1[0], s1[1], s1[2], s1[3]};
            float o1[8], o2[8];
#pragma unroll
            for (int i = 0; i < 8; ++i) { o1[i] = t1[i] * cc[i] - t2[i] * sv[i]; o2[i] = t2[i] * cc[i] + t1[i] * sv[i]; }
            bf16_t* dst = dst0 + (size_t)rofs * dstride;
            u32x4 w; w.x = pk2(o1[0], o1[1]); w.y = pk2(o1[2], o1[3]); w.z = pk2(o1[4], o1[5]); w.w = pk2(o1[6], o1[7]); *(u32x4*)(dst + 8 * fq) = w;
            w.x = pk2(o2[0], o2[1]); w.y = pk2(o2[2], o2[3]); w.z = pk2(o2[4], o2[5]); w.w = pk2(o2[6], o2[7]); *(u32x4*)(dst + 32 + 8 * fq) = w;
        }
    }
};
struct EpiS5State {
    static constexpr bool PERM = true;
    bf16_t* S;
    __device__ __forceinline__ void operator()(const f32x4 (&acc)[2][2][4][2], const Unit& u, int wr, int wc, int fr, int fq) const {
        PIN1(fr); PIN1(fq);
#pragma unroll
        for (int ai = 0; ai < 2; ++ai)
#pragma unroll
            for (int m = 0; m < 4; ++m) { const size_t row = (size_t)u.pm * 256 + ai * 128 + wr * 64 + m * 16 + fr;
                u32x4 w; w.x = pk2(acc[ai][0][m][0][0], acc[ai][0][m][0][1]); w.y = pk2(acc[ai][0][m][0][2], acc[ai][0][m][0][3]); w.z = pk2(acc[ai][0][m][1][0], acc[ai][0][m][1][1]); w.w = pk2(acc[ai][0][m][1][2], acc[ai][0][m][1][3]);
                *(u32x4*)(S + row * 128 + wc * 32 + 8 * fq) = w; }
    }
};
struct EpiS5Out {
    static constexpr bool PERM = true;
    bf16_t* Y; const bf16_t* UX; const float* dskip;
    __device__ __forceinline__ void operator()(const f32x4 (&acc)[2][2][4][2], const Unit& u, int wr, int wc, int fr, int fq) const {
        PIN1(fr); PIN1(fq);
        const int g = u.pn;
        float dk[8];
        { const float* dp = dskip + 16 * g + ((wc * 32 + 8 * fq) & 15);
#pragma unroll
          for (int e = 0; e < 8; ++e) dk[e] = dp[e]; }
#pragma unroll
        for (int ai = 0; ai < 2; ++ai)
#pragma unroll
            for (int mp = 0; mp < 2; ++mp) {
                u32x4 uw[2][2];
#pragma unroll
                for (int mm = 0; mm < 2; ++mm) { const size_t row = (size_t)u.pm * 256 + ai * 128 + wr * 64 + (2 * mp + mm) * 16 + fr;
#pragma unroll
                    for (int bj = 0; bj < 2; ++bj) uw[mm][bj] = *(const u32x4*)(UX + row * UXW + bj * 128 + wc * 32 + 8 * fq); }
#pragma unroll
                for (int mm = 0; mm < 2; ++mm) { const int m = 2 * mp + mm; const size_t row = (size_t)u.pm * 256 + ai * 128 + wr * 64 + m * 16 + fr; const int c = (int)(row - (size_t)g * NCH);
#pragma unroll
                    for (int bj = 0; bj < 2; ++bj) { const int col = bj * 128 + wc * 32 + 8 * fq, i = col >> 4, ho = col & 15;
                        float o[8]; const unsigned uu[4] = {uw[mm][bj].x, uw[mm][bj].y, uw[mm][bj].z, uw[mm][bj].w};
#pragma unroll
                        for (int n = 0; n < 2; ++n)
#pragma unroll
                            for (int j = 0; j < 4; ++j) { const int e = 4 * n + j; const float uv = (e & 1) ? bfhi(uu[e >> 1]) : bflo(uu[e >> 1]); o[e] = gelu_tanh(acc[ai][bj][m][n][j] + dk[e] * uv); }
                        u32x4 w; w.x = pk2(o[0], o[1]); w.y = pk2(o[2], o[3]); w.z = pk2(o[4], o[5]); w.w = pk2(o[6], o[7]);
                        *(u32x4*)(Y + (size_t)(16 * c + i) * D_MODEL + 16 * g + ho) = w; } }
            }
    }
};

constexpr int RING_BYTES = 131072, LDSCTL_OFF = RING_BYTES, LDS_BYTES = 147456;
struct Args { const float* in[18]; float* out; unsigned char* ws; };
struct Frame {
    LAS unsigned char* lds; int tid, lane, wave, vcu, G;
    const float* in[18]; float* out; unsigned char* ws;
};
__device__ __forceinline__ float wave_sum(float v) {
    v += SHFL_XOR_F(v, 1); v += SHFL_XOR_F(v, 2); v += SHFL_XOR_F(v, 4); v += SHFL_XOR_F(v, 8); v += SHFL_XOR_F(v, 16);
    return sum_x32(v);
}
__device__ __forceinline__ int win_src(int np) {
    const int pn = np >> 8, y = np & 255, bj = y >> 7, hh = (y >> 5) & 3, dd = y & 31;
    if (pn < 2 * NH4) { const int base = pn < NH4 ? 0 : D_MODEL, t = pn < NH4 ? pn : pn - NH4; return base + (4 * t + hh) * 64 + 32 * bj + dd; }
    if (pn < 3 * NH4) return np;
    if (pn < 3 * NH4 + 2) return 3 * D_MODEL + (4 * (pn - 3 * NH4) + hh) * 64 + 32 * bj + dd;
    if (hh == 0) return 3 * D_MODEL + 512 + 32 * bj + dd;
    if (hh == 1 && bj == 0 && dd < 8) return 3 * D_MODEL + 512 + 64 + dd;
    return -1;
}
__device__ __forceinline__ int glu_src(int np, int HW) { const int pn = np >> 8, y = np & 255; return (y >> 7) * HW + pn * 128 + (y & 127); }

struct TItem { const float* W; const float* gain; bf16_t* WT; int K, N, HW, NP, mode, item; };
__device__ __forceinline__ void ti_load(const TItem& T, float (&v)[32], f32x4 (&g)[2], int lane) {
    const int nblk = T.NP / 32, kb = T.item / nblk, nb = T.item % nblk, k0 = 64 * kb, n0 = 32 * nb;
    const int np = n0 + (lane & 31); const int src = T.mode == 0 ? np : (T.mode == 1 ? glu_src(np, T.HW) : win_src(np));
    const float* wp = T.W + (size_t)(k0 + (lane >> 5)) * T.N + (src >= 0 ? src : 0);
#pragma unroll
    for (int i = 0; i < 32; ++i) { const float x = wp[(size_t)(2 * i) * T.N]; v[i] = (src >= 0) ? x : 0.f; }
    if (T.gain) { g[0] = *(const f32x4*)(T.gain + k0 + 8 * (lane & 7)); g[1] = *(const f32x4*)(T.gain + k0 + 8 * (lane & 7) + 4); }
    else { g[0] = (f32x4){1.f, 1.f, 1.f, 1.f}; g[1] = g[0]; }
}
__device__ __forceinline__ void ti_finish(const TItem& T, const float (&v)[32], const f32x4 (&g)[2], LAS float* scr, int lane) {
    const int nblk = T.NP / 32, kb = T.item / nblk, nb = T.item % nblk, k0 = 64 * kb, n0 = 32 * nb;
#pragma unroll
    for (int i = 0; i < 32; ++i) scr[(2 * i + (lane >> 5)) * 33 + (lane & 31)] = v[i];
    WAIT_L(0);
    const int c = lane & 7;
#pragma unroll
    for (int j = 0; j < 4; ++j) { const int n = (lane >> 3) + 8 * j; const LAS float* q = scr + (8 * c) * 33 + n;
        u32x4 o; o.x = pk2(q[0 * 33] * g[0][0], q[1 * 33] * g[0][1]); o.y = pk2(q[2 * 33] * g[0][2], q[3 * 33] * g[0][3]); o.z = pk2(q[4 * 33] * g[1][0], q[5 * 33] * g[1][1]); o.w = pk2(q[6 * 33] * g[1][2], q[7 * 33] * g[1][3]);
        *(u32x4*)(T.WT + (size_t)(n0 + n) * T.K + k0 + 8 * c) = o; }
    WAIT_L(0);
}
__device__ __forceinline__ void s5_pre(Frame& F0) {
    Frame F = F0; F.lane = LANE_ID(); F.tid = F0.wave * 64 + F.lane;
    static_assert((SEGL & (SEGL - 1)) == 0, "a^(16 SEGL) by repeated squaring");
    for (int jg = blockIdx.x; jg < N_S5 * S5_GROUPS; jg += F.G) {
        const float* lre = F.in[1] + (size_t)jg * 64; const float* lim = F.in[2] + (size_t)jg * 64; const float* bre = F.in[4] + (size_t)jg * 1024; const float* bim = F.in[5] + (size_t)jg * 1024;
        float* pre = (float*)(F.ws + WS_S5PRE + (size_t)jg * S5PRE_STRIDE);
        if (F.tid < 64) { const int p = F.tid;
            const double dt = exp((double)F.in[3][jg]), lr = lre[p], li = lim[p], m = exp(lr * dt), ar = m * cos(li * dt), ai = m * sin(li * dt);
            double pr = 1.0, pi = 0.0, a16r = 1.0, a16i = 0.0;
            for (int tau = 0; tau < 18; ++tau) { pre[(tau * 64 + p) * 2] = (float)pr; pre[(tau * 64 + p) * 2 + 1] = (float)pi; if (tau == 16) { a16r = pr; a16i = pi; }
                const double nr = pr * ar - pi * ai, ni = pr * ai + pi * ar; pr = nr; pi = ni; }
            const double den = lr * lr + li * li, qr = ((ar - 1.0) * lr + ai * li) / den, qi = (ai * lr - (ar - 1.0) * li) / den;
            for (int h = 0; h < 16; ++h) { const int e = p * 16 + h; const double br = bre[e], bi = bim[e]; pre[2304 + e * 2] = (float)(qr * br - qi * bi); pre[2304 + e * 2 + 1] = (float)(qr * bi + qi * br); }
            double sr = a16r, si = a16i;
            for (int k = SEGL; k > 1; k >>= 1) { const double nr = sr * sr - si * si, ni = 2.0 * sr * si; sr = nr; si = ni; }
            f32x4 v; v.x = (float)a16r; v.y = (float)a16i; v.z = (float)sr; v.w = (float)si;
            *(f32x4*)(pre + 4352 + p * 4) = v; }
    }
}
__device__ __forceinline__ void s5_setup(Frame& F0) {
    Frame F = F0; F.lane = LANE_ID(); F.tid = F0.wave * 64 + F.lane;
    LAS float* ap = (LAS float*)F.lds;
    LAS float* bb = ap + 18 * 128;
    LAS float* cc = bb + 2048;
    LAS float* kt = cc + 2048;
    for (int jg = blockIdx.x; jg < N_S5 * S5_GROUPS; jg += F.G) {
        const int j = jg / S5_GROUPS, g = jg % S5_GROUPS;
        const float* cre = F.in[6] + (size_t)j * S5_GROUPS * 1024; const float* cim = F.in[7] + (size_t)j * S5_GROUPS * 1024;
        bf16_t* AM = (bf16_t*)(F.ws + WS_S5TAB + (size_t)j * SZ_S5TAB + MIX_AM); bf16_t* W1 = (bf16_t*)(F.ws + WS_S5TAB + (size_t)j * SZ_S5TAB + MIX_W1);
        __syncthreads();
        const float* pre = (const float*)(F.ws + WS_S5PRE + ((size_t)j * S5_GROUPS + g) * S5PRE_STRIDE);
        for (int e = F.tid; e < 4352; e += NTHREADS) ap[e] = pre[e];
        for (int e = F.tid; e < 1024; e += NTHREADS) { cc[e * 2] = cre[(size_t)g * 1024 + e]; cc[e * 2 + 1] = cim[(size_t)g * 1024 + e]; }
        __syncthreads();
        if (F.tid < 256) { const int tau = F.tid >> 4, ho = F.tid & 15; float sk[16];
#pragma unroll
            for (int hi = 0; hi < 16; ++hi) sk[hi] = 0.f;
            for (int p = 0; p < 64; ++p) { const float cr = cc[(ho * 64 + p) * 2], ci = cc[(ho * 64 + p) * 2 + 1], ar = ap[(tau * 64 + p) * 2], ai = ap[(tau * 64 + p) * 2 + 1];
                const float xr = cr * ar - ci * ai, xi = cr * ai + ci * ar; const LAS f32x4* bq = (const LAS f32x4*)(bb + p * 32);
#pragma unroll
                for (int q = 0; q < 8; ++q) { const f32x4 b2 = bq[q]; sk[2 * q] += xr * b2.x - xi * b2.y; sk[2 * q + 1] += xr * b2.z - xi * b2.w; } }
#pragma unroll
            for (int hi = 0; hi < 16; ++hi) kt[F.tid * 16 + hi] = sk[hi]; }
        __syncthreads();
        bf16_t* am = AM + (size_t)g * 256 * UXW;
        for (int e = F.tid; e < 256 * (UXW / 2); e += NTHREADS) { const int np = e / (UXW / 2), k = 2 * (e % (UXW / 2)), i = np >> 4, ho = np & 15; float v0, v1;
            if (k < 256) { const int jj = k >> 4, hi = k & 15; v0 = (jj <= i) ? kt[((i - jj) * 16 + ho) * 16 + hi] : 0.f; v1 = (jj <= i) ? kt[((i - jj) * 16 + ho) * 16 + hi + 1] : 0.f; }
            else { const int p = (k - 256) >> 1; const float cr = cc[(ho * 64 + p) * 2], ci = cc[(ho * 64 + p) * 2 + 1], ar = ap[((i + 1) * 64 + p) * 2], ai = ap[((i + 1) * 64 + p) * 2 + 1];
                v0 = cr * ar - ci * ai; v1 = -(cr * ai + ci * ar); }
            *(unsigned*)(am + (size_t)np * UXW + k) = pk2(v0, v1); }
        bf16_t* w1 = W1 + (size_t)g * 256 * 256;
        for (int e = F.tid; e < 256 * 128; e += NTHREADS) { const int np = e >> 7, k = 2 * (e & 127); float v[2] = {0.f, 0.f};
            if (np < 128) { const int p = np >> 1, comp = np & 1, jj = k >> 4;
#pragma unroll
                for (int t = 0; t < 2; ++t) { const int h = (k & 15) + t; const float ar = ap[((15 - jj) * 64 + p) * 2], ai = ap[((15 - jj) * 64 + p) * 2 + 1], br = bb[(p * 16 + h) * 2], bi = bb[(p * 16 + h) * 2 + 1];
                    v[t] = comp ? (ar * bi + ai * br) : (ar * br - ai * bi); } }
            *(unsigned*)(w1 + (size_t)np * 256 + k) = pk2(v[0], v[1]); }
    }
    __syncthreads();
}

constexpr int I_GLU = (D_MODEL / 64) * (2 * D_MODEL / 32), I_IN = (D_MODEL / 64) * (NIN_PAD / 32), I_O = (D_MODEL / 64) * (D_MODEL / 32), I_GU = (D_MODEL / 64) * (2 * D_FF / 32), I_DN = (D_FF / 64) * (D_MODEL / 32);
__device__ __forceinline__ int ti_layer_items(int layer) { return ((layer & 1) ? I_IN + I_O : I_GLU) + I_GU + I_DN; }
__device__ __forceinline__ TItem ti_decode_layer(const Frame& F, int layer, int r) {
    const int j = layer >> 1; TItem T;
    if ((layer & 1) == 0) { if (r < I_GLU) { T = TItem{F.in[9] + (size_t)j * D_MODEL * 2 * D_MODEL, nullptr, (bf16_t*)(F.ws + WS_WGLU + j * SZ_WGLU), D_MODEL, 2 * D_MODEL, D_MODEL, 2 * D_MODEL, 1, r}; return T; } r -= I_GLU; }
    else { if (r < I_IN) { T = TItem{F.in[10] + (size_t)j * D_MODEL * DSA_PROJ, F.in[16] + (size_t)(2 * j + 1) * D_MODEL, (bf16_t*)(F.ws + WS_WIN + j * SZ_WIN), D_MODEL, DSA_PROJ, 0, NIN_PAD, 2, r}; return T; } r -= I_IN;
           if (r < I_O) { T = TItem{F.in[13] + (size_t)j * D_MODEL * D_MODEL, nullptr, (bf16_t*)(F.ws + WS_WO + j * SZ_WO), D_MODEL, D_MODEL, 0, D_MODEL, 0, r}; return T; } r -= I_O; }
    if (r < I_GU) { T = TItem{F.in[14] + (size_t)layer * D_MODEL * 2 * D_FF, F.in[17] + (size_t)layer * D_MODEL, (bf16_t*)(F.ws + WS_WGU + layer * SZ_WGU), D_MODEL, 2 * D_FF, D_FF, 2 * D_FF, 1, r}; return T; } r -= I_GU;
    T = TItem{F.in[15] + (size_t)layer * D_FF * D_MODEL, nullptr, (bf16_t*)(F.ws + WS_WDN + layer * SZ_WDN), D_FF, D_MODEL, 0, D_MODEL, 0, r}; return T;
}
template <class ItemFn> __device__ __forceinline__ void convert_run(Frame& F, int layer, ItemFn item) {
    LAS float* scr = (LAS float*)(F.lds + 32768 + F.wave * 8704);
    const int nitems = ti_layer_items(layer);
    int it = item(0);
    if (it >= nitems) return;
    TItem cur = ti_decode_layer(F, layer, it); float v[32]; f32x4 g[2]; ti_load(cur, v, g, F.lane);
    for (int k = 1; ; ++k) {
        const int nit = item(k); const bool more = nit < nitems; TItem nxt = cur; float vn[32]; f32x4 gn[2];
        if (more) { nxt = ti_decode_layer(F, layer, nit); ti_load(nxt, vn, gn, F.lane); }
        ti_finish(cur, v, g, scr, F.lane);
        if (!more) break;
        cur = nxt; g[0] = gn[0]; g[1] = gn[1];
#pragma unroll
        for (int i = 0; i < 32; ++i) v[i] = vn[i];
    }
}
constexpr int CW_RATIO = 2;
__device__ __forceinline__ int cw_item(int k, bool busy, int w, int NBW, int BW) { const int P = CW_RATIO * NBW + BW; return busy ? k * P + CW_RATIO * NBW + w : (k / CW_RATIO) * P + (k % CW_RATIO) * NBW + w; }
__device__ __forceinline__ void convert_weights(Frame& F0) {
    Frame F = F0; F.lane = LANE_ID(); F.tid = F0.wave * 64 + F.lane;
    const int nbusy = N_S5 * S5_GROUPS < F.G ? N_S5 * S5_GROUPS : F.G, bx = (int)blockIdx.x;
    const bool busy = bx < nbusy; const int NBW = (F.G - nbusy) * NWAVES, BW = nbusy * NWAVES, w = busy ? bx * NWAVES + F.wave : (bx - nbusy) * NWAVES + F.wave;
    convert_run(F, 0, [&](int k) { return cw_item(k, busy, w, NBW, BW); });
}
__device__ __forceinline__ void convert_next_layer(Frame& F0, int layer) {
    Frame F = F0; F.lane = LANE_ID(); F.tid = F0.wave * 64 + F.lane;
    const int ntl = (SEQ / 256) * (2 * D_FF / 256), rem = ntl % F.G, bx = (int)blockIdx.x;
    WAIT_VM0(); __syncthreads();
    if (rem == 0 || bx >= rem) { const int rank = rem == 0 ? bx : bx - rem, cnt = rem == 0 ? F.G : F.G - rem; const int w0 = rank * NWAVES + F.wave, st = cnt * NWAVES;
        convert_run(F, layer, [&](int k) { return w0 + k * st; }); }
    __syncthreads();
}
__device__ __forceinline__ void prologue_rows(Frame& F0) {
    Frame F = F0; F.lane = LANE_ID(); F.tid = F0.wave * 64 + F.lane;
    const int gw = F.vcu * NWAVES + F.wave, NGW = F.G * NWAVES;
    u64* rowss0 = (u64*)(F.ws + WS_ROWSS); float* rope = (float*)(F.ws + WS_ROPE); bf16_t* XB = (bf16_t*)(F.ws + WS_XB);
    const float inv_freq = powf(10000.0f, -(float)(2 * (F.lane & 31)) / 64.0f);
    static_assert(D_MODEL % 256 == 0 && D_MODEL / 256 <= 4, "row chunks per lane");
    constexpr int NCK = D_MODEL / 256; f32x4 xv[NCK], xn[NCK];
    if (gw < SEQ) {
#pragma unroll
        for (int k = 0; k < NCK; ++k) xv[k] = *(const f32x4*)(F.in[0] + (size_t)gw * D_MODEL + F.lane * 4 + 256 * k); }
    for (int m = gw; m < SEQ; m += NGW) {
        float s = 0.f;
        if (m + NGW < SEQ) {
#pragma unroll
            for (int k = 0; k < NCK; ++k) xn[k] = *(const f32x4*)(F.in[0] + (size_t)(m + NGW) * D_MODEL + F.lane * 4 + 256 * k); }
#pragma unroll
        for (int k = 0; k < NCK; ++k) { const f32x4 v = xv[k]; s += (v.x * v.x + v.y * v.y) + (v.z * v.z + v.w * v.w);
            u32x2 w; w.x = pk2(v.x, v.y); w.y = pk2(v.z, v.w); *(u32x2*)(XB + (size_t)m * D_MODEL + F.lane * 4 + 256 * k) = w; }
#pragma unroll
        for (int k = 0; k < NCK; ++k) xv[k] = xn[k];
        s = wave_sum(s); if (F.lane == 0) rowss0[m] = (u64)(s * SS_FIX);
        if (F.lane < 32) { const float ang = (float)m * inv_freq;
            const double ad = (double)ang, nq = rint(ad * 0.63661977236758134308); const float r = (float)fma(-nq, 1.57079632679489661923, ad), r2 = r * r; const int qd = (int)nq & 3;
            const float sn = r + r * r2 * (-1.6666667163e-1f + r2 * (8.3333337680e-3f + r2 * (-1.9841270114e-4f + r2 * 2.7557314297e-6f)));
            const float cs = 1.0f + r2 * (-0.5f + r2 * (4.1666667908e-2f + r2 * (-1.3888889225e-3f + r2 * (2.4801587642e-5f + r2 * -2.7557314297e-7f))));
            const float c1 = (qd & 1) ? sn : cs, s1 = (qd & 1) ? cs : sn;
            rope[(size_t)m * 64 + F.lane] = (qd == 1 || qd == 2) ? -c1 : c1; rope[(size_t)m * 64 + 32 + F.lane] = (qd >= 2) ? -s1 : s1; }
    }
}

__device__ __forceinline__ void s5_build_ux(Frame& F0, const bf16_t* x, const u64* rowss, const float* gain) {
    Frame F = F0; F.lane = LANE_ID(); F.tid = F0.wave * 64 + F.lane;
    bf16_t* UX = (bf16_t*)(F.ws + WS_R + R_UX);
    const int gw = F.vcu * NWAVES + F.wave, NGW = F.G * NWAVES; const int j = F.lane >> 2, p = F.lane & 3;
    constexpr int NIT = NCH * (S5_GROUPS / 4);
    u32x4 xa, xc, na, nc; f32x4 gg[4], ng[4]; u64 ssq = 0, nss = 0;
#define BUX_LOAD(it_, A_, C_, G_, S_) do { const int c_ = (it_) / (S5_GROUPS / 4), gq_ = (it_) % (S5_GROUPS / 4), g_ = 4 * gq_ + p, t_ = 16 * c_ + j; const bf16_t* xr_ = x + (size_t)t_ * D_MODEL + 16 * g_; \
        A_ = *(const u32x4*)xr_; C_ = *(const u32x4*)(xr_ + 8); S_ = rowss[t_]; _Pragma("unroll") for (int q = 0; q < 4; ++q) G_[q] = *(const f32x4*)(gain + 16 * g_ + 4 * q); } while (0)
    if (gw < NIT) BUX_LOAD(gw, xa, xc, gg, ssq);
    for (int it = gw; it < NIT; it += NGW) { const int c = it / (S5_GROUPS / 4), gq = it % (S5_GROUPS / 4), g = 4 * gq + p;
        if (it + NGW < NIT) BUX_LOAD(it + NGW, na, nc, ng, nss);
        const float rs = rs_of(ssq); float v[16];
        const unsigned xw[8] = {xa.x, xa.y, xa.z, xa.w, xc.x, xc.y, xc.z, xc.w};
#pragma unroll
        for (int q = 0; q < 4; ++q) { v[4 * q] = bflo(xw[2 * q]) * rs * gg[q].x; v[4 * q + 1] = bfhi(xw[2 * q]) * rs * gg[q].y; v[4 * q + 2] = bflo(xw[2 * q + 1]) * rs * gg[q].z; v[4 * q + 3] = bfhi(xw[2 * q + 1]) * rs * gg[q].w; }
        bf16_t* dst = UX + ((size_t)g * NCH + c) * UXW + 16 * j;
        u32x4 w; w.x = pk2(v[0], v[1]); w.y = pk2(v[2], v[3]); w.z = pk2(v[4], v[5]); w.w = pk2(v[6], v[7]); *(u32x4*)dst = w;
        w.x = pk2(v[8], v[9]); w.y = pk2(v[10], v[11]); w.z = pk2(v[12], v[13]); w.w = pk2(v[14], v[15]); *(u32x4*)(dst + 8) = w;
        xa = na; xc = nc; ssq = nss;
#pragma unroll
        for (int q = 0; q < 4; ++q) gg[q] = ng[q]; }
#undef BUX_LOAD
}
__device__ __forceinline__ void s5_scan(Frame& F0, int j) {
    Frame F = F0; F.lane = LANE_ID(); F.tid = F0.wave * 64 + F.lane;
    bf16_t* UX = (bf16_t*)(F.ws + WS_R + R_UX); const bf16_t* S = (const bf16_t*)(F.ws + WS_R + R_S);
    constexpr int SPI = NTHREADS / NSEG, IPG = 64 / SPI;
    LAS float* E = (LAS float*)F.lds;
    const int pl = F.tid % SPI, seg = F.tid / SPI;
    for (int b = F.vcu; b < S5_GROUPS * IPG; b += F.G) { const int g = b / IPG, p = (b % IPG) * SPI + pl;
        __syncthreads();
        const f32x4 av = *(const f32x4*)((const float*)(F.ws + WS_S5PRE + ((size_t)j * S5_GROUPS + g) * S5PRE_STRIDE) + 4352 + p * 4); const float ar = av.x, ai = av.y, sr = av.z, si = av.w;
        const bf16_t* sp = S + ((size_t)g * NCH + (size_t)seg * SEGL) * 128 + 2 * p; float xr = 0.f, xi = 0.f;
        unsigned sv[SEGL];
#pragma unroll
        for (int c = 0; c < SEGL; ++c) sv[c] = *(const unsigned*)(sp + (size_t)c * 128);
#pragma unroll
        for (int c = 0; c < SEGL; ++c) { const float br = bflo(sv[c]), bi = bfhi(sv[c]); const float nr = ar * xr - ai * xi + br, ni = ar * xi + ai * xr + bi; xr = nr; xi = ni; }
        E[(seg * SPI + pl) * 2] = xr; E[(seg * SPI + pl) * 2 + 1] = xi;
        __syncthreads();
        xr = 0.f; xi = 0.f;
        for (int s = 0; s < seg; ++s) { const float er = E[(s * SPI + pl) * 2], ei = E[(s * SPI + pl) * 2 + 1]; const float nr = sr * xr - si * xi + er, ni = sr * xi + si * xr + ei; xr = nr; xi = ni; }
        bf16_t* up = UX + ((size_t)g * NCH + (size_t)seg * SEGL) * UXW + 256 + 2 * p;
#pragma unroll
        for (int c = 0; c < SEGL; ++c) { *(unsigned*)(up + (size_t)c * UXW) = pk2(xr, xi); const float br = bflo(sv[c]), bi = bfhi(sv[c]); const float nr = ar * xr - ai * xi + br, ni = ar * xi + ai * xr + bi; xr = nr; xi = ni; }
    }
    __syncthreads();
}

__device__ __forceinline__ void idx_kload(bf16x8 (&ka)[2][4], const bf16_t* KI, int k0, int lane) {
    const bf16_t* kp = KI + (size_t)(k0 + (lane & 31)) * 64 + 8 * (lane >> 5);
#pragma unroll
    for (int t = 0; t < 2; ++t)
#pragma unroll
        for (int ks = 0; ks < 4; ++ks) ka[t][ks] = *(const bf16x8*)(kp + (size_t)t * 32 * 64 + 16 * ks);
}
struct QAddr { int e[4], o[4], l[4]; };
constexpr int QLIN_OFF = 135168;
#ifdef EMU
#define QBASE(qt) 0
#define QPTR(qt, off) ((const LAS bf16x8*)((qt) + (off)))
#else
#define QBASE(qt) ((int)(unsigned)(size_t)(qt))
#define QPTR(qt, off) ((const LAS bf16x8*)(size_t)(unsigned)(off))
#endif
__device__ __forceinline__ QAddr idx_qaddr(int lane, const LAS unsigned char* qt) { QAddr A; const int ql = lane & 31, hi = lane >> 5, s3 = (ql >> 3) & 1, qb = QBASE(qt);
#pragma unroll
    for (int ks = 0; ks < 4; ++ks) { const int lo = qb + ql * 1024 + (((2 * ks + hi) ^ (ql & 7)) * 16); A.e[ks] = opaque(lo + (s3 ? 128 : 0)); A.o[ks] = opaque(lo - (s3 ? 128 : 0)); A.l[ks] = opaque(qb + QLIN_OFF - 65536 + ql * 128 + (((2 * ks + hi) ^ (ql & 7)) * 16)); }
    return A; }
__device__ __forceinline__ void idx_qload(bf16x8 (&qf)[4], const LAS unsigned char* qt, const QAddr& A, int h) {
#pragma unroll
    for (int ks = 0; ks < 4; ++ks) qf[ks] = (h == 8) ? *QPTR(qt, A.l[ks]) : *QPTR(qt, ((h & 1) ? A.o[ks] : A.e[ks]) + 128 * h);
}
__device__ __forceinline__ void idx_mma(f32x16& d0, f32x16& d1, const bf16x8 (&ka)[2][4], const bf16x8 (&qf)[4]) {
#pragma unroll
    for (int r = 0; r < 16; ++r) { d0[r] = 0.f; d1[r] = 0.f; }
#pragma unroll
    for (int ks = 0; ks < 4; ++ks) { d0 = MFMA32(ka[0][ks], qf[ks], d0); d1 = MFMA32(ka[1][ks], qf[ks], d1); }
}
#ifdef EMU
#define MFMA_SETTLE(x, y)
#define FMA_ABS(s, d, w) (s) = fmaf(fabsf(d), (w), (s))
#else
#define MFMA_SETTLE(x, y) asm volatile("s_nop 11" : "+v"(x), "+v"(y))
#define FMA_ABS(s, d, w) asm("v_fma_f32 %0, |%1|, %2, %0" : "+v"(s) : "v"(d), "v"(w))
#endif
__device__ __forceinline__ void idx_acc(f32x16& S, const f32x16& D, const float hw) {
#pragma unroll
    for (int i = 0; i < 16; ++i) { float t = S[i]; const float d = D[i]; FMA_ABS(t, d, hw); S[i] = t; }
}
template <bool MMA, bool ACC, bool LOAD>
__device__ __forceinline__ void idx_step(f32x16& n0, f32x16& n1, const bf16x8 (&ka)[2][4], const bf16x8 (&qf)[4], f32x16& s0, f32x16& s1, const f32x16& p0, const f32x16& p1, const float w,
                                         bf16x8 (&ql)[4], const LAS unsigned char* qt, const QAddr& A, const int hl) {
    const f32x16 z = {0.f, 0.f, 0.f, 0.f, 0.f, 0.f, 0.f, 0.f, 0.f, 0.f, 0.f, 0.f, 0.f, 0.f, 0.f, 0.f};
#pragma unroll
    for (int i = 0; i < 8; ++i) { const int ks = i & 3;
        if (MMA) { if (i < 4) n0 = MFMA32(ka[0][ks], qf[ks], ks == 0 ? z : n0); else n1 = MFMA32(ka[1][ks], qf[ks], ks == 0 ? z : n1); }
        if (ACC) {
#pragma unroll
            for (int e = 0; e < 4; ++e) { const int r = 4 * ks + e; if (i < 4) { float t = s0[r]; const float d = p0[r]; FMA_ABS(t, d, w); s0[r] = t; } else { float t = s1[r]; const float d = p1[r]; FMA_ABS(t, d, w); s1[r] = t; } } }
        if (LOAD && i < 4) ql[i] = (hl == 8) ? *QPTR(qt, A.l[i]) : *QPTR(qt, ((hl & 1) ? A.o[i] : A.e[i]) + 128 * hl);
        SCHED_BAR();
    }
}
template <int MODE = 0>
__device__ __forceinline__ void idx_scores2(f32x16& s0, f32x16& s1, const LAS unsigned char* qt, const QAddr& A, const float (&hw)[8], const bf16x8 (&ka)[2][4]) {
    constexpr bool M = MODE != 3, C = MODE != 2;
    bf16x8 qx[4], qy[4]; f32x16 a0, a1, b0, b1;
    if (MODE == 3) {
#pragma unroll
        for (int r = 0; r < 16; ++r) { a0[r] = 0.f; a1[r] = 0.f; b0[r] = 0.f; b1[r] = 0.f; s0[r] = 0.f; s1[r] = 0.f; }
        PIN16(a0); PIN16(a1); PIN16(b0); PIN16(b1); }
    idx_qload(qx, qt, A, 0); idx_qload(qy, qt, A, 8); SCHED_BAR();
    idx_step<M, false, false>(a0, a1, ka, qx, s0, s1, a0, a1, 0.f, qx, qt, A, 0);
    if (MODE == 2) { PIN16(a0); PIN16(a1); }
    idx_step<M, false, M>(s0, s1, ka, qy, s0, s1, a0, a1, 0.f, qx, qt, A, 1);
    idx_step<M, C, M>(b0, b1, ka, qx, s0, s1, a0, a1, hw[0], qy, qt, A, 2);
    if (MODE == 2) { PIN16(b0); PIN16(b1); }
    idx_step<M, C, M>(a0, a1, ka, qy, s0, s1, b0, b1, hw[1], qx, qt, A, 3);
    if (MODE == 2) { PIN16(a0); PIN16(a1); }
    idx_step<M, C, M>(b0, b1, ka, qx, s0, s1, a0, a1, hw[2], qy, qt, A, 4);
    if (MODE == 2) { PIN16(b0); PIN16(b1); }
    idx_step<M, C, M>(a0, a1, ka, qy, s0, s1, b0, b1, hw[3], qx, qt, A, 5);
    if (MODE == 2) { PIN16(a0); PIN16(a1); }
    idx_step<M, C, M>(b0, b1, ka, qx, s0, s1, a0, a1, hw[4], qy, qt, A, 6);
    if (MODE == 2) { PIN16(b0); PIN16(b1); }
    idx_step<M, C, M>(a0, a1, ka, qy, s0, s1, b0, b1, hw[5], qx, qt, A, 7);
    if (MODE == 2) { PIN16(a0); PIN16(a1); }
    idx_step<M, C, false>(b0, b1, ka, qx, s0, s1, a0, a1, hw[6], qy, qt, A, 0);
    if (MODE == 2) { PIN16(b0); PIN16(b1); }
    idx_step<false, C, false>(b0, b1, ka, qx, s0, s1, b0, b1, hw[7], qy, qt, A, 0);
}
__device__ __forceinline__ float score_u(float s, float inv32) { return __builtin_fmaf(s, inv32, (float)(NB / 2) + BIN_MAGIC); }
#ifdef EMU
#define HIST_ADD(hq, hadj, m) LDS_ATOMIC_ADD((hq) + (__float_as_uint(m) - 0x4B000000u), 1u)
#else
#if PROBE_DUP == 4
#define HIST_ADD(hq, hadj, m) do { LDS_ATOMIC_ADD((LAS unsigned*)(size_t)((__float_as_uint(m) << 2) + (hadj)), 1u); LDS_ATOMIC_ADD((LAS unsigned*)(size_t)((__float_as_uint(m) << 2) + (hadj)), (unsigned)opaque(0)); } while (0)
#else
#define HIST_ADD(hq, hadj, m) LDS_ATOMIC_ADD((LAS unsigned*)(size_t)((__float_as_uint(m) << 2) + (hadj)), 1u)
#endif
#endif

template <int PASS> __device__ __forceinline__ void idx_pass(Frame& F0, int un, LAS unsigned* hist, LAS int* qinfo) {
    Frame F = F0; F.lane = LANE_ID(); F.tid = F0.wave * 64 + F.lane;
    const bf16_t* KI = (const bf16_t*)(F.ws + WS_MIX + MIX_KI); const float* WI = (const float*)(F.ws + WS_MIX + MIX_WI);
    const int lane = F.lane, ql = lane & 31, hi = lane >> 5, q = 32 * un + ql, ntiles = un + 1, npairs = (ntiles + 1) >> 1;
    const LAS unsigned char* qt = F.lds + 65536;
    float hwp[8];
#pragma unroll
    for (int h = 0; h < 8; ++h) hwp[h] = 0.5f * WI[(size_t)q * 8 + h];
    const int bstar = PASS == 2 ? qinfo[ql * 4] : 0; const float inv32 = __builtin_bit_cast(float, qinfo[ql * 4 + 3]) * BIN_SCALE;
    const float thr_hi = bstar < 0 ? -__builtin_inff() : (bstar >= NB - 1 ? __builtin_inff() : BIN_MAGIC + (float)bstar);
    const float thr_lo = bstar <= 0 ? -__builtin_inff() : BIN_MAGIC + (float)bstar;
    const float cpos = (float)(NB / 2) + 0.5f - (float)bstar;
    LAS unsigned* cand = (LAS unsigned*)(F.lds + 98304) + (ql * 16 + F.wave * 2 + hi) * 16; int mycnt = 0;
    const float cmax = __builtin_bit_cast(float, opaque_s(__builtin_bit_cast(int, BIN_MAGIC + (float)(NB - 1))));
    LAS unsigned* hq = hist + ql * NB; const unsigned hadj = (unsigned)(size_t)hq - (0x4B000000u << 2); (void)hadj; (void)hq;
    const QAddr QA = idx_qaddr(lane, qt);
    bf16x8 ka[2][4];
    if (F.wave < npairs) idx_kload(ka, KI, 64 * F.wave, lane);
    for (int kp = F.wave; kp < npairs; kp += NWAVES) {
        const bool more = kp + NWAVES < npairs;
        f32x16 sc0, sc1; idx_scores2(sc0, sc1, qt, QA, hwp, ka);
        PIN16(sc0); PIN16(sc1);
#if PROBE_DUP >= 1 && PROBE_DUP <= 3
        { f32x16 t0, t1; idx_scores2<PROBE_DUP == 1 ? 0 : PROBE_DUP>(t0, t1, qt, QA, hwp, ka); PIN16(t0); PIN16(t1); }
#endif
        if (more) idx_kload(ka, KI, 64 * (kp + NWAVES), lane);
        const bool full = (2 * kp + 1 < ntiles - 1);
#pragma unroll
        for (int t = 0; t < 2; ++t) { const int kt = 2 * kp + t;
            if (PASS == 1) {
                if (full) {
#pragma unroll
                    for (int r = 0; r < 16; ++r) { const float m = MED3F(score_u(t ? sc1[r] : sc0[r], inv32), BIN_MAGIC, cmax); HIST_ADD(hq, hadj, m); }
                } else {
#pragma unroll
                    for (int r = 0; r < 16; ++r) { const int key = 32 * kt + crow(r, hi); const float m = MED3F(score_u(t ? sc1[r] : sc0[r], inv32), BIN_MAGIC, cmax);
                        if (key <= q) HIST_ADD(hq, hadj, m); }
                }
            } else if (kt < ntiles) {
                unsigned mlo = 0u, mhi = 0u;
#pragma unroll
                for (int r = 0; r < 16; ++r) { const int key = 32 * kt + crow(r, hi); const float sv = t ? sc1[r] : sc0[r]; float u = score_u(sv, inv32);
                    if (!full) u = key <= q ? u : __builtin_nanf("");
                    const u64 above = BALLOT64(u > thr_hi); WRITELANE64(mlo, mhi, above, r);
                    const u64 cm = BALLOT64(u >= thr_lo) & ~above;
                    if (cm != 0ull) { if (u >= thr_lo && !(u > thr_hi)) { if (mycnt < 16) { const float fr_ = MED3F(__builtin_fmaf(sv, inv32, cpos) * 262144.0f, 0.f, 262143.0f); cand[mycnt] = ((unsigned)fr_ << 14) | (unsigned)(16383 - key); } ++mycnt; } } }
                if (lane < 16) { u32x2 w; w.x = mlo; w.y = mhi; ((LAS u32x2*)hist)[kt * 16 + lane] = w; }
            }
        }
    }
    if (PASS == 2) ((LAS int*)(F.lds + RING_BYTES + 2048))[ql * 16 + F.wave * 2 + hi] = mycnt < 16 ? mycnt : 16;
}
__device__ __forceinline__ void indexer_unit(Frame& F0, int un) {
    Frame F = F0; F.lane = LANE_ID(); F.tid = F0.wave * 64 + F.lane;
    const bf16_t* QI = (const bf16_t*)(F.ws + WS_MIX + MIX_QI); const bf16_t* KI = (const bf16_t*)(F.ws + WS_MIX + MIX_KI); const float* WI = (const float*)(F.ws + WS_MIX + MIX_WI);
    unsigned* M32 = (unsigned*)(F.ws + WS_MASK);
    LAS unsigned* hist = (LAS unsigned*)F.lds; LAS int* qinfo = (LAS int*)(F.lds + RING_BYTES); LAS int* ccnt = (LAS int*)(F.lds + RING_BYTES + 2048);
    LAS float* nrm = (LAS float*)(F.lds + 98304);
    const int lane = F.lane, q0 = 32 * un;
    __syncthreads();
    { const unsigned zz = (unsigned)opaque(0); const u32x4 z4 = (u32x4){zz, zz, zz, zz};
      for (int e = F.tid; e < 32 * NB / 4; e += NTHREADS) ((LAS u32x4*)hist)[e] = z4; }
    if (F.tid < 128) qinfo[F.tid] = 0;
    for (int e = F.tid; e < 32 * 64; e += NTHREADS) { const int row = e >> 6, c = e & 63;
        *(LAS u32x4*)(F.lds + 65536 + row * 1024 + ((c ^ (row & 15)) * 16)) = *(const u32x4*)(QI + (size_t)(q0 + row) * 512 + 8 * c); }
    if (F.tid < 256) { const int row = F.tid & 31, h = F.tid >> 5; const bf16_t* qr = QI + (size_t)(q0 + row) * 512 + h * 64; float ss = 0.f;
        for (int e = 0; e < 64; e += 8) { const u32x4 a = *(const u32x4*)(qr + e); ss += bflo(a.x) * bflo(a.x) + bfhi(a.x) * bfhi(a.x) + bflo(a.y) * bflo(a.y) + bfhi(a.y) * bfhi(a.y) + bflo(a.z) * bflo(a.z) + bfhi(a.z) * bfhi(a.z) + bflo(a.w) * bflo(a.w) + bfhi(a.w) * bfhi(a.w); }
        const float w = WI[(size_t)(q0 + row) * 8 + h]; nrm[row * 8 + h] = w * w * ss; }
    { const int row = F.tid & 31, d4 = (F.tid >> 5) * 4; float a0 = 0.f, a1 = 0.f, a2 = 0.f, a3 = 0.f;
#pragma unroll
      for (int h = 0; h < 8; ++h) { const float w = 0.5f * WI[(size_t)(q0 + row) * 8 + h]; const u32x2 v = *(const u32x2*)(QI + (size_t)(q0 + row) * 512 + h * 64 + d4);
          a0 += w * bflo(v.x); a1 += w * bfhi(v.x); a2 += w * bflo(v.y); a3 += w * bfhi(v.y); }
      u32x2 o; o.x = pk2(a0, a1); o.y = pk2(a2, a3); *(LAS u32x2*)(F.lds + QLIN_OFF + row * 128 + (((d4 >> 3) ^ (row & 7)) * 16) + (d4 & 7) * 2) = o; }
    __syncthreads();
    if (F.tid < 32) { float a = 0.f;
#pragma unroll
        for (int h = 0; h < 8; ++h) a += nrm[F.tid * 8 + h];
        const float inv = a > 1e-30f ? RSQF(0.5f * a) : 1.0f; qinfo[F.tid * 4 + 3] = __builtin_bit_cast(int, inv); }
    __syncthreads();
    idx_pass<1>(F, un, hist, qinfo);
    __syncthreads();
    for (int i = 0; i < 4; ++i) { const int qq = 4 * F.wave + i; const int n = q0 + qq + 1;
        unsigned cnt[8]; unsigned tot = 0;
#pragma unroll
        for (int e = 0; e < 2; ++e) { const u32x4 w = ((const LAS u32x4*)(hist + qq * NB + lane * 8))[e]; cnt[4 * e] = w.x; cnt[4 * e + 1] = w.y; cnt[4 * e + 2] = w.z; cnt[4 * e + 3] = w.w; tot += w.x + w.y + w.z + w.w; }
        unsigned v = tot;
#pragma unroll
        for (int o = 1; o < 64; o <<= 1) { const unsigned t = SHFL_IDX_U(v, (lane + o) & 63); if (lane + o < 64) v += t; }
        const unsigned above = v - tot;
        if (n > TOPK) { const bool mine = (above < (unsigned)TOPK) && (above + tot >= (unsigned)TOPK);
            if (mine) { unsigned a = above, abest = above; int bb = 7; bool found = false;
#pragma unroll
                for (int t = 7; t >= 0; --t) { const bool hit = !found && (a + cnt[t] >= (unsigned)TOPK); if (hit) { bb = t; abest = a; found = true; } a += cnt[t]; }
                qinfo[qq * 4] = lane * 8 + bb; qinfo[qq * 4 + 1] = TOPK - (int)abest; }
        } else if (lane == 0) { qinfo[qq * 4] = opaque(-1); qinfo[qq * 4 + 1] = opaque(0); }
    }
    __syncthreads();
    idx_pass<2>(F, un, hist, qinfo);
    __syncthreads();
    LAS unsigned* cand = (LAS unsigned*)(F.lds + 98304);
    for (int i = 0; i < 4; ++i) { const int qq = 4 * F.wave + i; const int rneed = qinfo[qq * 4 + 1];
        if (rneed <= 0) continue;
#pragma unroll
        for (int k = 0; k < 4; ++k) { const int sl = lane + 64 * k;
            if ((sl & 15) < ccnt[qq * 16 + (sl >> 4)]) { const unsigned me = cand[qq * 256 + sl]; int rank = 0;
                for (int sb = 0; sb < 16; ++sb) { const int c2 = ccnt[qq * 16 + sb];
                    for (int p2 = 0; p2 < c2; ++p2) rank += (cand[qq * 256 + sb * 16 + p2] > me) ? 1 : 0; }
                if (rank < rneed) { const unsigned key = 16383u - (me & 16383u); const int kk = key & 31, h2 = (kk >> 2) & 1, r = (kk & 3) + 4 * (kk >> 3); LDS_ATOMIC_OR(hist + (key >> 5) * 32 + r * 2 + h2, 1u << qq); } } }
    }
    __syncthreads();
    const int ktz = 8 * (un >> 3) + 8;
    for (int e = F.tid; e < ktz * 32; e += NTHREADS) { const int kt = e >> 5; M32[((size_t)kt * (SEQ / 32) + un) * 32 + (e & 31)] = kt <= un ? hist[e] : 0u; }
}
__device__ __forceinline__ void indexer_phase(Frame& F) {
    constexpr int NU = SEQ / 32;
    for (int p = F.vcu; p < NU / 2; p += F.G) { indexer_unit(F, p); indexer_unit(F, NU - 1 - p); }
    __syncthreads();
}

#ifdef EMU
#define A2_DMA(gsrc, ldsoff) emu_glds16((const void*)(gsrc), (void*)(F.lds + (ldsoff)))
#define A2_WAIT_BAR(N) emu::block_barrier()
#define A2_SBAR()
#define A2_PIN(x)
#define A2_CVTPK(lo, hi) pk2(lo, hi)
struct a2_m8 { u64 v[8]; u64 operator[](int i) const { return v[i]; } };
static inline a2_m8 a2_sload8(const u64* p) { a2_m8 r; for (int i = 0; i < 8; ++i) r.v[i] = p[i]; return r; }
#define A2_SWAIT4(a, b, c, d)
#else
typedef unsigned long long a2_m8 __attribute__((ext_vector_type(8)));
__device__ __forceinline__ a2_m8 a2_sload8(const u64* p) { a2_m8 r; asm volatile("s_load_dwordx16 %0, %1, 0x0 glc" : "=s"(r) : "s"(p)); return r; }
#define A2_SWAIT4(a, b, c, d) asm volatile("s_waitcnt lgkmcnt(0)" : "+s"(a), "+s"(b), "+s"(c), "+s"(d))
__device__ __forceinline__ void a2_glds16(const void* gsrc, unsigned lds_dst) { unsigned keep;
    asm volatile("s_mov_b32 %0, m0\n\ts_mov_b32 m0, %2\n\ts_nop 0\n\tglobal_load_lds_dwordx4 %1, off\n\ts_mov_b32 m0, %0" : "=&s"(keep) : "v"(gsrc), "s"(lds_dst) : "memory"); }
typedef __bf16 a2_bf16x2 __attribute__((ext_vector_type(2)));
__device__ __forceinline__ unsigned a2_cvtpk(float lo, float hi) { f32x2 v = {lo, hi}; a2_bf16x2 b = __builtin_convertvector(v, a2_bf16x2); return __builtin_bit_cast(unsigned, b); }
#define A2_DMA(gsrc, ldsoff) a2_glds16((const void*)(gsrc), (unsigned)__builtin_amdgcn_readfirstlane((int)(lds0 + (unsigned)(ldsoff))))
#define A2_WAIT_BAR(N) asm volatile("s_waitcnt vmcnt(" #N ") lgkmcnt(0)\n\ts_barrier" ::: "memory")
#define A2_SBAR() __builtin_amdgcn_sched_barrier(0)
#define A2_PIN(x) asm volatile("" : "+v"(x))
#define A2_CVTPK(lo, hi) a2_cvtpk(lo, hi)
#endif
constexpr int A2_NSLOT = 3, A2_SLOTB = 8192, A2_K = 0, A2_V = A2_NSLOT * A2_SLOTB, A2_WS = 2 * A2_NSLOT * A2_SLOTB, A2_OST = A2_WS + 8 * 64 * 4, A2_BYTES = A2_OST + 8 * 4096;
static_assert(A2_BYTES <= RING_BYTES, "attention scratch fits the ring");
__device__ __forceinline__ void attn_unit2(Frame& F0, int h, int qb) {
    Frame F = F0; F.lane = LANE_ID(); F.tid = F0.wave * 64 + F.lane;
    bf16_t* Qg = (bf16_t*)(F.ws + WS_R + R_Q); const bf16_t* Kg = (const bf16_t*)(F.ws + WS_R + R_K); const bf16_t* Vg = (const bf16_t*)(F.ws + WS_R + R_V);
    const int lane = F.lane, r32 = lane & 31, hi = lane >> 5, wid = F.wave, q0 = qb * 256;
    const bf16_t* Qw = Qg + (size_t)(q0 + wid * 32) * D_MODEL + h * 64; const bf16_t* Kh = Kg + h * 64; const bf16_t* Vh = Vg + h * 64;
#ifndef EMU
    const unsigned lds0 = (unsigned)(uintptr_t)F.lds;
#endif
    LAS float* wsf = (LAS float*)(F.lds + A2_WS) + wid * 64;
    const bf16_t* ksrc = Kh + (size_t)lane * D_MODEL + wid * 8;
    const bf16_t* vsrc = Vh + (size_t)(16 * (wid & 3) + (lane >> 2)) * D_MODEL + (wid >> 2) * 32 + (lane & 3) * 8;
    const int kdst = A2_K + wid * 1024, vdst = A2_V + wid * 1024;
#define DMA_K(t, slot) A2_DMA(ksrc + (size_t)(t) * 64 * D_MODEL, kdst + (slot))
#define DMA_V(t, slot) A2_DMA(vsrc + (size_t)(t) * 64 * D_MODEL, vdst + (slot))
    const LAS unsigned char* kp0 = F.lds + A2_K + hi * 1024 + r32 * 16;
    const LAS unsigned char* vp0 = F.lds + A2_V + ((lane >> 4) & 1) * 32 + (lane & 3) * 8 + (4 * hi + ((lane & 15) >> 2)) * 64;
    const int NT = (q0 + 256) / 64;
    const u64* MW = (const u64*)(F.ws + WS_MASK) + (size_t)(8 * qb + wid) * 16; constexpr size_t MS = (size_t)(SEQ / 32) * 16;
    DMA_K(0, 0); DMA_V(0, 0); DMA_K(1, A2_SLOTB);
    bf16x8 qr[4];
#pragma unroll
    for (int d0 = 0; d0 < 4; ++d0) qr[d0] = *(const bf16x8*)(Qw + (size_t)r32 * D_MODEL + d0 * 16 + hi * 8);
    float l_reg = 0.f; f32x16 o[2]; f32x16 zero16;
#pragma unroll
    for (int r = 0; r < 16; ++r) { o[0][r] = 0.f; o[1][r] = 0.f; zero16[r] = 0.f; }
    f32x16 pA0, pA1, pB0, pB1; bf16x8 kf[8];
    int sl_prev = 0, sl_cur = 0, sl_next = A2_SLOTB;
#define ROT() do { sl_prev = sl_cur; sl_cur = sl_next; sl_next = (sl_next == (A2_NSLOT - 1) * A2_SLOTB) ? 0 : sl_next + A2_SLOTB; } while (0)
#define KLOAD2(kp, j) do { kf[2 * (j)] = *(const LAS bf16x8*)((kp) + (j) * 2048); kf[2 * (j) + 1] = *(const LAS bf16x8*)((kp) + (j) * 2048 + 512); } while (0)
    DMA_K(2, 2 * A2_SLOTB);
    A2_WAIT_BAR(3);
    { const LAS unsigned char* kb = kp0;
      KLOAD2(kb, 0); KLOAD2(kb, 1); KLOAD2(kb, 2); KLOAD2(kb, 3);
      pA0 = MFMA32(kf[0], qr[0], zero16); pA1 = MFMA32(kf[1], qr[0], zero16);
#pragma unroll
      for (int d0 = 1; d0 < 4; ++d0) { pA0 = MFMA32(kf[2 * d0], qr[d0], pA0); pA1 = MFMA32(kf[2 * d0 + 1], qr[d0], pA1); }
      a2_m8 m0 = a2_sload8(MW), m1 = a2_sload8(MW + 8), m2 = a2_sload8(MW + MS), m3 = a2_sload8(MW + MS + 8); A2_SWAIT4(m0, m1, m2, m3);
#pragma unroll
      for (int r = 0; r < 8; ++r) { pA0[r] = INVB(m0[r]) ? EXP2F(pA0[r]) : 0.f; pA0[8 + r] = INVB(m1[r]) ? EXP2F(pA0[8 + r]) : 0.f; pA1[r] = INVB(m2[r]) ? EXP2F(pA1[r]) : 0.f; pA1[8 + r] = INVB(m3[r]) ? EXP2F(pA1[8 + r]) : 0.f; } }
    A2_WAIT_BAR(0);
    DMA_K(3, 0); DMA_V(1, A2_SLOTB);
    ROT();
    { const LAS unsigned char* kb = kp0 + sl_cur; KLOAD2(kb, 0); KLOAD2(kb, 1); KLOAD2(kb, 2); KLOAD2(kb, 3); }
    A2_WAIT_BAR(2);
    s16x4 vlo[8], vhi[8]; u32x4 pw0, pw1, pw2, pw3;
#define PKW(P, B) A2_CVTPK(P[B], P[(B) + 1])
#define PAF(k) __builtin_bit_cast(bf16x8, pw##k)
#define VFR(i) (bf16x8){vlo[i][0], vlo[i][1], vlo[i][2], vlo[i][3], vhi[i][0], vhi[i][1], vhi[i][2], vhi[i][3]}
#define GAPA(MF, A0, A1, A2, A3, W0, W1, PW) do { MF; sacc += A0; sacc += A1; sacc += A2; sacc += A3; A2_PIN(sacc); W0; W1; A2_PIN(PW); A2_SBAR(); } while (0)
#define GAPB(MF, X, B, J, MK) do { MF; X[B] = INVB(MK[J]) ? EXP2F(X[B]) : 0.f; X[(B) + 1] = INVB(MK[(J) + 1]) ? EXP2F(X[(B) + 1]) : 0.f; X[(B) + 2] = INVB(MK[(J) + 2]) ? EXP2F(X[(B) + 2]) : 0.f; X[(B) + 3] = INVB(MK[(J) + 3]) ? EXP2F(X[(B) + 3]) : 0.f; A2_PIN(X); A2_SBAR(); } while (0)
#define VRD(i) do { vlo[i] = DS_TR16(vp_ + (((i) >> 2) * 4096 + ((i) & 3) * 1024)); vhi[i] = DS_TR16(vp_ + (((i) >> 2) * 4096 + ((i) & 3) * 1024 + 512)); } while (0)
#define KRD(G, j) do { if (G) { KLOAD2(kp0 + sl_next, j); A2_SBAR(); } } while (0)
#define STEP(C0, C1, P0, P1, t, GK, GV, GL) do { A2_SBAR(); \
    const LAS unsigned char* vp_ = vp0 + sl_prev; const u64* mka_ = MW + (size_t)(2 * (t)) * MS; const u64* mkb_ = mka_ + MS; \
    a2_m8 ma0_ = a2_sload8(mka_), ma1_ = a2_sload8(mka_ + 8), mb0_ = a2_sload8(mkb_), mb1_ = a2_sload8(mkb_ + 8); \
    VRD(0); A2_SBAR(); float sacc = (P0[0] + P0[1]); \
    GAPA(C0 = MFMA32(kf[0], qr[0], zero16), P0[2], P0[3], P0[4], P0[5],     pw0[0] = PKW(P0, 0), pw0[1] = PKW(P0, 2), pw0); \
    VRD(4); A2_SBAR(); GAPA(C1 = MFMA32(kf[1], qr[0], zero16), P0[6], P0[7], P0[8], P0[9],     pw0[2] = PKW(P0, 4), pw0[3] = PKW(P0, 6), pw0); \
    VRD(1); A2_SBAR(); GAPA(C0 = MFMA32(kf[2], qr[1], C0),   P0[10], P0[11], P0[12], P0[13], pw1[0] = PKW(P0, 8), pw1[1] = PKW(P0, 10), pw1); \
    VRD(5); A2_SBAR(); GAPA(C1 = MFMA32(kf[3], qr[1], C1),   P0[14], P0[15], P1[0], P1[1],   pw1[2] = PKW(P0, 12), pw1[3] = PKW(P0, 14), pw1); \
    VRD(2); A2_SBAR(); GAPA(C0 = MFMA32(kf[4], qr[2], C0),   P1[2], P1[3], P1[4], P1[5],     pw2[0] = PKW(P1, 0), pw2[1] = PKW(P1, 2), pw2); \
    VRD(6); A2_SBAR(); GAPA(C1 = MFMA32(kf[5], qr[2], C1),   P1[6], P1[7], P1[8], P1[9],     pw2[2] = PKW(P1, 4), pw2[3] = PKW(P1, 6), pw2); \
    VRD(3); A2_SBAR(); GAPA(C0 = MFMA32(kf[6], qr[3], C0),   P1[10], P1[11], P1[12], P1[13], pw3[0] = PKW(P1, 8), pw3[1] = PKW(P1, 10), pw3); \
    VRD(7); A2_SBAR(); GAPA(C1 = MFMA32(kf[7], qr[3], C1),   P1[14], P1[15], 0.f, 0.f,       pw3[2] = PKW(P1, 12), pw3[3] = PKW(P1, 14), pw3); \
    l_reg += sacc; \
    if (GK) { DMA_K((t) + 3, sl_cur); } if (GV) { DMA_V((t) + 1, sl_next); } \
    A2_SWAIT4(ma0_, ma1_, mb0_, mb1_); A2_SBAR(); \
    GAPB(o[0] = MFMA32(PAF(0), VFR(0), o[0]), C0, 0, 0, ma0_); \
    GAPB(o[1] = MFMA32(PAF(0), VFR(4), o[1]), C0, 4, 4, ma0_); \
    KRD(GL, 0); GAPB(o[0] = MFMA32(PAF(1), VFR(1), o[0]), C0, 8, 0, ma1_); \
    KRD(GL, 1); GAPB(o[1] = MFMA32(PAF(1), VFR(5), o[1]), C0, 12, 4, ma1_); \
    KRD(GL, 2); GAPB(o[0] = MFMA32(PAF(2), VFR(2), o[0]), C1, 0, 0, mb0_); \
    KRD(GL, 3); GAPB(o[1] = MFMA32(PAF(2), VFR(6), o[1]), C1, 4, 4, mb0_); \
    GAPB(o[0] = MFMA32(PAF(3), VFR(3), o[0]), C1, 8, 0, mb1_); \
    GAPB(o[1] = MFMA32(PAF(3), VFR(7), o[1]), C1, 12, 4, mb1_); \
    } while (0)
    int t = 1;
    for (; t + 5 < NT; t += 2) {
        STEP(pB0, pB1, pA0, pA1, t, true, true, true);     A2_WAIT_BAR(2); ROT();
        STEP(pA0, pA1, pB0, pB1, t + 1, true, true, true); A2_WAIT_BAR(2); ROT();
    }
#define ENDW(tt) do { if ((tt) + 3 < NT) { A2_WAIT_BAR(2); } else if ((tt) + 2 < NT) { A2_WAIT_BAR(1); } else { A2_WAIT_BAR(0); } } while (0)
    for (; t + 1 < NT; t += 2) {
        STEP(pB0, pB1, pA0, pA1, t, (t + 3 < NT), (t + 1 < NT), (t + 1 < NT));         ENDW(t);     ROT();
        STEP(pA0, pA1, pB0, pB1, t + 1, (t + 4 < NT), (t + 2 < NT), (t + 2 < NT));     ENDW(t + 1); ROT();
    }
    STEP(pB0, pB1, pA0, pA1, NT - 1, false, false, false);
    { float sacc = pB0[0] + pB0[1];
#pragma unroll
      for (int r = 2; r < 16; ++r) sacc += pB0[r];
#pragma unroll
      for (int r = 0; r < 16; ++r) sacc += pB1[r];
      l_reg += sacc;
      pw0 = (u32x4){PKW(pB0, 0), PKW(pB0, 2), PKW(pB0, 4), PKW(pB0, 6)}; pw1 = (u32x4){PKW(pB0, 8), PKW(pB0, 10), PKW(pB0, 12), PKW(pB0, 14)};
      pw2 = (u32x4){PKW(pB1, 0), PKW(pB1, 2), PKW(pB1, 4), PKW(pB1, 6)}; pw3 = (u32x4){PKW(pB1, 8), PKW(pB1, 10), PKW(pB1, 12), PKW(pB1, 14)};
      A2_SBAR();
      const LAS unsigned char* vp_ = vp0 + sl_cur;
#pragma unroll
      for (int d0 = 0; d0 < 2; ++d0) {
#pragma unroll
          for (int ks = 0; ks < 4; ++ks) { VRD(d0 * 4 + ks); }
          o[d0] = MFMA32(PAF(0), VFR(d0 * 4 + 0), o[d0]); o[d0] = MFMA32(PAF(1), VFR(d0 * 4 + 1), o[d0]); o[d0] = MFMA32(PAF(2), VFR(d0 * 4 + 2), o[d0]); o[d0] = MFMA32(PAF(3), VFR(d0 * 4 + 3), o[d0]); } }
    l_reg = sum_x32(l_reg);
    if (hi == 0) wsf[32 + r32] = l_reg;
    WAIT_L(0);
    float rli[16];
#pragma unroll
    for (int r = 0; r < 16; ++r) rli[r] = RCPF(wsf[32 + crow(r, hi)]);
    bf16_t* Ow = Qg + (size_t)(q0 + wid * 32) * D_MODEL + h * 64;
    { LAS bf16_t* stg = (LAS bf16_t*)(F.lds + A2_OST) + wid * 2048;
#pragma unroll
      for (int r = 0; r < 16; ++r) { const int orow = crow(r, hi);
#pragma unroll
          for (int d0 = 0; d0 < 2; ++d0) stg[orow * 64 + d0 * 32 + r32] = (bf16_t)f2bf(o[d0][r] * rli[r]); }
      WAIT_L(0);
#pragma unroll
      for (int i = 0; i < 4; ++i) { const int row = i * 8 + (lane >> 3), ch = lane & 7; const u32x4 v = *(const LAS u32x4*)(stg + row * 64 + ch * 8); *(u32x4*)(Ow + (size_t)row * D_MODEL + ch * 8) = v; } }
    A2_WAIT_BAR(0);
#undef DMA_K
#undef DMA_V
#undef ROT
#undef KLOAD2
#undef PKW
#undef PAF
#undef VFR
#undef GAPA
#undef GAPB
#undef VRD
#undef KRD
#undef STEP
#undef ENDW
}
__device__ __forceinline__ void attn_phase(Frame& F) {
    constexpr int NQB = SEQ / 256, NP = N_HEADS * (NQB / 2);
    const bool remap = (F.G == 256 && N_HEADS == 16 && NQB == 64);
    for (int p = F.vcu, i = 0; p < NP; p += F.G, ++i) {
        const int head = remap ? (F.vcu >> 5) + 8 * ((F.vcu & 31) >> 4) : p / (NQB / 2), s = remap ? (F.vcu & 15) + 16 * i : p % (NQB / 2);
        attn_unit2(F, head, s); attn_unit2(F, head, NQB - 1 - s); }
    __syncthreads();
}

#ifdef EMU
#define CG_SYNC() emu::grid_barrier()
#define LDS_DECL(name) unsigned char* name = emu::lds_ptr()
#else
namespace cg = cooperative_groups;
#define CG_SYNC() cg::this_grid().sync()
#define LDS_DECL(name) extern __shared__ __attribute__((aligned(16))) unsigned char name[]
#endif

#ifdef EMU
static int g_emu_max_layers = DEPTH;
#define MAX_LAYERS g_emu_max_layers
static int g_emu_stop = 0;
#define EMU_STOP(k) do { if (g_emu_stop == (k)) return; } while (0)
#else
#define MAX_LAYERS DEPTH
#define EMU_SNAPSHOT() do {} while (0)
#define EMU_STOP(k) do {} while (0)
#endif
__global__ void __launch_bounds__(NTHREADS, 2) mega_fwd(Args args) {
    LDS_DECL(lds_raw);
    Frame F;
    F.lds = (LAS unsigned char*)lds_raw; F.tid = threadIdx.x; F.lane = F.tid & 63; F.wave = RFL(F.tid >> 6);
    F.G = gridDim.x; { const int bx = blockIdx.x; F.vcu = (F.G % 8 == 0) ? (bx % 8) * (F.G / 8) + bx / 8 : bx; }
#pragma unroll
    for (int i = 0; i < 18; ++i) F.in[i] = args.in[i];
    F.out = args.out; F.ws = args.ws;
    volatile LAS unsigned* MISC = (volatile LAS unsigned*)(F.lds + LDSCTL_OFF + 1024);
    if (F.tid < 64) MISC[F.tid] = 0u;
    __syncthreads();
    XcdBarrier bar = xcd_barrier_post((unsigned*)(F.ws + WS_CTL) + 4096, MISC + 8);
#define GRID_BAR() xcd_barrier(bar)
    u64* rowss = (u64*)(F.ws + WS_ROWSS); bf16_t* XB = (bf16_t*)(F.ws + WS_XB);
    LAS unsigned char* ring = F.lds;

#ifndef KN
#define KN 0xffff
#endif
#ifndef TSEL
#define TSEL 0
#endif
#if TSEL && !defined(EMU)
    unsigned long long tacc = 0ull, tt0 = 0ull;
#define T_BEGIN(bit) do { if (TSEL & (bit)) tt0 = wall_clock64(); } while (0)
#define T_END(bit) do { if (TSEL & (bit)) tacc += wall_clock64() - tt0; } while (0)
#else
#define T_BEGIN(bit)
#define T_END(bit)
#endif
    T_BEGIN(1);
    if (KN & 1) { s5_pre(F);
    WAIT_VM0(); __syncthreads();
    s5_setup(F);
    __syncthreads();
    convert_weights(F);
    prologue_rows(F); }
    EMU_STOP(1);
    GRID_BAR(); T_END(1);
    if (opaque_s(0) != 0) CG_SYNC();

    const Frame F_ = F;
    for (int layer = 0; layer < MAX_LAYERS; ++layer) {
        const int j = layer >> 1;
        Frame F = F_; F.ws = opaque_p(F_.ws); u64* rowss = (u64*)(F.ws + WS_ROWSS); bf16_t* XB = (bf16_t*)(F.ws + WS_XB);
        u64* rs_mix = rowss + (size_t)(2 * layer) * SEQ; u64* rs_ffn = rowss + (size_t)(2 * layer + 1) * SEQ; u64* rs_next = rowss + (size_t)(2 * layer + 2) * SEQ;
        if ((layer & 1) == 0) {
            T_BEGIN(2); if (KN & 2) s5_build_ux(F, XB, rs_mix, F.in[16] + (size_t)layer * D_MODEL);
            GRID_BAR(); T_END(2); EMU_STOP(2);
            T_BEGIN(4); if (KN & 4) { pg8::Gemm g{(const bf16_t*)(F.ws + WS_R + R_UX), (const bf16_t*)(F.ws + WS_S5TAB + (size_t)j * SZ_S5TAB + MIX_W1), UXW, 256, 256}; pg8::GroupOrder S{F.G, F.vcu};
              EpiS5State E{(bf16_t*)(F.ws + WS_R + R_S)}; pg8::gemm_phase(ring, F.wave, g, S, E); }
            GRID_BAR(); T_END(4); EMU_STOP(3);
            T_BEGIN(8); if (KN & 8) s5_scan(F, j);
            GRID_BAR(); T_END(8); EMU_STOP(4);
            T_BEGIN(16); if (KN & 16) { pg8::Gemm g{(const bf16_t*)(F.ws + WS_R + R_UX), (const bf16_t*)(F.ws + WS_S5TAB + (size_t)j * SZ_S5TAB + MIX_AM), UXW, UXW, UXW}; pg8::GroupOrder S{F.G, F.vcu};
              EpiS5Out E{(bf16_t*)(F.ws + WS_R + R_Y), (const bf16_t*)(F.ws + WS_R + R_UX), F.in[8] + (size_t)j * D_MODEL}; pg8::gemm_phase(ring, F.wave, g, S, E); }
            GRID_BAR(); T_END(16); EMU_STOP(5);
            T_BEGIN(32); if (KN & 32) { pg8::Gemm g{(const bf16_t*)(F.ws + WS_R + R_Y), (const bf16_t*)(F.ws + WS_WGLU + j * SZ_WGLU), D_MODEL, D_MODEL, D_MODEL}; pg8::StaticOrder S; S.init(SEQ, 2 * D_MODEL, F.G, (int)blockIdx.x);
              EpiRes<true> E{XB, nullptr, rs_ffn}; pg8::gemm_phase(ring, F.wave, g, S, E); }
            GRID_BAR(); T_END(32);
        } else {
            T_BEGIN(64); if (KN & 64) { pg8::Gemm g{XB, (const bf16_t*)(F.ws + WS_WIN + j * SZ_WIN), D_MODEL, D_MODEL, D_MODEL}; pg8::StaticOrder S; S.init(SEQ, NIN_PAD, F.G, (int)blockIdx.x);
              EpiInProj E{(bf16_t*)(F.ws + WS_R + R_Q), (bf16_t*)(F.ws + WS_R + R_K), (bf16_t*)(F.ws + WS_R + R_V), (bf16_t*)(F.ws + WS_MIX + MIX_QI), (bf16_t*)(F.ws + WS_MIX + MIX_KI), (float*)(F.ws + WS_MIX + MIX_WI),
                          rs_mix, (const float*)(F.ws + WS_ROPE), F.in[11] + (size_t)j * 64, F.in[12] + (size_t)j * 64};
              pg8::gemm_phase(ring, F.wave, g, S, E); }
            GRID_BAR(); T_END(64); EMU_STOP(7);
            T_BEGIN(128); if (KN & 128) indexer_phase(F);
            GRID_BAR(); T_END(128); EMU_STOP(8);
            T_BEGIN(256); if (KN & 256) attn_phase(F);
            GRID_BAR(); T_END(256); EMU_STOP(9);
            T_BEGIN(512); if (KN & 512) { pg8::Gemm g{(const bf16_t*)(F.ws + WS_R + R_Q), (const bf16_t*)(F.ws + WS_WO + j * SZ_WO), D_MODEL, D_MODEL, D_MODEL}; pg8::StaticOrder S; S.init(SEQ, D_MODEL, F.G, (int)blockIdx.x);
              EpiRes<false> E{XB, nullptr, rs_ffn}; pg8::gemm_phase(ring, F.wave, g, S, E); }
            GRID_BAR(); T_END(512);
        }
        EMU_SNAPSHOT();
        T_BEGIN(1024); if (KN & 1024) { pg8::Gemm g{XB, (const bf16_t*)(F.ws + WS_WGU + layer * SZ_WGU), D_MODEL, D_MODEL, D_MODEL}; pg8::StaticOrder S; S.init(SEQ, 2 * D_FF, F.G, (int)blockIdx.x);
          EpiSwiGLU E{(bf16_t*)(F.ws + WS_R + R_ACT), rs_ffn}; pg8::gemm_phase(ring, F.wave, g, S, E); }
        if ((KN & 1) && opaque_s(layer) + 1 < MAX_LAYERS) convert_next_layer(F, layer + 1);
        GRID_BAR(); T_END(1024);
        T_BEGIN(2048); if (KN & 2048) { pg8::Gemm g{(const bf16_t*)(F.ws + WS_R + R_ACT), (const bf16_t*)(F.ws + WS_WDN + layer * SZ_WDN), D_FF, D_FF, D_FF}; pg8::StaticOrder S; S.init(SEQ, D_MODEL, F.G, (int)blockIdx.x);
          EpiRes<false> E{XB, opaque_s(layer) + 1 < MAX_LAYERS ? nullptr : F.out, rs_next}; pg8::gemm_phase(ring, F.wave, g, S, E); }
        if (opaque_s(layer) + 1 < DEPTH) GRID_BAR();
#ifdef EMU
        else GRID_BAR();
        EMU_SNAPSHOT();
#endif
        T_END(2048);
    }
#if TSEL && !defined(EMU)
    GRID_BAR(); if (blockIdx.x == 0 && threadIdx.x == 0) F_.out[0] += (float)tacc * 1e-4f;
#endif
}

#ifndef EMU
extern "C" void kernel_launch(void* const* d_in, const int* in_sizes, int n_in, void* d_out, int out_size, void* d_ws, size_t ws_size, hipStream_t stream) {
    static int grid = 0;
    if (grid == 0) {
        if (n_in != 18 || out_size != SEQ * D_MODEL || ws_size < WS_END) { fprintf(stderr, "kernel_launch: unexpected shapes (n_in %d out %d ws %zu need %zu)\n", n_in, out_size, ws_size, (size_t)WS_END); grid = -1; return; }
        int dev = 0, cus = 0, per_cu = 0;
        hipGetDevice(&dev); hipDeviceGetAttribute(&cus, hipDeviceAttributeMultiprocessorCount, dev);
        hipFuncSetAttribute((const void*)mega_fwd, hipFuncAttributeMaxDynamicSharedMemorySize, LDS_BYTES);
        hipOccupancyMaxActiveBlocksPerMultiprocessor(&per_cu, (const void*)mega_fwd, NTHREADS, LDS_BYTES);
        if (per_cu < 1) { fprintf(stderr, "kernel_launch: occupancy query says %d blocks/CU\n", per_cu); grid = -1; return; }
        grid = cus;
        (void)hipGetLastError();
    }
    if (grid < 0) return;
    hipMemsetAsync((char*)d_ws + WS_CTL, 0, CTL_BYTES, stream);
    Args a{};
    for (int i = 0; i < 18; ++i) a.in[i] = (const float*)d_in[i];
    a.out = (float*)d_out; a.ws = (unsigned char*)d_ws;
    void* params[] = {&a};
    hipError_t e = hipLaunchCooperativeKernel((const void*)mega_fwd, dim3(grid), dim3(NTHREADS), params, LDS_BYTES, stream);
    if (e != hipSuccess) fprintf(stderr, "cooperative launch failed: %s (grid %d)\n", hipGetErrorString(e), grid);
}
#endif
```

```cpp
#ifndef EMU
#include <hip/hip_runtime.h>
#include <hip/hip_cooperative_groups.h>
#include <cstdio>
#include <cstdint>
#include <cmath>
#endif

#ifdef CFG_SMALL
constexpr int D_MODEL = 256, SEQ = 4096, DEPTH = 2, N_HEADS = 4;
#else
constexpr int D_MODEL = 1024, SEQ = 16384, DEPTH = 4, N_HEADS = 16;
#endif
constexpr int S5_GROUPS = D_MODEL / 16, S5_STATE = 64, HEAD_DIM = 64, IDX_HEADS = 8, TOPK = 256;
constexpr int D_FF = ((8 * D_MODEL / 3 + 255) / 256) * 256;
constexpr int N_S5 = (DEPTH + 1) / 2, N_DSA = DEPTH / 2;
constexpr int DSA_PROJ = 3 * D_MODEL + 512 + 64 + 8;
constexpr int NH4 = D_MODEL / 256;
constexpr int NIN_TILES = 3 * NH4 + 3, NIN_PAD = NIN_TILES * 256;
constexpr int NCH = SEQ / 16, NCHT = NCH / 256;
constexpr int UXW = 384;
constexpr int NSEG = 32, SEGL = NCH / NSEG;
constexpr float EPS = 1e-6f;
constexpr float C2 = 0.125f * 1.4426950408889634f;
constexpr int NWAVES = 8, NTHREADS = 512;
#ifndef PROBE_DUP
#define PROBE_DUP 0
#endif
constexpr int NB = 512; constexpr float BIN_SCALE = 32.f, BIN_MAGIC = 8388608.f;
constexpr int CAND_CAP = 256;

constexpr size_t MiB = 1u << 20;
constexpr size_t WS_CTL = 0, CTL_BYTES = 3 * MiB;
constexpr size_t WS_ROWSS = 1 * MiB;
constexpr size_t SZ_WGLU = (size_t)2 * D_MODEL * D_MODEL * 2, SZ_WIN = (size_t)NIN_PAD * D_MODEL * 2, SZ_WO = (size_t)D_MODEL * D_MODEL * 2,
                 SZ_WGU = (size_t)2 * D_FF * D_MODEL * 2, SZ_WDN = (size_t)D_MODEL * D_FF * 2;
constexpr size_t WS_WGLU = CTL_BYTES, WS_WIN = WS_WGLU + N_S5 * SZ_WGLU, WS_WO = WS_WIN + N_DSA * SZ_WIN, WS_WGU = WS_WO + N_DSA * SZ_WO,
                 WS_WDN = WS_WGU + DEPTH * SZ_WGU, WS_ROPE = WS_WDN + DEPTH * SZ_WDN;
constexpr size_t SZ_ROPE = (size_t)SEQ * 64 * 4;
constexpr size_t S5PRE_STRIDE = 18432;
constexpr size_t WS_S5PRE = WS_ROPE + SZ_ROPE, SZ_S5PRE = (size_t)N_S5 * S5_GROUPS * S5PRE_STRIDE;
constexpr size_t WS_MIX = WS_S5PRE + SZ_S5PRE;
constexpr size_t SZ_AM = (size_t)S5_GROUPS * 256 * UXW * 2, SZ_W1 = (size_t)S5_GROUPS * 256 * 256 * 2, SZ_APOW = (size_t)S5_GROUPS * 64 * 16;
constexpr size_t MIX_AM = 0, MIX_W1 = MIX_AM + SZ_AM;
constexpr size_t MIX_QI = 0, SZ_QI = (size_t)SEQ * 512 * 2, MIX_KI = MIX_QI + SZ_QI, SZ_KI = (size_t)SEQ * 64 * 2, MIX_WI = MIX_KI + SZ_KI, SZ_WI = (size_t)SEQ * 8 * 4;
constexpr size_t SZ_S5TAB = MIX_W1 + SZ_W1, SZ_MIX_DSA = MIX_WI + SZ_WI;
constexpr size_t SZ_MIX = (SZ_MIX_DSA + 4095) / 4096 * 4096;
constexpr size_t WS_XB = WS_MIX + SZ_MIX, SZ_XB = (size_t)SEQ * D_MODEL * 2;
constexpr size_t WS_MASK = WS_XB + SZ_XB, SZ_MASK = (size_t)(SEQ / 32) * SEQ * 4;
constexpr size_t WS_R = WS_MASK + SZ_MASK;
constexpr size_t R_Q = 0, R_K = SZ_XB, R_V = 2 * SZ_XB;
constexpr size_t R_ACT = 0, SZ_ACT = (size_t)SEQ * D_FF * 2;
constexpr size_t R_UX = 0, SZ_UX = (size_t)S5_GROUPS * NCH * UXW * 2, R_S = ((SZ_UX + 4095) / 4096) * 4096, SZ_S = (size_t)S5_GROUPS * NCH * 128 * 4, R_Y = R_S;
constexpr size_t SZ_R0 = 3 * SZ_XB > SZ_ACT ? 3 * SZ_XB : SZ_ACT, SZ_R1 = R_S + SZ_S, SZ_R = SZ_R0 > SZ_R1 ? SZ_R0 : SZ_R1;
constexpr size_t WS_S5TAB = ((WS_R + SZ_R + 4095) / 4096) * 4096;
constexpr size_t WS_END = WS_S5TAB + N_S5 * SZ_S5TAB;
static_assert(SZ_S >= (size_t)SEQ * D_MODEL * 2, "Y fits over S");
static_assert(SEQ <= 16384, "candidate packing holds 14-bit keys");
static_assert((2 * DEPTH + 1) * (size_t)SEQ * 8 <= 2 * MiB, "rowss arrays fit");
typedef unsigned long long u64;
constexpr float SS_FIX = 1048576.0f, SS_INV = 1.0f / 1048576.0f;

typedef unsigned short bf16_t;
typedef short bf16x8 __attribute__((ext_vector_type(8)));
typedef float f32x4 __attribute__((ext_vector_type(4)));
typedef float f32x16 __attribute__((ext_vector_type(16)));
typedef unsigned u32x4 __attribute__((ext_vector_type(4)));
typedef unsigned u32x2 __attribute__((ext_vector_type(2)));
typedef short s16x4 __attribute__((ext_vector_type(4)));
typedef float f32x2 __attribute__((ext_vector_type(2)));

#ifdef EMU
#define LAS
#define GAS
#define MFMA16(a, b, c) emu_mfma16(a, b, c)
#define MFMA32(a, b, c) emu_mfma32(a, b, c)
#define WAIT_V(n)
#define WAIT_L(n) emu::wave_barrier()
#define WAIT_VM0() do {} while (0)
#define S_BARRIER() emu::block_barrier()
#define SCHED_BAR()
#define PIN16(x)
#define PIN1(x)
#define PINS(x)
#define PIN2(x)
#define SETPRIO(x)
#define RFL(x) (x)
#define LANE_ID() ((int)(threadIdx.x & 63))
#define GLDS16B(base, voff, l) emu_glds16((const void*)((const char*)(base) + (voff)), (void*)(l))
#define DS_TR16(p) emu_ds_read_tr16((const void*)(p))
#define EXP2F(x) exp2f(x)
#define RCPF(x) (1.0f / (x))
#define RSQF(x) (1.0f / sqrtf(x))
#define LDS_ATOMIC_ADD(p, v) atomicAdd((unsigned*)(p), (unsigned)(v))
#define LDS_ATOMIC_OR(p, v) atomicOr((unsigned*)(p), (unsigned)(v))
#define INVB(m) ((int)(((m) >> (threadIdx.x & 63)) & 1ull))
#define BALLOT64(p) __ballot(p)
#define WRITELANE64(lo, hi, b, r) do { if ((int)(threadIdx.x & 63) == (r)) { lo = (unsigned)(b); hi = (unsigned)((b) >> 32); } } while (0)
#define MED3F(a, lo, hi) fminf(fmaxf((a), (lo)), (hi))
#define RLX_LOAD(p) (*(p))
#define RLX_STORE(p, v) (*(p) = (v))
#define RLX_ADD(p, v) atomicAdd((unsigned*)(p), (unsigned)(v))
#else
#define LAS __attribute__((address_space(3)))
#define GAS __attribute__((address_space(1)))
#define MFMA16(a, b, c) __builtin_amdgcn_mfma_f32_16x16x32_bf16(a, b, c, 0, 0, 0)
#define MFMA32(a, b, c) __builtin_amdgcn_mfma_f32_32x32x16_bf16(a, b, c, 0, 0, 0)
#define WAIT_V(n) asm volatile("s_waitcnt vmcnt(" #n ")" ::: "memory")
#define WAIT_L(n) asm volatile("s_waitcnt lgkmcnt(" #n ")" ::: "memory")
#define WAIT_VM0() asm volatile("s_waitcnt vmcnt(0)" ::: "memory")
#define S_BARRIER() __builtin_amdgcn_s_barrier()
#define SCHED_BAR() __builtin_amdgcn_sched_barrier(0)
#define PIN16(x) asm volatile("" : "+v"(x))
#define PIN1(x) asm volatile("" : "+v"(x))
#define PINS(x) asm volatile("" : "+s"(x))
#define PIN2(x) asm volatile("" : "+v"(x))
#define SETPRIO(x) __builtin_amdgcn_s_setprio(x)
#define RFL(x) __builtin_amdgcn_readfirstlane(x)
#define LANE_ID() lane_id_now()
__device__ __forceinline__ void glds16b_(const char* base, unsigned voff, unsigned lds_dst) { asm volatile("s_mov_b32 m0, %2\n\ts_nop 0\n\tglobal_load_lds_dwordx4 %0, %1" :: "v"(voff), "s"(base), "s"(lds_dst) : "memory", "m0"); }
#define GLDS16B(base, voff, l) glds16b_((base), (voff), (unsigned)__builtin_amdgcn_readfirstlane((int)(unsigned)(size_t)(l)))
typedef short v4i16_t __attribute__((ext_vector_type(4)));
#define DS_TR16(p) __builtin_bit_cast(s16x4, __builtin_amdgcn_ds_read_tr16_b64_v4i16((LAS v4i16_t*)(p)))
#define EXP2F(x) __builtin_amdgcn_exp2f(x)
#define RCPF(x) __builtin_amdgcn_rcpf(x)
#define RSQF(x) __builtin_amdgcn_rsqf(x)
#define LDS_ATOMIC_ADD(p, v) __hip_atomic_fetch_add((LAS unsigned*)(p), (unsigned)(v), __ATOMIC_RELAXED, __HIP_MEMORY_SCOPE_WORKGROUP)
#define LDS_ATOMIC_OR(p, v) __hip_atomic_fetch_or((LAS unsigned*)(p), (unsigned)(v), __ATOMIC_RELAXED, __HIP_MEMORY_SCOPE_WORKGROUP)
#define INVB(m) __builtin_amdgcn_inverse_ballot_w64(m)
#define BALLOT64(p) __builtin_amdgcn_ballot_w64(p)
#define WRITELANE64(lo, hi, b, r) do { asm("v_writelane_b32 %0, %1, %2" : "+v"(lo) : "s"((unsigned)(b)), "n"(r)); asm("v_writelane_b32 %0, %1, %2" : "+v"(hi) : "s"((unsigned)((b) >> 32)), "n"(r)); } while (0)
#define MED3F(a, lo, hi) __builtin_amdgcn_fmed3f((a), (lo), (hi))
#define RLX_LOAD(p) __hip_atomic_load(p, __ATOMIC_RELAXED, __HIP_MEMORY_SCOPE_AGENT)
#define RLX_STORE(p, v) __hip_atomic_store(p, v, __ATOMIC_RELAXED, __HIP_MEMORY_SCOPE_AGENT)
#define RLX_ADD(p, v) __hip_atomic_fetch_add(p, v, __ATOMIC_RELAXED, __HIP_MEMORY_SCOPE_AGENT)
#endif

__device__ __forceinline__ int opaque(int v) { PIN1(v); return v; }
#ifndef EMU
__device__ __forceinline__ int lane_id_now() { int l; asm volatile("v_mbcnt_lo_u32_b32 %0, -1, 0\n\tv_mbcnt_hi_u32_b32 %0, -1, %0" : "=v"(l)); return l; }
#endif
__device__ __forceinline__ int opaque_s(int v) { PINS(v); return v; }
#ifdef EMU
__device__ __forceinline__ unsigned char* opaque_p(unsigned char* p) { PINS(p); return p; }
#else
__device__ __forceinline__ unsigned char* opaque_p(unsigned char* p) { unsigned long long v = (unsigned long long)p; PINS(v); return (unsigned char*)(__attribute__((address_space(1))) unsigned char*)v; }
#endif
#ifdef EMU
__device__ __forceinline__ const char* uni_ptr(const char* p) { return p; }
#else
__device__ __forceinline__ const char* uni_ptr(const char* p) { const unsigned long long v = (unsigned long long)p; const unsigned lo = __builtin_amdgcn_readfirstlane((unsigned)v), hi = __builtin_amdgcn_readfirstlane((unsigned)(v >> 32));
    return (const char*)(((unsigned long long)hi << 32) | lo); }
#endif
#ifdef EMU
__device__ __forceinline__ unsigned f2bf(float f) { unsigned u = __builtin_bit_cast(unsigned, f); return (u + 0x7fffu + ((u >> 16) & 1u)) >> 16; }
#else
__device__ __forceinline__ unsigned f2bf(float f) { return (unsigned)__builtin_bit_cast(unsigned short, (__bf16)f); }
#endif
#ifdef EMU
__device__ __forceinline__ unsigned pk2(float lo, float hi) { return f2bf(lo) | (f2bf(hi) << 16); }
#else
typedef __bf16 hw_bf16x2 __attribute__((ext_vector_type(2)));
__device__ __forceinline__ unsigned pk2(float lo, float hi) { f32x2 v = {lo, hi}; hw_bf16x2 b = __builtin_convertvector(v, hw_bf16x2); return __builtin_bit_cast(unsigned, b); }
#endif
__device__ __forceinline__ float bf2f(unsigned h) { return __builtin_bit_cast(float, h << 16); }
__device__ __forceinline__ float bflo(unsigned w) { return __builtin_bit_cast(float, w << 16); }
__device__ __forceinline__ float bfhi(unsigned w) { return __builtin_bit_cast(float, w & 0xffff0000u); }
__device__ __forceinline__ float sigmoidf_(float v) { return RCPF(1.0f + EXP2F(-1.4426950408889634f * v)); }
__device__ __forceinline__ float gelu_tanh(float v) { const float p = __builtin_fmaf(-0.10294322f, v * v, -2.30220819f); return v * RCPF(1.0f + EXP2F(v * p)); }
__device__ __forceinline__ float rs_of(u64 ss) { const float f = __builtin_fmaf((float)(unsigned)(ss >> 32), 4294967296.0f, (float)(unsigned)ss); return RSQF(f * (SS_INV / D_MODEL) + EPS); }
__device__ __forceinline__ float row_rs(const u64* rowss, int r) { return rs_of(rowss[r]); }
#ifdef EMU
#define PIN64(x)
#else
#define PIN64(x) asm volatile("" : "+v"(x))
#endif
__device__ __forceinline__ void row_rs8(float (&rs)[8], const u64* rowss, int r0) { u64 raw[8];
#pragma unroll
    for (int it = 0; it < 8; ++it) raw[it] = rowss[r0 + (it >> 2) * 128 + (it & 3) * 16];
#pragma unroll
    for (int it = 0; it < 8; ++it) PIN64(raw[it]);
#pragma unroll
    for (int it = 0; it < 8; ++it) rs[it] = rs_of(raw[it]); }
__device__ __forceinline__ int crow(int r, int hi) { return (r & 3) + 8 * (r >> 2) + 4 * hi; }

#define XB_TMO      128
#define XB_XCNT(j)  (256  + 64 * (j))
#define XB_XSUB(j)  (1280 + 64 * (j))
#define XB_XGEN(j)  (2304 + 64 * (j))
#define XB_TOP      3328
#define XB_TOPGEN   3392
#define XCD_BAR_WORDS 3456
#define XB_SPIN_CAP 0xF0000000u
struct XcdBarrier { unsigned* bar; unsigned x; volatile LAS unsigned* st; };
#ifdef EMU
__device__ __forceinline__ XcdBarrier xcd_barrier_post(unsigned* bar, volatile unsigned* st) { XcdBarrier b; b.bar = bar; b.x = 0; b.st = st; return b; }
__device__ __forceinline__ void xcd_barrier(const XcdBarrier&) { emu::grid_barrier(); }
#else
__device__ __forceinline__ unsigned xb_ld(unsigned* p)              { return __hip_atomic_load(p, __ATOMIC_RELAXED, __HIP_MEMORY_SCOPE_AGENT); }
__device__ __forceinline__ unsigned xb_add(unsigned* p, unsigned v) { return __hip_atomic_fetch_add(p + opaque(0), v, __ATOMIC_RELAXED, __HIP_MEMORY_SCOPE_AGENT); }
__device__ __forceinline__ unsigned xb_xcc_id() { return (unsigned)__builtin_amdgcn_s_getreg((3 << 11) | 20) & 0xFu; }
#define XB_SPIN(cond, bar) do { unsigned _sp = 0; while (cond) { __builtin_amdgcn_s_sleep(1); \
    if ((++_sp & 255u) == 0u) { if (xb_ld(&(bar)[XB_TMO])) break; if (_sp > XB_SPIN_CAP) { atomicAdd(&(bar)[XB_TMO], 1u); break; } } } } while (0)
__device__ __forceinline__ XcdBarrier xcd_barrier_post(unsigned* bar, volatile LAS unsigned* st) {
    XcdBarrier b; b.bar = bar; b.x = (unsigned)__builtin_amdgcn_readfirstlane((int)xb_xcc_id()); b.st = st;
    if (threadIdx.x == 0) (void)xb_add(&bar[XB_XCNT(b.x)], 1u);
    return b;
}
__device__ __forceinline__ void xcd_barrier_complete(unsigned* bar, unsigned x, unsigned& nloc, unsigned& nx) {
    const unsigned G = gridDim.x * gridDim.y * gridDim.z;
    unsigned sum, cnt, mine, sp = 0u;
    for (;;) {
        sum = 0u; cnt = 0u; mine = 0u;
#pragma unroll
        for (unsigned j = 0; j < 16; ++j) { const unsigned c = xb_ld(&bar[XB_XCNT(j)]); sum += c; cnt += (c > 0u) ? 1u : 0u; mine = (j == x) ? c : mine; }
        if (sum == G) break;
        __builtin_amdgcn_s_sleep(1);
        if ((++sp & 255u) == 0u) { if (xb_ld(&bar[XB_TMO])) break; if (sp > XB_SPIN_CAP) { atomicAdd(&bar[XB_TMO], 1u); break; } }
    }
    nloc = mine > 0u ? mine : 1u; nx = cnt > 0u ? cnt : 1u;
}
__device__ __forceinline__ void xcd_barrier(const XcdBarrier& b) {
    asm volatile("s_waitcnt vmcnt(0)" ::: "memory");
    __syncthreads();
    if (threadIdx.x == 0) {
        unsigned* bar = b.bar; const unsigned bx = (unsigned)__builtin_amdgcn_readfirstlane(opaque((int)b.x));
        __builtin_amdgcn_s_waitcnt(0);
        unsigned nloc = b.st[0], nx = b.st[1];
        if (nloc == 0u) { xcd_barrier_complete(bar, bx, nloc, nx); b.st[0] = nloc; b.st[1] = nx; }
        const unsigned old = xb_add(&bar[XB_XSUB(bx)], 1u);
        const unsigned gen = old / nloc;
        if (old + 1u == (gen + 1u) * nloc) {
            __builtin_amdgcn_fence(__ATOMIC_RELEASE, "agent");
            asm volatile("s_waitcnt vmcnt(0)" ::: "memory");
            const unsigned og = xb_add(&bar[XB_TOP], 1u);
            const unsigned tg = og / nx;
            if (og + 1u == (tg + 1u) * nx) xb_add(&bar[XB_TOPGEN], 1u);
            else XB_SPIN(xb_ld(&bar[XB_TOPGEN]) == tg, bar);
            __builtin_amdgcn_fence(__ATOMIC_ACQUIRE, "agent");
            xb_add(&bar[XB_XGEN(bx)], 1u);
            asm volatile("s_waitcnt vmcnt(0)" ::: "memory");
        } else {
            XB_SPIN(xb_ld(&bar[XB_XGEN(bx)]) == gen, bar);
            __builtin_amdgcn_fence(__ATOMIC_ACQUIRE, "agent");
            asm volatile("s_waitcnt vmcnt(0)" ::: "memory");
        }
    }
    __syncthreads();
}
#endif

namespace pg8 {
constexpr int BM = 256, BK = 64, HALF = 128, HTB = HALF * BK * 2, STAGE_BYTES = 8 * HTB, NXCD = 8, WGM = 8;
__host__ __device__ __forceinline__ int lds_byte(int r, int c) { const int st = (r >> 4) * 2 + (c >> 5), rr = r & 15, cc = c & 31, ob = rr * 64 + cc * 2; return st * 1024 + (ob ^ (((ob >> 9) & 1) << 5)); }
__host__ __device__ __forceinline__ void stage_rc(int b, int& R, int& C) { const int st = b / 1024, sb = b % 1024, swz = sb ^ (((sb >> 9) & 1) << 5); R = (st >> 1) * 16 + swz / 64; C = (st & 1) * 32 + (swz % 64) / 2; }
__host__ __device__ __forceinline__ int perm32(int rho) { const int n = rho >> 4, i = rho & 15; return 8 * (i >> 2) + 4 * n + (i & 3); }
struct Unit { int pm, pn; };
struct Gemm { const bf16_t* A; const bf16_t* Bt; int lda, ldb, K; };
struct StaticOrder {
    int nM, nN, nwg, G, c;
    __host__ __device__ void init(int M, int N, int G_, int c_) { nM = M / BM; nN = N / BM; nwg = nM * nN; G = G_; c = c_; }
    __host__ __device__ bool next(int i, Unit& u) const {
        const long L = (long)i * G + c; if (L >= nwg) return false;
        int wgid = (int)L; { const int q = nwg / NXCD, r = nwg % NXCD, xcd = wgid % NXCD, off = wgid / NXCD; wgid = (xcd < r ? xcd * (q + 1) : r * (q + 1) + (xcd - r) * q) + off; }
        const int nig = WGM * nN, gid = wgid / nig, fm = gid * WGM, gsz = (nM - fm) < WGM ? (nM - fm) : WGM;
        u.pm = fm + ((wgid % nig) % gsz); u.pn = (wgid % nig) / gsz; return true;
    }
};
struct GroupOrder {
    int G, c;
    __host__ __device__ bool next(int i, Unit& u) const { const int idx = i * G + c; if (idx >= S5_GROUPS * NCHT) return false; const int g = idx / NCHT; u.pm = idx; u.pn = g; return true; }
};

template <class Epi, class Sched>
__device__ __forceinline__ void gemm_phase(LAS unsigned char* lds, const int wave_id, const Gemm g, const Sched& S, const Epi& E) {
    const int lane = LANE_ID(), wid = opaque_s(wave_id), tid = wid * 64 + lane, wr = wid >> 2, wc = wid & 3, fr = lane & 15, fq = lane >> 4;
    const int K = g.K, nt = K / BK;
    unsigned voffA[2], voffB[2];
#pragma unroll
    for (int i = 0; i < 2; ++i) { int R, C; stage_rc(tid * 16 + i * 8192, R, C); const int Rb = Epi::PERM ? ((R & ~31) + perm32(R & 31)) : R;
        voffA[i] = (unsigned)(R * g.lda + C) * 2u; voffB[i] = (unsigned)(Rb * g.ldb + C) * 2u; }
    const size_t kstep = (size_t)(BK * 2);
    const size_t hstepA = (size_t)HALF * g.lda * 2, hstepB = (size_t)HALF * g.ldb * 2;
    const size_t tstepA = 2 * hstepA, tstepB = 2 * hstepB;
    const unsigned ldsw = (unsigned)wid * 1024u;
    const int aoff = lds_byte(wr * 64 + fr, fq * 8), boff = lds_byte(wc * 32 + fr, fq * 8);
#define PG8_SA(b, h) (((b) * 2 + (h)) * HTB)
#define PG8_SB(b, h) ((4 + (b) * 2 + (h)) * HTB)
#define PG8_STAGE(bufoff, gbase, voff) do { const char* _gb = uni_ptr((const char*)(gbase));     \
    _Pragma("unroll") for (int _i = 0; _i < 2; ++_i) \
        GLDS16B(_gb, (voff)[_i], lds + (bufoff) + ldsw + _i * 8192); } while (0)
#define PG8_LDA(dst, b, h) do { _Pragma("unroll") for (int m = 0; m < 4; ++m) _Pragma("unroll") for (int k = 0; k < 2; ++k) dst[m][k] = *(const LAS bf16x8*)(lds + PG8_SA(b, h) + aoff + m * 2048 + k * 1024); } while (0)
#define PG8_LDB(dst, b, h) do { _Pragma("unroll") for (int n = 0; n < 2; ++n) _Pragma("unroll") for (int k = 0; k < 2; ++k) dst[n][k] = *(const LAS bf16x8*)(lds + PG8_SB(b, h) + boff + n * 2048 + k * 1024); } while (0)
#define PG8_MMA(ai, bj, At, Bt) do { SETPRIO(1); _Pragma("unroll") for (int m = 0; m < 4; ++m) _Pragma("unroll") for (int n = 0; n < 2; ++n) _Pragma("unroll") for (int k = 0; k < 2; ++k) \
        acc[ai][bj][m][n] = MFMA16(Bt[n][k], At[m][k], acc[ai][bj][m][n]); SETPRIO(0); } while (0)
#define PG8_BAR S_BARRIER()
    Unit cur, nxt; int ui = 0;
    if (!S.next(0, cur)) return;
    f32x4 acc[2][2][4][2];
#pragma unroll
    for (int a = 0; a < 2; ++a)
#pragma unroll
        for (int b = 0; b < 2; ++b)
#pragma unroll
            for (int m = 0; m < 4; ++m)
#pragma unroll
                for (int n = 0; n < 2; ++n) acc[a][b][m][n] = (f32x4){0.f, 0.f, 0.f, 0.f};
    bf16x8 At[4][2], B0[2][2], B1[2][2];
    const char* cA = (const char*)g.A + (size_t)cur.pm * tstepA; const char* cB = (const char*)g.Bt + (size_t)cur.pn * tstepB;
    PG8_STAGE(PG8_SB(0, 0), cB, voffB); PG8_STAGE(PG8_SB(0, 1), cB + hstepB, voffB); PG8_STAGE(PG8_SA(0, 0), cA, voffA); PG8_STAGE(PG8_SA(0, 1), cA + hstepA, voffA);
    if (wr == 1) PG8_BAR;
    WAIT_V(2); PG8_BAR;
    PG8_STAGE(PG8_SB(1, 0), cB + kstep, voffB); PG8_STAGE(PG8_SA(1, 0), cA + kstep, voffA); PG8_STAGE(PG8_SB(1, 1), cB + hstepB + kstep, voffB);
    WAIT_V(6); PG8_BAR;
    for (;;) {
        const bool has_next = S.next(ui + 1, nxt);
        const char* nA = has_next ? (const char*)g.A + (size_t)nxt.pm * tstepA : cA; const char* nB = has_next ? (const char*)g.Bt + (size_t)nxt.pn * tstepB : cB;
        for (int t = 0; t < nt; t += 2) {
            const bool last = (t == nt - 2);
            const char* a1 = cA + (size_t)(t + 1) * kstep;
            const char* a2 = last ? nA : cA + (size_t)(t + 2) * kstep; const char* b2 = last ? nB : cB + (size_t)(t + 2) * kstep;
            const char* a3 = a2 + kstep; const char* b3 = b2 + kstep;
            PG8_LDB(B0, 0, 0); PG8_LDB(B1, 0, 1); SCHED_BAR(); PG8_LDA(At, 0, 0); PG8_STAGE(PG8_SA(1, 1), a1 + hstepA, voffA);
            WAIT_V(8); WAIT_L(0); PG8_BAR; PG8_MMA(0, 0, At, B0); PG8_MMA(0, 1, At, B1); PG8_BAR; SCHED_BAR();
            PG8_LDA(At, 0, 1); PG8_STAGE(PG8_SB(0, 0), b2, voffB); PG8_STAGE(PG8_SB(0, 1), b2 + hstepB, voffB); PG8_STAGE(PG8_SA(0, 0), a2, voffA);
            WAIT_V(8); WAIT_L(0); PG8_BAR; PG8_MMA(1, 0, At, B0); PG8_MMA(1, 1, At, B1); PG8_BAR; SCHED_BAR();
            PG8_LDB(B0, 1, 0); PG8_LDB(B1, 1, 1); SCHED_BAR(); PG8_LDA(At, 1, 0); PG8_STAGE(PG8_SA(0, 1), a2 + hstepA, voffA);
            WAIT_V(8); WAIT_L(0); PG8_BAR; PG8_MMA(0, 0, At, B0); PG8_MMA(0, 1, At, B1); PG8_BAR; SCHED_BAR();
            PG8_LDA(At, 1, 1); PG8_STAGE(PG8_SB(1, 0), b3, voffB); PG8_STAGE(PG8_SB(1, 1), b3 + hstepB, voffB); PG8_STAGE(PG8_SA(1, 0), a3, voffA);
            WAIT_V(8); WAIT_L(0); PG8_BAR; PG8_MMA(1, 0, At, B0); PG8_MMA(1, 1, At, B1); PG8_BAR; SCHED_BAR();
        }
        if (wr == 0) PG8_BAR;
        { const int le = LANE_ID(); E(acc, cur, wr, wc, le & 15, le >> 4); }
        if (!has_next) break;
#pragma unroll
        for (int a = 0; a < 2; ++a)
#pragma unroll
            for (int b = 0; b < 2; ++b)
#pragma unroll
                for (int m = 0; m < 4; ++m)
#pragma unroll
                    for (int n = 0; n < 2; ++n) acc[a][b][m][n] = (f32x4){0.f, 0.f, 0.f, 0.f};
        cur = nxt; cA = nA; cB = nB; ++ui;
        if (wr == 1) PG8_BAR;
    }
    WAIT_V(0);
    PG8_BAR;
#undef PG8_SA
#undef PG8_SB
#undef PG8_STAGE
#undef PG8_LDA
#undef PG8_LDB
#undef PG8_MMA
#undef PG8_BAR
}
}
using pg8::Unit;

#ifdef EMU
#define SHFL_XOR_F(v, m) __shfl_xor(v, m)
#define SHFL_IDX_U(v, i) __shfl(v, i)
__device__ __forceinline__ float sum_x16(float s) { return s + __shfl_xor(s, 16); }
__device__ __forceinline__ float sum_x32(float s) { return s + __shfl_xor(s, 32); }
#else
#define SHFL_XOR_F(v, m) __builtin_bit_cast(float, __builtin_amdgcn_ds_swizzle(__builtin_bit_cast(int, (float)(v)), (((m) << 10) | 0x1F)))
#define SHFL_IDX_U(v, i) ((unsigned)__builtin_amdgcn_ds_bpermute((i) << 2, (int)(v)))
__device__ __forceinline__ float sum_x16(float s) { float a = s, b = s; asm("s_nop 1\n\tv_permlane16_swap_b32 %0, %1" : "+v"(a), "+v"(b)); return a + b; }
__device__ __forceinline__ float sum_x32(float s) { float a = s, b = s; asm("s_nop 1\n\tv_permlane32_swap_b32 %0, %1" : "+v"(a), "+v"(b)); return a + b; }
#endif
__device__ __forceinline__ float quad_sum(float s) { return sum_x32(sum_x16(s)); }

template <bool GLU> struct EpiRes {
    static constexpr bool PERM = true;
    bf16_t* xb; float* xout; u64* rowss;
    __device__ __forceinline__ void operator()(const f32x4 (&acc)[2][2][4][2], const Unit& u, int wr, int wc, int fr, int fq) const {
        PIN1(fr); PIN1(fq);
        constexpr int NB = GLU ? 1 : 2;
        const bool last = xout != nullptr;
#pragma unroll
        for (int ai = 0; ai < 2; ++ai) {
            u32x4 xo[4][NB];
#pragma unroll
            for (int m = 0; m < 4; ++m) { const int r = u.pm * 256 + ai * 128 + wr * 64 + m * 16 + fr;
#pragma unroll
                for (int bj = 0; bj < NB; ++bj) { const size_t off = (size_t)r * D_MODEL + (GLU ? u.pn * 128 : u.pn * 256 + bj * 128) + wc * 32 + 8 * fq; xo[m][bj] = *(const u32x4*)(xb + off); } }
#pragma unroll
            for (int m = 0; m < 4; ++m) { const int r = u.pm * 256 + ai * 128 + wr * 64 + m * 16 + fr; float ss = 0.f;
#pragma unroll
                for (int bj = 0; bj < NB; ++bj) { const size_t off = (size_t)r * D_MODEL + (GLU ? u.pn * 128 : u.pn * 256 + bj * 128) + wc * 32 + 8 * fq; f32x4 o[2];
                    const unsigned xw[4] = {xo[m][bj].x, xo[m][bj].y, xo[m][bj].z, xo[m][bj].w};
#pragma unroll
                    for (int n = 0; n < 2; ++n)
#pragma unroll
                        for (int i = 0; i < 4; ++i) { const unsigned w2 = xw[2 * n + (i >> 1)]; const float xv = (i & 1) ? bfhi(w2) : bflo(w2);
                            const float t = xv + (GLU ? acc[ai][0][m][n][i] * sigmoidf_(acc[ai][1][m][n][i]) : acc[ai][bj][m][n][i]); o[n][i] = t; ss += t * t; }
                    if (last) { *(f32x4*)(xout + off) = o[0]; *(f32x4*)(xout + off + 4) = o[1]; }
                    else { u32x4 w; w.x = pk2(o[0][0], o[0][1]); w.y = pk2(o[0][2], o[0][3]); w.z = pk2(o[1][0], o[1][1]); w.w = pk2(o[1][2], o[1][3]); *(u32x4*)(xb + off) = w; } }
                if (!last) { ss = quad_sum(ss); if (fq == 0) atomicAdd(rowss + r, (u64)(ss * SS_FIX)); } }
        }
    }
};
struct EpiSwiGLU {
    static constexpr bool PERM = true;
    bf16_t* act; const u64* rowss;
    __device__ __forceinline__ void operator()(const f32x4 (&acc)[2][2][4][2], const Unit& u, int wr, int wc, int fr, int fq) const {
        PIN1(fr); PIN1(fq);
        float rsv8[8]; row_rs8(rsv8, rowss, u.pm * 256 + wr * 64 + fr);
#pragma unroll
        for (int ai = 0; ai < 2; ++ai)
#pragma unroll
            for (int m = 0; m < 4; ++m) {
                const int r = u.pm * 256 + ai * 128 + wr * 64 + m * 16 + fr; const float rs = rsv8[ai * 4 + m], rs2 = rs * rs, nrs = -1.4426950408889634f * rs;
                float o[8];
#pragma unroll
                for (int n = 0; n < 2; ++n)
#pragma unroll
                    for (int i = 0; i < 4; ++i) { const float g_ = acc[ai][0][m][n][i], u_ = acc[ai][1][m][n][i]; o[4 * n + i] = (g_ * u_) * (rs2 * RCPF(1.0f + EXP2F(nrs * g_))); }
                u32x4 w; w.x = pk2(o[0], o[1]); w.y = pk2(o[2], o[3]); w.z = pk2(o[4], o[5]); w.w = pk2(o[6], o[7]);
                *(u32x4*)(act + (size_t)r * D_FF + u.pn * 128 + wc * 32 + 8 * fq) = w;
            }
    }
};
struct EpiInProj {
    static constexpr bool PERM = true;
    bf16_t *Q, *Kb, *V, *QI, *KI; float* WI; const u64* rowss; const float* rope; const float* qg; const float* kg;
    __device__ __forceinline__ void operator()(const f32x4 (&acc)[2][2][4][2], const Unit& u, int wr, int wc, int fr, int fq) const {
        PIN1(fr); PIN1(fq);
        const int pn = u.pn; const int r0 = u.pm * 256 + wr * 64 + fr;
        if (pn >= 2 * NH4 && pn < 3 * NH4) {
            float rsv[8]; row_rs8(rsv, rowss, r0);
#pragma unroll
            for (int it = 0; it < 8; ++it) { const int ai = it >> 2, m = it & 3; const int r = r0 + ai * 128 + m * 16; const float rs = rsv[it];
                const size_t off = (size_t)r * D_MODEL + (pn - 2 * NH4) * 256 + wc * 32 + 8 * fq; u32x4 w;
                w.x = pk2(rs * acc[ai][0][m][0][0], rs * acc[ai][0][m][0][1]); w.y = pk2(rs * acc[ai][0][m][0][2], rs * acc[ai][0][m][0][3]); w.z = pk2(rs * acc[ai][0][m][1][0], rs * acc[ai][0][m][1][1]); w.w = pk2(rs * acc[ai][0][m][1][2], rs * acc[ai][0][m][1][3]); *(u32x4*)(V + off) = w;
                w.x = pk2(rs * acc[ai][1][m][0][0], rs * acc[ai][1][m][0][1]); w.y = pk2(rs * acc[ai][1][m][0][2], rs * acc[ai][1][m][0][3]); w.z = pk2(rs * acc[ai][1][m][1][0], rs * acc[ai][1][m][1][1]); w.w = pk2(rs * acc[ai][1][m][1][2], rs * acc[ai][1][m][1][3]); *(u32x4*)(V + off + 128) = w; }
            return;
        }
        const bool last = (pn == 3 * NH4 + 2);
        if (last && wc == 1) {
#pragma unroll
            for (int it = 0; it < 8; ++it) { const int ai = it >> 2, m = it & 3; const int r = r0 + ai * 128 + m * 16; const float sc = row_rs(rowss, r) * (0.35355339059327373f * 0.125f);
                if (fq == 0) { *(f32x4*)(WI + (size_t)r * 8) = (f32x4){acc[ai][0][m][0][0] * sc, acc[ai][0][m][0][1] * sc, acc[ai][0][m][0][2] * sc, acc[ai][0][m][0][3] * sc};
                               *(f32x4*)(WI + (size_t)r * 8 + 4) = (f32x4){acc[ai][0][m][1][0] * sc, acc[ai][0][m][1][1] * sc, acc[ai][0][m][1][2] * sc, acc[ai][0][m][1][3] * sc}; } }
            return;
        }
        if (last && wc != 0) return;
        const bool isq = pn < NH4, isk = (pn >= NH4 && pn < 2 * NH4), nrm = isq || isk || last;
        float g1[8], g2[8];
        { const float* gn = isq ? qg : kg;
#pragma unroll
          for (int i = 0; i < 8; ++i) { g1[i] = (isq || isk) ? gn[8 * fq + i] : 1.0f; g2[i] = (isq || isk) ? gn[32 + 8 * fq + i] : 1.0f; } }
        const float qs = isq ? C2 : 1.0f;
        bf16_t* dst0;
        if (isq) dst0 = Q + (size_t)r0 * D_MODEL + (pn * 4 + wc) * 64; else if (isk) dst0 = Kb + (size_t)r0 * D_MODEL + ((pn - NH4) * 4 + wc) * 64;
        else if (last) dst0 = KI + (size_t)r0 * 64; else dst0 = QI + (size_t)r0 * 512 + ((pn - 3 * NH4) * 4 + wc) * 64;
        const size_t dstride = (isq || isk) ? (size_t)D_MODEL : (last ? (size_t)64 : (size_t)512);
        f32x4 cn[4]; float rsn;
        { const float* cs = rope + (size_t)r0 * 64 + 8 * fq; rsn = row_rs(rowss, r0); cn[0] = *(const f32x4*)cs; cn[1] = *(const f32x4*)(cs + 4); cn[2] = *(const f32x4*)(cs + 32); cn[3] = *(const f32x4*)(cs + 36); }
#pragma unroll
        for (int it = 0; it < 8; ++it) { const int ai = it >> 2, m = it & 3; const int rofs = ai * 128 + m * 16;
            const f32x4 c0 = cn[0], c1 = cn[1], s0 = cn[2], s1 = cn[3]; const float rs = rsn;
            if (it < 7) { const int rn_ = r0 + ((it + 1) >> 2) * 128 + ((it + 1) & 3) * 16; const float* cs = rope + (size_t)rn_ * 64 + 8 * fq; rsn = row_rs(rowss, rn_);
                cn[0] = *(const f32x4*)cs; cn[1] = *(const f32x4*)(cs + 4); cn[2] = *(const f32x4*)(cs + 32); cn[3] = *(const f32x4*)(cs + 36); }
            float t1[8], t2[8];
#pragma unroll
            for (int n = 0; n < 2; ++n)
#pragma unroll
                for (int i = 0; i < 4; ++i) { t1[4 * n + i] = acc[ai][0][m][n][i]; t2[4 * n + i] = acc[ai][1][m][n][i]; }
            float f = rs * qs;
            if (nrm) {
                float ss = 0.f;
#pragma unroll
                for (int i = 0; i < 8; ++i) ss += t1[i] * t1[i] + t2[i] * t2[i];
                ss = quad_sum(ss); f *= RSQF(rs * rs * ss * (1.0f / 64.0f) + EPS);
            }
#pragma unroll
            for (int i = 0; i < 8; ++i) { t1[i] *= f * g1[i]; t2[i] *= f * g2[i]; }
            const float cc[8] = {c0[0], c0[1], c0[2], c0[3], c1[0], c1[1], c1[2], c1[3]}, sv[8] = {s0[0], s0[1], s0[2], s0[3], s1[0], s1[1], s1[2], s1[3]};
            float o1[8], o2[8];
#pragma unroll
            for (int i = 0; i < 8; ++i) { o1[i] = t1[i] * cc[i] - t2[i] * sv[i]; o2[i] = t2[i] * cc[i] + t1[i] * sv[i]; }
            bf16_t* dst = dst0 + (size_t)rofs * dstride;
            u32x4 w; w.x = pk2(o1[0], o1[1]); w.y = pk2(o1[2], o1[3]); w.z = pk2(o1[4], o1[5]); w.w = pk2(o1[6], o1[7]); *(u32x4*)(dst + 8 * fq) = w;
            w.x = pk2(o2[0], o2[1]); w.y = pk2(o2[2], o2[3]); w.z = pk2(o2[4], o2[5]); w.w = pk2(o2[6], o2[7]); *(u32x4*)(dst + 32 + 8 * fq) = w;
        }
    }
};
struct EpiS5State {
    static constexpr bool PERM = true;
    bf16_t* S;
    __device__ __forceinline__ void operator()(const f32x4 (&acc)[2][2][4][2], const Unit& u, int wr, int wc, int fr, int fq) const {
        PIN1(fr); PIN1(fq);
#pragma unroll
        for (int ai = 0; ai < 2; ++ai)
#pragma unroll
            for (int m = 0; m < 4; ++m) { const size_t row = (size_t)u.pm * 256 + ai * 128 + wr * 64 + m * 16 + fr;
                u32x4 w; w.x = pk2(acc[ai][0][m][0][0], acc[ai][0][m][0][1]); w.y = pk2(acc[ai][0][m][0][2], acc[ai][0][m][0][3]); w.z = pk2(acc[ai][0][m][1][0], acc[ai][0][m][1][1]); w.w = pk2(acc[ai][0][m][1][2], acc[ai][0][m][1][3]);
                *(u32x4*)(S + row * 128 + wc * 32 + 8 * fq) = w; }
    }
};
struct EpiS5Out {
    static constexpr bool PERM = true;
    bf16_t* Y; const bf16_t* UX; const float* dskip;
    __device__ __forceinline__ void operator()(const f32x4 (&acc)[2][2][4][2], const Unit& u, int wr, int wc, int fr, int fq) const {
        PIN1(fr); PIN1(fq);
        const int g = u.pn;
        float dk[8];
        { const float* dp = dskip + 16 * g + ((wc * 32 + 8 * fq) & 15);
#pragma unroll
          for (int e = 0; e < 8; ++e) dk[e] = dp[e]; }
#pragma unroll
        for (int ai = 0; ai < 2; ++ai)
#pragma unroll
            for (int mp = 0; mp < 2; ++mp) {
                u32x4 uw[2][2];
#pragma unroll
                for (int mm = 0; mm < 2; ++mm) { const size_t row = (size_t)u.pm * 256 + ai * 128 + wr * 64 + (2 * mp + mm) * 16 + fr;
#pragma unroll
                    for (int bj = 0; bj < 2; ++bj) uw[mm][bj] = *(const u32x4*)(UX + row * UXW + bj * 128 + wc * 32 + 8 * fq); }
#pragma unroll
                for (int mm = 0; mm < 2; ++mm) { const int m = 2 * mp + mm; const size_t row = (size_t)u.pm * 256 + ai * 128 + wr * 64 + m * 16 + fr; const int c = (int)(row - (size_t)g * NCH);
#pragma unroll
                    for (int bj = 0; bj < 2; ++bj) { const int col = bj * 128 + wc * 32 + 8 * fq, i = col >> 4, ho = col & 15;
                        float o[8]; const unsigned uu[4] = {uw[mm][bj].x, uw[mm][bj].y, uw[mm][bj].z, uw[mm][bj].w};
#pragma unroll
                        for (int n = 0; n < 2; ++n)
#pragma unroll
                            for (int j = 0; j < 4; ++j) { const int e = 4 * n + j; const float uv = (e & 1) ? bfhi(uu[e >> 1]) : bflo(uu[e >> 1]); o[e] = gelu_tanh(acc[ai][bj][m][n][j] + dk[e] * uv); }
                        u32x4 w; w.x = pk2(o[0], o[1]); w.y = pk2(o[2], o[3]); w.z = pk2(o[4], o[5]); w.w = pk2(o[6], o[7]);
                        *(u32x4*)(Y + (size_t)(16 * c + i) * D_MODEL + 16 * g + ho) = w; } }
            }
    }
};

constexpr int RING_BYTES = 131072, LDSCTL_OFF = RING_BYTES, LDS_BYTES = 147456;
struct Args { const float* in[18]; float* out; unsigned char* ws; };
struct Frame {
    LAS unsigned char* lds; int tid, lane, wave, vcu, G;
    const float* in[18]; float* out; unsigned char* ws;
};
__device__ __forceinline__ float wave_sum(float v) {
    v += SHFL_XOR_F(v, 1); v += SHFL_XOR_F(v, 2); v += SHFL_XOR_F(v, 4); v += SHFL_XOR_F(v, 8); v += SHFL_XOR_F(v, 16);
    return sum_x32(v);
}
__device__ __forceinline__ int win_src(int np) {
    const int pn = np >> 8, y = np & 255, bj = y >> 7, hh = (y >> 5) & 3, dd = y & 31;
    if (pn < 2 * NH4) { const int base = pn < NH4 ? 0 : D_MODEL, t = pn < NH4 ? pn : pn - NH4; return base + (4 * t + hh) * 64 + 32 * bj + dd; }
    if (pn < 3 * NH4) return np;
    if (pn < 3 * NH4 + 2) return 3 * D_MODEL + (4 * (pn - 3 * NH4) + hh) * 64 + 32 * bj + dd;
    if (hh == 0) return 3 * D_MODEL + 512 + 32 * bj + dd;
    if (hh == 1 && bj == 0 && dd < 8) return 3 * D_MODEL + 512 + 64 + dd;
    return -1;
}
__device__ __forceinline__ int glu_src(int np, int HW) { const int pn = np >> 8, y = np & 255; return (y >> 7) * HW + pn * 128 + (y & 127); }

struct TItem { const float* W; const float* gain; bf16_t* WT; int K, N, HW, NP, mode, item; };
__device__ __forceinline__ void ti_load(const TItem& T, float (&v)[32], f32x4 (&g)[2], int lane) {
    const int nblk = T.NP / 32, kb = T.item / nblk, nb = T.item % nblk, k0 = 64 * kb, n0 = 32 * nb;
    const int np = n0 + (lane & 31); const int src = T.mode == 0 ? np : (T.mode == 1 ? glu_src(np, T.HW) : win_src(np));
    const float* wp = T.W + (size_t)(k0 + (lane >> 5)) * T.N + (src >= 0 ? src : 0);
#pragma unroll
    for (int i = 0; i < 32; ++i) { const float x = wp[(size_t)(2 * i) * T.N]; v[i] = (src >= 0) ? x : 0.f; }
    if (T.gain) { g[0] = *(const f32x4*)(T.gain + k0 + 8 * (lane & 7)); g[1] = *(const f32x4*)(T.gain + k0 + 8 * (lane & 7) + 4); }
    else { g[0] = (f32x4){1.f, 1.f, 1.f, 1.f}; g[1] = g[0]; }
}
__device__ __forceinline__ void ti_finish(const TItem& T, const float (&v)[32], const f32x4 (&g)[2], LAS float* scr, int lane) {
    const int nblk = T.NP / 32, kb = T.item / nblk, nb = T.item % nblk, k0 = 64 * kb, n0 = 32 * nb;
#pragma unroll
    for (int i = 0; i < 32; ++i) scr[(2 * i + (lane >> 5)) * 33 + (lane & 31)] = v[i];
    WAIT_L(0);
    const int c = lane & 7;
#pragma unroll
    for (int j = 0; j < 4; ++j) { const int n = (lane >> 3) + 8 * j; const LAS float* q = scr + (8 * c) * 33 + n;
        u32x4 o; o.x = pk2(q[0 * 33] * g[0][0], q[1 * 33] * g[0][1]); o.y = pk2(q[2 * 33] * g[0][2], q[3 * 33] * g[0][3]); o.z = pk2(q[4 * 33] * g[1][0], q[5 * 33] * g[1][1]); o.w = pk2(q[6 * 33] * g[1][2], q[7 * 33] * g[1][3]);
        *(u32x4*)(T.WT + (size_t)(n0 + n) * T.K + k0 + 8 * c) = o; }
    WAIT_L(0);
}
__device__ __forceinline__ void s5_pre(Frame& F0) {
    Frame F = F0; F.lane = LANE_ID(); F.tid = F0.wave * 64 + F.lane;
    static_assert((SEGL & (SEGL - 1)) == 0, "a^(16 SEGL) by repeated squaring");
    for (int jg = blockIdx.x; jg < N_S5 * S5_GROUPS; jg += F.G) {
        const float* lre = F.in[1] + (size_t)jg * 64; const float* lim = F.in[2] + (size_t)jg * 64; const float* bre = F.in[4] + (size_t)jg * 1024; const float* bim = F.in[5] + (size_t)jg * 1024;
        float* pre = (float*)(F.ws + WS_S5PRE + (size_t)jg * S5PRE_STRIDE);
        if (F.tid < 64) { const int p = F.tid;
            const double dt = exp((double)F.in[3][jg]), lr = lre[p], li = lim[p], m = exp(lr * dt), ar = m * cos(li * dt), ai = m * sin(li * dt);
            double pr = 1.0, pi = 0.0, a16r = 1.0, a16i = 0.0;
            for (int tau = 0; tau < 18; ++tau) { pre[(tau * 64 + p) * 2] = (float)pr; pre[(tau * 64 + p) * 2 + 1] = (float)pi; if (tau == 16) { a16r = pr; a16i = pi; }
                const double nr = pr * ar - pi * ai, ni = pr * ai + pi * ar; pr = nr; pi = ni; }
            const double den = lr * lr + li * li, qr = ((ar - 1.0) * lr + ai * li) / den, qi = (ai * lr - (ar - 1.0) * li) / den;
            for (int h = 0; h < 16; ++h) { const int e = p * 16 + h; const double br = bre[e], bi = bim[e]; pre[2304 + e * 2] = (float)(qr * br - qi * bi); pre[2304 + e * 2 + 1] = (float)(qr * bi + qi * br); }
            double sr = a16r, si = a16i;
            for (int k = SEGL; k > 1; k >>= 1) { const double nr = sr * sr - si * si, ni = 2.0 * sr * si; sr = nr; si = ni; }
            f32x4 v; v.x = (float)a16r; v.y = (float)a16i; v.z = (float)sr; v.w = (float)si;
            *(f32x4*)(pre + 4352 + p * 4) = v; }
    }
}
__device__ __forceinline__ void s5_setup(Frame& F0) {
    Frame F = F0; F.lane = LANE_ID(); F.tid = F0.wave * 64 + F.lane;
    LAS float* ap = (LAS float*)F.lds;
    LAS float* bb = ap + 18 * 128;
    LAS float* cc = bb + 2048;
    LAS float* kt = cc + 2048;
    for (int jg = blockIdx.x; jg < N_S5 * S5_GROUPS; jg += F.G) {
        const int j = jg / S5_GROUPS, g = jg % S5_GROUPS;
        const float* cre = F.in[6] + (size_t)j * S5_GROUPS * 1024; const float* cim = F.in[7] + (size_t)j * S5_GROUPS * 1024;
        bf16_t* AM = (bf16_t*)(F.ws + WS_S5TAB + (size_t)j * SZ_S5TAB + MIX_AM); bf16_t* W1 = (bf16_t*)(F.ws + WS_S5TAB + (size_t)j * SZ_S5TAB + MIX_W1);
        __syncthreads();
        const float* pre = (const float*)(F.ws + WS_S5PRE + ((size_t)j * S5_GROUPS + g) * S5PRE_STRIDE);
        for (int e = F.tid; e < 4352; e += NTHREADS) ap[e] = pre[e];
        for (int e = F.tid; e < 1024; e += NTHREADS) { cc[e * 2] = cre[(size_t)g * 1024 + e]; cc[e * 2 + 1] = cim[(size_t)g * 1024 + e]; }
        __syncthreads();
        if (F.tid < 256) { const int tau = F.tid >> 4, ho = F.tid & 15; float sk[16];
#pragma unroll
            for (int hi = 0; hi < 16; ++hi) sk[hi] = 0.f;
            for (int p = 0; p < 64; ++p) { const float cr = cc[(ho * 64 + p) * 2], ci = cc[(ho * 64 + p) * 2 + 1], ar = ap[(tau * 64 + p) * 2], ai = ap[(tau * 64 + p) * 2 + 1];
                const float xr = cr * ar - ci * ai, xi = cr * ai + ci * ar; const LAS f32x4* bq = (const LAS f32x4*)(bb + p * 32);
#pragma unroll
                for (int q = 0; q < 8; ++q) { const f32x4 b2 = bq[q]; sk[2 * q] += xr * b2.x - xi * b2.y; sk[2 * q + 1] += xr * b2.z - xi * b2.w; } }
#pragma unroll
            for (int hi = 0; hi < 16; ++hi) kt[F.tid * 16 + hi] = sk[hi]; }
        __syncthreads();
        bf16_t* am = AM + (size_t)g * 256 * UXW;
        for (int e = F.tid; e < 256 * (UXW / 2); e += NTHREADS) { const int np = e / (UXW / 2), k = 2 * (e % (UXW / 2)), i = np >> 4, ho = np & 15; float v0, v1;
            if (k < 256) { const int jj = k >> 4, hi = k & 15; v0 = (jj <= i) ? kt[((i - jj) * 16 + ho) * 16 + hi] : 0.f; v1 = (jj <= i) ? kt[((i - jj) * 16 + ho) * 16 + hi + 1] : 0.f; }
            else { const int p = (k - 256) >> 1; const float cr = cc[(ho * 64 + p) * 2], ci = cc[(ho * 64 + p) * 2 + 1], ar = ap[((i + 1) * 64 + p) * 2], ai = ap[((i + 1) * 64 + p) * 2 + 1];
                v0 = cr * ar - ci * ai; v1 = -(cr * ai + ci * ar); }
            *(unsigned*)(am + (size_t)np * UXW + k) = pk2(v0, v1); }
        bf16_t* w1 = W1 + (size_t)g * 256 * 256;
        for (int e = F.tid; e < 256 * 128; e += NTHREADS) { const int np = e >> 7, k = 2 * (e & 127); float v[2] = {0.f, 0.f};
            if (np < 128) { const int p = np >> 1, comp = np & 1, jj = k >> 4;
#pragma unroll
                for (int t = 0; t < 2; ++t) { const int h = (k & 15) + t; const float ar = ap[((15 - jj) * 64 + p) * 2], ai = ap[((15 - jj) * 64 + p) * 2 + 1], br = bb[(p * 16 + h) * 2], bi = bb[(p * 16 + h) * 2 + 1];
                    v[t] = comp ? (ar * bi + ai * br) : (ar * br - ai * bi); } }
            *(unsigned*)(w1 + (size_t)np * 256 + k) = pk2(v[0], v[1]); }
    }
    __syncthreads();
}

constexpr int I_GLU = (D_MODEL / 64) * (2 * D_MODEL / 32), I_IN = (D_MODEL / 64) * (NIN_PAD / 32), I_O = (D_MODEL / 64) * (D_MODEL / 32), I_GU = (D_MODEL / 64) * (2 * D_FF / 32), I_DN = (D_FF / 64) * (D_MODEL / 32);
__device__ __forceinline__ int ti_layer_items(int layer) { return ((layer & 1) ? I_IN + I_O : I_GLU) + I_GU + I_DN; }
__device__ __forceinline__ TItem ti_decode_layer(const Frame& F, int layer, int r) {
    const int j = layer >> 1; TItem T;
    if ((layer & 1) == 0) { if (r < I_GLU) { T = TItem{F.in[9] + (size_t)j * D_MODEL * 2 * D_MODEL, nullptr, (bf16_t*)(F.ws + WS_WGLU + j * SZ_WGLU), D_MODEL, 2 * D_MODEL, D_MODEL, 2 * D_MODEL, 1, r}; return T; } r -= I_GLU; }
    else { if (r < I_IN) { T = TItem{F.in[10] + (size_t)j * D_MODEL * DSA_PROJ, F.in[16] + (size_t)(2 * j + 1) * D_MODEL, (bf16_t*)(F.ws + WS_WIN + j * SZ_WIN), D_MODEL, DSA_PROJ, 0, NIN_PAD, 2, r}; return T; } r -= I_IN;
           if (r < I_O) { T = TItem{F.in[13] + (size_t)j * D_MODEL * D_MODEL, nullptr, (bf16_t*)(F.ws + WS_WO + j * SZ_WO), D_MODEL, D_MODEL, 0, D_MODEL, 0, r}; return T; } r -= I_O; }
    if (r < I_GU) { T = TItem{F.in[14] + (size_t)layer * D_MODEL * 2 * D_FF, F.in[17] + (size_t)layer * D_MODEL, (bf16_t*)(F.ws + WS_WGU + layer * SZ_WGU), D_MODEL, 2 * D_FF, D_FF, 2 * D_FF, 1, r}; return T; } r -= I_GU;
    T = TItem{F.in[15] + (size_t)layer * D_FF * D_MODEL, nullptr, (bf16_t*)(F.ws + WS_WDN + layer * SZ_WDN), D_FF, D_MODEL, 0, D_MODEL, 0, r}; return T;
}
template <class ItemFn> __device__ __forceinline__ void convert_run(Frame& F, int layer, ItemFn item) {
    LAS float* scr = (LAS float*)(F.lds + 32768 + F.wave * 8704);
    const int nitems = ti_layer_items(layer);
    int it = item(0);
    if (it >= nitems) return;
    TItem cur = ti_decode_layer(F, layer, it); float v[32]; f32x4 g[2]; ti_load(cur, v, g, F.lane);
    for (int k = 1; ; ++k) {
        const int nit = item(k); const bool more = nit < nitems; TItem nxt = cur; float vn[32]; f32x4 gn[2];
        if (more) { nxt = ti_decode_layer(F, layer, nit); ti_load(nxt, vn, gn, F.lane); }
        ti_finish(cur, v, g, scr, F.lane);
        if (!more) break;
        cur = nxt; g[0] = gn[0]; g[1] = gn[1];
#pragma unroll
        for (int i = 0; i < 32; ++i) v[i] = vn[i];
    }
}
constexpr int CW_RATIO = 2;
__device__ __forceinline__ int cw_item(int k, bool busy, int w, int NBW, int BW) { const int P = CW_RATIO * NBW + BW; return busy ? k * P + CW_RATIO * NBW + w : (k / CW_RATIO) * P + (k % CW_RATIO) * NBW + w; }
__device__ __forceinline__ void convert_weights(Frame& F0) {
    Frame F = F0; F.lane = LANE_ID(); F.tid = F0.wave * 64 + F.lane;
    const int nbusy = N_S5 * S5_GROUPS < F.G ? N_S5 * S5_GROUPS : F.G, bx = (int)blockIdx.x;
    const bool busy = bx < nbusy; const int NBW = (F.G - nbusy) * NWAVES, BW = nbusy * NWAVES, w = busy ? bx * NWAVES + F.wave : (bx - nbusy) * NWAVES + F.wave;
    convert_run(F, 0, [&](int k) { return cw_item(k, busy, w, NBW, BW); });
}
__device__ __forceinline__ void convert_next_layer(Frame& F0, int layer) {
    Frame F = F0; F.lane = LANE_ID(); F.tid = F0.wave * 64 + F.lane;
    const int ntl = (SEQ / 256) * (2 * D_FF / 256), rem = ntl % F.G, bx = (int)blockIdx.x;
    WAIT_VM0(); __syncthreads();
    if (rem == 0 || bx >= rem) { const int rank = rem == 0 ? bx : bx - rem, cnt = rem == 0 ? F.G : F.G - rem; const int w0 = rank * NWAVES + F.wave, st = cnt * NWAVES;
        convert_run(F, layer, [&](int k) { return w0 + k * st; }); }
    __syncthreads();
}
__device__ __forceinline__ void prologue_rows(Frame& F0) {
    Frame F = F0; F.lane = LANE_ID(); F.tid = F0.wave * 64 + F.lane;
    const int gw = F.vcu * NWAVES + F.wave, NGW = F.G * NWAVES;
    u64* rowss0 = (u64*)(F.ws + WS_ROWSS); float* rope = (float*)(F.ws + WS_ROPE); bf16_t* XB = (bf16_t*)(F.ws + WS_XB);
    const float inv_freq = powf(10000.0f, -(float)(2 * (F.lane & 31)) / 64.0f);
    static_assert(D_MODEL % 256 == 0 && D_MODEL / 256 <= 4, "row chunks per lane");
    constexpr int NCK = D_MODEL / 256; f32x4 xv[NCK], xn[NCK];
    if (gw < SEQ) {
#pragma unroll
        for (int k = 0; k < NCK; ++k) xv[k] = *(const f32x4*)(F.in[0] + (size_t)gw * D_MODEL + F.lane * 4 + 256 * k); }
    for (int m = gw; m < SEQ; m += NGW) {
        float s = 0.f;
        if (m + NGW < SEQ) {
#pragma unroll
            for (int k = 0; k < NCK; ++k) xn[k] = *(const f32x4*)(F.in[0] + (size_t)(m + NGW) * D_MODEL + F.lane * 4 + 256 * k); }
#pragma unroll
        for (int k = 0; k < NCK; ++k) { const f32x4 v = xv[k]; s += (v.x * v.x + v.y * v.y) + (v.z * v.z + v.w * v.w);
            u32x2 w; w.x = pk2(v.x, v.y); w.y = pk2(v.z, v.w); *(u32x2*)(XB + (size_t)m * D_MODEL + F.lane * 4 + 256 * k) = w; }
#pragma unroll
        for (int k = 0; k < NCK; ++k) xv[k] = xn[k];
        s = wave_sum(s); if (F.lane == 0) rowss0[m] = (u64)(s * SS_FIX);
        if (F.lane < 32) { const float ang = (float)m * inv_freq;
            const double ad = (double)ang, nq = rint(ad * 0.63661977236758134308); const float r = (float)fma(-nq, 1.57079632679489661923, ad), r2 = r * r; const int qd = (int)nq & 3;
            const float sn = r + r * r2 * (-1.6666667163e-1f + r2 * (8.3333337680e-3f + r2 * (-1.9841270114e-4f + r2 * 2.7557314297e-6f)));
            const float cs = 1.0f + r2 * (-0.5f + r2 * (4.1666667908e-2f + r2 * (-1.3888889225e-3f + r2 * (2.4801587642e-5f + r2 * -2.7557314297e-7f))));
            const float c1 = (qd & 1) ? sn : cs, s1 = (qd & 1) ? cs : sn;
            rope[(size_t)m * 64 + F.lane] = (qd == 1 || qd == 2) ? -c1 : c1; rope[(size_t)m * 64 + 32 + F.lane] = (qd >= 2) ? -s1 : s1; }
    }
}

__device__ __forceinline__ void s5_build_ux(Frame& F0, const bf16_t* x, const u64* rowss, const float* gain) {
    Frame F = F0; F.lane = LANE_ID(); F.tid = F0.wave * 64 + F.lane;
    bf16_t* UX = (bf16_t*)(F.ws + WS_R + R_UX);
    const int gw = F.vcu * NWAVES + F.wave, NGW = F.G * NWAVES; const int j = F.lane >> 2, p = F.lane & 3;
    constexpr int NIT = NCH * (S5_GROUPS / 4);
    u32x4 xa, xc, na, nc; f32x4 gg[4], ng[4]; u64 ssq = 0, nss = 0;
#define BUX_LOAD(it_, A_, C_, G_, S_) do { const int c_ = (it_) / (S5_GROUPS / 4), gq_ = (it_) % (S5_GROUPS / 4), g_ = 4 * gq_ + p, t_ = 16 * c_ + j; const bf16_t* xr_ = x + (size_t)t_ * D_MODEL + 16 * g_; \
        A_ = *(const u32x4*)xr_; C_ = *(const u32x4*)(xr_ + 8); S_ = rowss[t_]; _Pragma("unroll") for (int q = 0; q < 4; ++q) G_[q] = *(const f32x4*)(gain + 16 * g_ + 4 * q); } while (0)
    if (gw < NIT) BUX_LOAD(gw, xa, xc, gg, ssq);
    for (int it = gw; it < NIT; it += NGW) { const int c = it / (S5_GROUPS / 4), gq = it % (S5_GROUPS / 4), g = 4 * gq + p;
        if (it + NGW < NIT) BUX_LOAD(it + NGW, na, nc, ng, nss);
        const float rs = rs_of(ssq); float v[16];
        const unsigned xw[8] = {xa.x, xa.y, xa.z, xa.w, xc.x, xc.y, xc.z, xc.w};
#pragma unroll
        for (int q = 0; q < 4; ++q) { v[4 * q] = bflo(xw[2 * q]) * rs * gg[q].x; v[4 * q + 1] = bfhi(xw[2 * q]) * rs * gg[q].y; v[4 * q + 2] = bflo(xw[2 * q + 1]) * rs * gg[q].z; v[4 * q + 3] = bfhi(xw[2 * q + 1]) * rs * gg[q].w; }
        bf16_t* dst = UX + ((size_t)g * NCH + c) * UXW + 16 * j;
        u32x4 w; w.x = pk2(v[0], v[1]); w.y = pk2(v[2], v[3]); w.z = pk2(v[4], v[5]); w.w = pk2(v[6], v[7]); *(u32x4*)dst = w;
        w.x = pk2(v[8], v[9]); w.y = pk2(v[10], v[11]); w.z = pk2(v[12], v[13]); w.w = pk2(v[14], v[15]); *(u32x4*)(dst + 8) = w;
        xa = na; xc = nc; ssq = nss;
#pragma unroll
        for (int q = 0; q < 4; ++q) gg[q] = ng[q]; }
#undef BUX_LOAD
}
__device__ __forceinline__ void s5_scan(Frame& F0, int j) {
    Frame F = F0; F.lane = LANE_ID(); F.tid = F0.wave * 64 + F.lane;
    bf16_t* UX = (bf16_t*)(F.ws + WS_R + R_UX); const bf16_t* S = (const bf16_t*)(F.ws + WS_R + R_S);
    constexpr int SPI = NTHREADS / NSEG, IPG = 64 / SPI;
    LAS float* E = (LAS float*)F.lds;
    const int pl = F.tid % SPI, seg = F.tid / SPI;
    for (int b = F.vcu; b < S5_GROUPS * IPG; b += F.G) { const int g = b / IPG, p = (b % IPG) * SPI + pl;
        __syncthreads();
        const f32x4 av = *(const f32x4*)((const float*)(F.ws + WS_S5PRE + ((size_t)j * S5_GROUPS + g) * S5PRE_STRIDE) + 4352 + p * 4); const float ar = av.x, ai = av.y, sr = av.z, si = av.w;
        const bf16_t* sp = S + ((size_t)g * NCH + (size_t)seg * SEGL) * 128 + 2 * p; float xr = 0.f, xi = 0.f;
        unsigned sv[SEGL];
#pragma unroll
        for (int c = 0; c < SEGL; ++c) sv[c] = *(const unsigned*)(sp + (size_t)c * 128);
#pragma unroll
        for (int c = 0; c < SEGL; ++c) { const float br = bflo(sv[c]), bi = bfhi(sv[c]); const float nr = ar * xr - ai * xi + br, ni = ar * xi + ai * xr + bi; xr = nr; xi = ni; }
        E[(seg * SPI + pl) * 2] = xr; E[(seg * SPI + pl) * 2 + 1] = xi;
        __syncthreads();
        xr = 0.f; xi = 0.f;
        for (int s = 0; s < seg; ++s) { const float er = E[(s * SPI + pl) * 2], ei = E[(s * SPI + pl) * 2 + 1]; const float nr = sr * xr - si * xi + er, ni = sr * xi + si * xr + ei; xr = nr; xi = ni; }
        bf16_t* up = UX + ((size_t)g * NCH + (size_t)seg * SEGL) * UXW + 256 + 2 * p;
#pragma unroll
        for (int c = 0; c < SEGL; ++c) { *(unsigned*)(up + (size_t)c * UXW) = pk2(xr, xi); const float br = bflo(sv[c]), bi = bfhi(sv[c]); const float nr = ar * xr - ai * xi + br, ni = ar * xi + ai * xr + bi; xr = nr; xi = ni; }
    }
    __syncthreads();
}

__device__ __forceinline__ void idx_kload(bf16x8 (&ka)[2][4], const bf16_t* KI, int k0, int lane) {
    const bf16_t* kp = KI + (size_t)(k0 + (lane & 31)) * 64 + 8 * (lane >> 5);
#pragma unroll
    for (int t = 0; t < 2; ++t)
#pragma unroll
        for (int ks = 0; ks < 4; ++ks) ka[t][ks] = *(const bf16x8*)(kp + (size_t)t * 32 * 64 + 16 * ks);
}
struct QAddr { int e[4], o[4], l[4]; };
constexpr int QLIN_OFF = 135168;
#ifdef EMU
#define QBASE(qt) 0
#define QPTR(qt, off) ((const LAS bf16x8*)((qt) + (off)))
#else
#define QBASE(qt) ((int)(unsigned)(size_t)(qt))
#define QPTR(qt, off) ((const LAS bf16x8*)(size_t)(unsigned)(off))
#endif
__device__ __forceinline__ QAddr idx_qaddr(int lane, const LAS unsigned char* qt) { QAddr A; const int ql = lane & 31, hi = lane >> 5, s3 = (ql >> 3) & 1, qb = QBASE(qt);
#pragma unroll
    for (int ks = 0; ks < 4; ++ks) { const int lo = qb + ql * 1024 + (((2 * ks + hi) ^ (ql & 7)) * 16); A.e[ks] = opaque(lo + (s3 ? 128 : 0)); A.o[ks] = opaque(lo - (s3 ? 128 : 0)); A.l[ks] = opaque(qb + QLIN_OFF - 65536 + ql * 128 + (((2 * ks + hi) ^ (ql & 7)) * 16)); }
    return A; }
__device__ __forceinline__ void idx_qload(bf16x8 (&qf)[4], const LAS unsigned char* qt, const QAddr& A, int h) {
#pragma unroll
    for (int ks = 0; ks < 4; ++ks) qf[ks] = (h == 8) ? *QPTR(qt, A.l[ks]) : *QPTR(qt, ((h & 1) ? A.o[ks] : A.e[ks]) + 128 * h);
}
__device__ __forceinline__ void idx_mma(f32x16& d0, f32x16& d1, const bf16x8 (&ka)[2][4], const bf16x8 (&qf)[4]) {
#pragma unroll
    for (int r = 0; r < 16; ++r) { d0[r] = 0.f; d1[r] = 0.f; }
#pragma unroll
    for (int ks = 0; ks < 4; ++ks) { d0 = MFMA32(ka[0][ks], qf[ks], d0); d1 = MFMA32(ka[1][ks], qf[ks], d1); }
}
#ifdef EMU
#define MFMA_SETTLE(x, y)
#define FMA_ABS(s, d, w) (s) = fmaf(fabsf(d), (w), (s))
#else
#define MFMA_SETTLE(x, y) asm volatile("s_nop 11" : "+v"(x), "+v"(y))
#define FMA_ABS(s, d, w) asm("v_fma_f32 %0, |%1|, %2, %0" : "+v"(s) : "v"(d), "v"(w))
#endif
__device__ __forceinline__ void idx_acc(f32x16& S, const f32x16& D, const float hw) {
#pragma unroll
    for (int i = 0; i < 16; ++i) { float t = S[i]; const float d = D[i]; FMA_ABS(t, d, hw); S[i] = t; }
}
template <bool MMA, bool ACC, bool LOAD>
__device__ __forceinline__ void idx_step(f32x16& n0, f32x16& n1, const bf16x8 (&ka)[2][4], const bf16x8 (&qf)[4], f32x16& s0, f32x16& s1, const f32x16& p0, const f32x16& p1, const float w,
                                         bf16x8 (&ql)[4], const LAS unsigned char* qt, const QAddr& A, const int hl) {
    const f32x16 z = {0.f, 0.f, 0.f, 0.f, 0.f, 0.f, 0.f, 0.f, 0.f, 0.f, 0.f, 0.f, 0.f, 0.f, 0.f, 0.f};
#pragma unroll
    for (int i = 0; i < 8; ++i) { const int ks = i & 3;
        if (MMA) { if (i < 4) n0 = MFMA32(ka[0][ks], qf[ks], ks == 0 ? z : n0); else n1 = MFMA32(ka[1][ks], qf[ks], ks == 0 ? z : n1); }
        if (ACC) {
#pragma unroll
            for (int e = 0; e < 4; ++e) { const int r = 4 * ks + e; if (i < 4) { float t = s0[r]; const float d = p0[r]; FMA_ABS(t, d, w); s0[r] = t; } else { float t = s1[r]; const float d = p1[r]; FMA_ABS(t, d, w); s1[r] = t; } } }
        if (LOAD && i < 4) ql[i] = (hl == 8) ? *QPTR(qt, A.l[i]) : *QPTR(qt, ((hl & 1) ? A.o[i] : A.e[i]) + 128 * hl);
        SCHED_BAR();
    }
}
template <int MODE = 0>
__device__ __forceinline__ void idx_scores2(f32x16& s0, f32x16& s1, const LAS unsigned char* qt, const QAddr& A, const float (&hw)[8], const bf16x8 (&ka)[2][4]) {
    constexpr bool M = MODE != 3, C = MODE != 2;
    bf16x8 qx[4], qy[4]; f32x16 a0, a1, b0, b1;
    if (MODE == 3) {
#pragma unroll
        for (int r = 0; r < 16; ++r) { a0[r] = 0.f; a1[r] = 0.f; b0[r] = 0.f; b1[r] = 0.f; s0[r] = 0.f; s1[r] = 0.f; }
        PIN16(a0); PIN16(a1); PIN16(b0); PIN16(b1); }
    idx_qload(qx, qt, A, 0); idx_qload(qy, qt, A, 8); SCHED_BAR();
    idx_step<M, false, false>(a0, a1, ka, qx, s0, s1, a0, a1, 0.f, qx, qt, A, 0);
    if (MODE == 2) { PIN16(a0); PIN16(a1); }
    idx_step<M, false, M>(s0, s1, ka, qy, s0, s1, a0, a1, 0.f, qx, qt, A, 1);
    idx_step<M, C, M>(b0, b1, ka, qx, s0, s1, a0, a1, hw[0], qy, qt, A, 2);
    if (MODE == 2) { PIN16(b0); PIN16(b1); }
    idx_step<M, C, M>(a0, a1, ka, qy, s0, s1, b0, b1, hw[1], qx, qt, A, 3);
    if (MODE == 2) { PIN16(a0); PIN16(a1); }
    idx_step<M, C, M>(b0, b1, ka, qx, s0, s1, a0, a1, hw[2], qy, qt, A, 4);
    if (MODE == 2) { PIN16(b0); PIN16(b1); }
    idx_step<M, C, M>(a0, a1, ka, qy, s0, s1, b0, b1, hw[3], qx, qt, A, 5);
    if (MODE == 2) { PIN16(a0); PIN16(a1); }
    idx_step<M, C, M>(b0, b1, ka, qx, s0, s1, a0, a1, hw[4], qy, qt, A, 6);
    if (MODE == 2) { PIN16(b0); PIN16(b1); }
    idx_step<M, C, M>(a0, a1, ka, qy, s0, s1, b0, b1, hw[5], qx, qt, A, 7);
    if (MODE == 2) { PIN16(a0); PIN16(a1); }
    idx_step<M, C, false>(b0, b1, ka, qx, s0, s1, a0, a1, hw[6], qy, qt, A, 0);
    if (MODE == 2) { PIN16(b0); PIN16(b1); }
    idx_step<false, C, false>(b0, b1, ka, qx, s0, s1, b0, b1, hw[7], qy, qt, A, 0);
}
__device__ __forceinline__ float score_u(float s, float inv32) { return __builtin_fmaf(s, inv32, (float)(NB / 2) + BIN_MAGIC); }
#ifdef EMU
#define HIST_ADD(hq, hadj, m) LDS_ATOMIC_ADD((hq) + (__float_as_uint(m) - 0x4B000000u), 1u)
#else
#if PROBE_DUP == 4
#define HIST_ADD(hq, hadj, m) do { LDS_ATOMIC_ADD((LAS unsigned*)(size_t)((__float_as_uint(m) << 2) + (hadj)), 1u); LDS_ATOMIC_ADD((LAS unsigned*)(size_t)((__float_as_uint(m) << 2) + (hadj)), (unsigned)opaque(0)); } while (0)
#else
#define HIST_ADD(hq, hadj, m) LDS_ATOMIC_ADD((LAS unsigned*)(size_t)((__float_as_uint(m) << 2) + (hadj)), 1u)
#endif
#endif

template <int PASS> __device__ __forceinline__ void idx_pass(Frame& F0, int un, LAS unsigned* hist, LAS int* qinfo) {
    Frame F = F0; F.lane = LANE_ID(); F.tid = F0.wave * 64 + F.lane;
    const bf16_t* KI = (const bf16_t*)(F.ws + WS_MIX + MIX_KI); const float* WI = (const float*)(F.ws + WS_MIX + MIX_WI);
    const int lane = F.lane, ql = lane & 31, hi = lane >> 5, q = 32 * un + ql, ntiles = un + 1, npairs = (ntiles + 1) >> 1;
    const LAS unsigned char* qt = F.lds + 65536;
    float hwp[8];
#pragma unroll
    for (int h = 0; h < 8; ++h) hwp[h] = 0.5f * WI[(size_t)q * 8 + h];
    const int bstar = PASS == 2 ? qinfo[ql * 4] : 0; const float inv32 = __builtin_bit_cast(float, qinfo[ql * 4 + 3]) * BIN_SCALE;
    const float thr_hi = bstar < 0 ? -__builtin_inff() : (bstar >= NB - 1 ? __builtin_inff() : BIN_MAGIC + (float)bstar);
    const float thr_lo = bstar <= 0 ? -__builtin_inff() : BIN_MAGIC + (float)bstar;
    const float cpos = (float)(NB / 2) + 0.5f - (float)bstar;
    LAS unsigned* cand = (LAS unsigned*)(F.lds + 98304) + (ql * 16 + F.wave * 2 + hi) * 16; int mycnt = 0;
    const float cmax = __builtin_bit_cast(float, opaque_s(__builtin_bit_cast(int, BIN_MAGIC + (float)(NB - 1))));
    LAS unsigned* hq = hist + ql * NB; const unsigned hadj = (unsigned)(size_t)hq - (0x4B000000u << 2); (void)hadj; (void)hq;
    const QAddr QA = idx_qaddr(lane, qt);
    bf16x8 ka[2][4];
    if (F.wave < npairs) idx_kload(ka, KI, 64 * F.wave, lane);
    for (int kp = F.wave; kp < npairs; kp += NWAVES) {
        const bool more = kp + NWAVES < npairs;
        f32x16 sc0, sc1; idx_scores2(sc0, sc1, qt, QA, hwp, ka);
        PIN16(sc0); PIN16(sc1);
#if PROBE_DUP >= 1 && PROBE_DUP <= 3
        { f32x16 t0, t1; idx_scores2<PROBE_DUP == 1 ? 0 : PROBE_DUP>(t0, t1, qt, QA, hwp, ka); PIN16(t0); PIN16(t1); }
#endif
        if (more) idx_kload(ka, KI, 64 * (kp + NWAVES), lane);
        const bool full = (2 * kp + 1 < ntiles - 1);
#pragma unroll
        for (int t = 0; t < 2; ++t) { const int kt = 2 * kp + t;
            if (PASS == 1) {
                if (full) {
#pragma unroll
                    for (int r = 0; r < 16; ++r) { const float m = MED3F(score_u(t ? sc1[r] : sc0[r], inv32), BIN_MAGIC, cmax); HIST_ADD(hq, hadj, m); }
                } else {
#pragma unroll
                    for (int r = 0; r < 16; ++r) { const int key = 32 * kt + crow(r, hi); const float m = MED3F(score_u(t ? sc1[r] : sc0[r], inv32), BIN_MAGIC, cmax);
                        if (key <= q) HIST_ADD(hq, hadj, m); }
                }
            } else if (kt < ntiles) {
                unsigned mlo = 0u, mhi = 0u;
#pragma unroll
                for (int r = 0; r < 16; ++r) { const int key = 32 * kt + crow(r, hi); const float sv = t ? sc1[r] : sc0[r]; float u = score_u(sv, inv32);
                    if (!full) u = key <= q ? u : __builtin_nanf("");
                    const u64 above = BALLOT64(u > thr_hi); WRITELANE64(mlo, mhi, above, r);
                    const u64 cm = BALLOT64(u >= thr_lo) & ~above;
                    if (cm != 0ull) { if (u >= thr_lo && !(u > thr_hi)) { if (mycnt < 16) { const float fr_ = MED3F(__builtin_fmaf(sv, inv32, cpos) * 262144.0f, 0.f, 262143.0f); cand[mycnt] = ((unsigned)fr_ << 14) | (unsigned)(16383 - key); } ++mycnt; } } }
                if (lane < 16) { u32x2 w; w.x = mlo; w.y = mhi; ((LAS u32x2*)hist)[kt * 16 + lane] = w; }
            }
        }
    }
    if (PASS == 2) ((LAS int*)(F.lds + RING_BYTES + 2048))[ql * 16 + F.wave * 2 + hi] = mycnt < 16 ? mycnt : 16;
}
__device__ __forceinline__ void indexer_unit(Frame& F0, int un) {
    Frame F = F0; F.lane = LANE_ID(); F.tid = F0.wave * 64 + F.lane;
    const bf16_t* QI = (const bf16_t*)(F.ws + WS_MIX + MIX_QI); const bf16_t* KI = (const bf16_t*)(F.ws + WS_MIX + MIX_KI); const float* WI = (const float*)(F.ws + WS_MIX + MIX_WI);
    unsigned* M32 = (unsigned*)(F.ws + WS_MASK);
    LAS unsigned* hist = (LAS unsigned*)F.lds; LAS int* qinfo = (LAS int*)(F.lds + RING_BYTES); LAS int* ccnt = (LAS int*)(F.lds + RING_BYTES + 2048);
    LAS float* nrm = (LAS float*)(F.lds + 98304);
    const int lane = F.lane, q0 = 32 * un;
    __syncthreads();
    { const unsigned zz = (unsigned)opaque(0); const u32x4 z4 = (u32x4){zz, zz, zz, zz};
      for (int e = F.tid; e < 32 * NB / 4; e += NTHREADS) ((LAS u32x4*)hist)[e] = z4; }
    if (F.tid < 128) qinfo[F.tid] = 0;
    { static_assert(32 * 64 == 4 * NTHREADS, "four Q~ chunks per thread");
      u32x4 qv[4];
#pragma unroll
      for (int k = 0; k < 4; ++k) { const int e = F.tid + k * NTHREADS, row = e >> 6, c = e & 63; qv[k] = *(const u32x4*)(QI + (size_t)(q0 + row) * 512 + 8 * c); }
#pragma unroll
      for (int k = 0; k < 4; ++k) { const int e = F.tid + k * NTHREADS, row = e >> 6, c = e & 63; *(LAS u32x4*)(F.lds + 65536 + row * 1024 + ((c ^ (row & 15)) * 16)) = qv[k]; } }
    if (F.tid < 256) { const int row = F.tid & 31, h = F.tid >> 5; const bf16_t* qr = QI + (size_t)(q0 + row) * 512 + h * 64; float ss = 0.f;
        for (int e = 0; e < 64; e += 8) { const u32x4 a = *(const u32x4*)(qr + e); ss += bflo(a.x) * bflo(a.x) + bfhi(a.x) * bfhi(a.x) + bflo(a.y) * bflo(a.y) + bfhi(a.y) * bfhi(a.y) + bflo(a.z) * bflo(a.z) + bfhi(a.z) * bfhi(a.z) + bflo(a.w) * bflo(a.w) + bfhi(a.w) * bfhi(a.w); }
        const float w = WI[(size_t)(q0 + row) * 8 + h]; nrm[row * 8 + h] = w * w * ss; }
    { const int row = F.tid & 31, d4 = (F.tid >> 5) * 4; float a0 = 0.f, a1 = 0.f, a2 = 0.f, a3 = 0.f;
#pragma unroll
      for (int h = 0; h < 8; ++h) { const float w = 0.5f * WI[(size_t)(q0 + row) * 8 + h]; const u32x2 v = *(const u32x2*)(QI + (size_t)(q0 + row) * 512 + h * 64 + d4);
          a0 += w * bflo(v.x); a1 += w * bfhi(v.x); a2 += w * bflo(v.y); a3 += w * bfhi(v.y); }
      u32x2 o; o.x = pk2(a0, a1); o.y = pk2(a2, a3); *(LAS u32x2*)(F.lds + QLIN_OFF + row * 128 + (((d4 >> 3) ^ (row & 7)) * 16) + (d4 & 7) * 2) = o; }
    __syncthreads();
    if (F.tid < 32) { float a = 0.f;
#pragma unroll
        for (int h = 0; h < 8; ++h) a += nrm[F.tid * 8 + h];
        const float inv = a > 1e-30f ? RSQF(0.5f * a) : 1.0f; qinfo[F.tid * 4 + 3] = __builtin_bit_cast(int, inv); }
    __syncthreads();
    idx_pass<1>(F, un, hist, qinfo);
    __syncthreads();
    for (int i = 0; i < 4; ++i) { const int qq = 4 * F.wave + i; const int n = q0 + qq + 1;
        unsigned cnt[8]; unsigned tot = 0;
#pragma unroll
        for (int e = 0; e < 2; ++e) { const u32x4 w = ((const LAS u32x4*)(hist + qq * NB + lane * 8))[e]; cnt[4 * e] = w.x; cnt[4 * e + 1] = w.y; cnt[4 * e + 2] = w.z; cnt[4 * e + 3] = w.w; tot += w.x + w.y + w.z + w.w; }
        unsigned v = tot;
#pragma unroll
        for (int o = 1; o < 64; o <<= 1) { const unsigned t = SHFL_IDX_U(v, (lane + o) & 63); if (lane + o < 64) v += t; }
        const unsigned above = v - tot;
        if (n > TOPK) { const bool mine = (above < (unsigned)TOPK) && (above + tot >= (unsigned)TOPK);
            if (mine) { unsigned a = above, abest = above; int bb = 7; bool found = false;
#pragma unroll
                for (int t = 7; t >= 0; --t) { const bool hit = !found && (a + cnt[t] >= (unsigned)TOPK); if (hit) { bb = t; abest = a; found = true; } a += cnt[t]; }
                qinfo[qq * 4] = lane * 8 + bb; qinfo[qq * 4 + 1] = TOPK - (int)abest; }
        } else if (lane == 0) { qinfo[qq * 4] = opaque(-1); qinfo[qq * 4 + 1] = opaque(0); }
    }
    __syncthreads();
    idx_pass<2>(F, un, hist, qinfo);
    __syncthreads();
    LAS unsigned* cand = (LAS unsigned*)(F.lds + 98304);
    for (int i = 0; i < 4; ++i) { const int qq = 4 * F.wave + i; const int rneed = qinfo[qq * 4 + 1];
        if (rneed <= 0) continue;
#pragma unroll
        for (int k = 0; k < 4; ++k) { const int sl = lane + 64 * k;
            if ((sl & 15) < ccnt[qq * 16 + (sl >> 4)]) { const unsigned me = cand[qq * 256 + sl]; int rank = 0;
                for (int sb = 0; sb < 16; ++sb) { const int c2 = ccnt[qq * 16 + sb];
                    for (int p2 = 0; p2 < c2; ++p2) rank += (cand[qq * 256 + sb * 16 + p2] > me) ? 1 : 0; }
                if (rank < rneed) { const unsigned key = 16383u - (me & 16383u); const int kk = key & 31, h2 = (kk >> 2) & 1, r = (kk & 3) + 4 * (kk >> 3); LDS_ATOMIC_OR(hist + (key >> 5) * 32 + r * 2 + h2, 1u << qq); } } }
    }
    __syncthreads();
    const int ktz = 8 * (un >> 3) + 8;
    for (int e = F.tid; e < ktz * 8; e += NTHREADS) { const int kt = e >> 3; const unsigned zz = 0u;
        *(u32x4*)(M32 + ((size_t)kt * (SEQ / 32) + un) * 32 + 4 * (e & 7)) = kt <= un ? ((const LAS u32x4*)hist)[e] : (u32x4){zz, zz, zz, zz}; }
}
__device__ __forceinline__ void indexer_phase(Frame& F) {
    constexpr int NU = SEQ / 32;
    for (int p = F.vcu; p < NU / 2; p += F.G) { indexer_unit(F, p); indexer_unit(F, NU - 1 - p); }
    __syncthreads();
}

#ifdef EMU
#define A2_DMA(gsrc, ldsoff) emu_glds16((const void*)(gsrc), (void*)(F.lds + (ldsoff)))
#define A2_WAIT_BAR(N) emu::block_barrier()
#define A2_SBAR()
#define A2_PIN(x)
#define A2_CVTPK(lo, hi) pk2(lo, hi)
struct a2_m8 { u64 v[8]; u64 operator[](int i) const { return v[i]; } };
static inline a2_m8 a2_sload8(const u64* p) { a2_m8 r; for (int i = 0; i < 8; ++i) r.v[i] = p[i]; return r; }
#define A2_SWAIT4(a, b, c, d)
#else
typedef unsigned long long a2_m8 __attribute__((ext_vector_type(8)));
__device__ __forceinline__ a2_m8 a2_sload8(const u64* p) { a2_m8 r; asm volatile("s_load_dwordx16 %0, %1, 0x0 glc" : "=s"(r) : "s"(p)); return r; }
#define A2_SWAIT4(a, b, c, d) asm volatile("s_waitcnt lgkmcnt(0)" : "+s"(a), "+s"(b), "+s"(c), "+s"(d))
__device__ __forceinline__ void a2_glds16(const void* gsrc, unsigned lds_dst) { unsigned keep;
    asm volatile("s_mov_b32 %0, m0\n\ts_mov_b32 m0, %2\n\ts_nop 0\n\tglobal_load_lds_dwordx4 %1, off\n\ts_mov_b32 m0, %0" : "=&s"(keep) : "v"(gsrc), "s"(lds_dst) : "memory"); }
typedef __bf16 a2_bf16x2 __attribute__((ext_vector_type(2)));
__device__ __forceinline__ unsigned a2_cvtpk(float lo, float hi) { f32x2 v = {lo, hi}; a2_bf16x2 b = __builtin_convertvector(v, a2_bf16x2); return __builtin_bit_cast(unsigned, b); }
#define A2_DMA(gsrc, ldsoff) a2_glds16((const void*)(gsrc), (unsigned)__builtin_amdgcn_readfirstlane((int)(lds0 + (unsigned)(ldsoff))))
#define A2_WAIT_BAR(N) asm volatile("s_waitcnt vmcnt(" #N ") lgkmcnt(0)\n\ts_barrier" ::: "memory")
#define A2_SBAR() __builtin_amdgcn_sched_barrier(0)
#define A2_PIN(x) asm volatile("" : "+v"(x))
#define A2_CVTPK(lo, hi) a2_cvtpk(lo, hi)
#endif
constexpr int A2_NSLOT = 3, A2_SLOTB = 8192, A2_K = 0, A2_V = A2_NSLOT * A2_SLOTB, A2_WS = 2 * A2_NSLOT * A2_SLOTB, A2_OST = A2_WS + 8 * 64 * 4, A2_BYTES = A2_OST + 8 * 4096;
static_assert(A2_BYTES <= RING_BYTES, "attention scratch fits the ring");
__device__ __forceinline__ void attn_unit2(Frame& F0, int h, int qb) {
    Frame F = F0; F.lane = LANE_ID(); F.tid = F0.wave * 64 + F.lane;
    bf16_t* Qg = (bf16_t*)(F.ws + WS_R + R_Q); const bf16_t* Kg = (const bf16_t*)(F.ws + WS_R + R_K); const bf16_t* Vg = (const bf16_t*)(F.ws + WS_R + R_V);
    const int lane = F.lane, r32 = lane & 31, hi = lane >> 5, wid = F.wave, q0 = qb * 256;
    const bf16_t* Qw = Qg + (size_t)(q0 + wid * 32) * D_MODEL + h * 64; const bf16_t* Kh = Kg + h * 64; const bf16_t* Vh = Vg + h * 64;
#ifndef EMU
    const unsigned lds0 = (unsigned)(uintptr_t)F.lds;
#endif
    LAS float* wsf = (LAS float*)(F.lds + A2_WS) + wid * 64;
    const bf16_t* ksrc = Kh + (size_t)lane * D_MODEL + wid * 8;
    const bf16_t* vsrc = Vh + (size_t)(16 * (wid & 3) + (lane >> 2)) * D_MODEL + (wid >> 2) * 32 + (lane & 3) * 8;
    const int kdst = A2_K + wid * 1024, vdst = A2_V + wid * 1024;
#define DMA_K(t, slot) A2_DMA(ksrc + (size_t)(t) * 64 * D_MODEL, kdst + (slot))
#define DMA_V(t, slot) A2_DMA(vsrc + (size_t)(t) * 64 * D_MODEL, vdst + (slot))
    const LAS unsigned char* kp0 = F.lds + A2_K + hi * 1024 + r32 * 16;
    const LAS unsigned char* vp0 = F.lds + A2_V + ((lane >> 4) & 1) * 32 + (lane & 3) * 8 + (4 * hi + ((lane & 15) >> 2)) * 64;
    const int NT = (q0 + 256) / 64;
    const u64* MW = (const u64*)(F.ws + WS_MASK) + (size_t)(8 * qb + wid) * 16; constexpr size_t MS = (size_t)(SEQ / 32) * 16;
    DMA_K(0, 0); DMA_V(0, 0); DMA_K(1, A2_SLOTB);
    bf16x8 qr[4];
#pragma unroll
    for (int d0 = 0; d0 < 4; ++d0) qr[d0] = *(const bf16x8*)(Qw + (size_t)r32 * D_MODEL + d0 * 16 + hi * 8);
    float l_reg = 0.f; f32x16 o[2]; f32x16 zero16;
#pragma unroll
    for (int r = 0; r < 16; ++r) { o[0][r] = 0.f; o[1][r] = 0.f; zero16[r] = 0.f; }
    f32x16 pA0, pA1, pB0, pB1; bf16x8 kf[8];
    int sl_prev = 0, sl_cur = 0, sl_next = A2_SLOTB;
#define ROT() do { sl_prev = sl_cur; sl_cur = sl_next; sl_next = (sl_next == (A2_NSLOT - 1) * A2_SLOTB) ? 0 : sl_next + A2_SLOTB; } while (0)
#define KLOAD2(kp, j) do { kf[2 * (j)] = *(const LAS bf16x8*)((kp) + (j) * 2048); kf[2 * (j) + 1] = *(const LAS bf16x8*)((kp) + (j) * 2048 + 512); } while (0)
    DMA_K(2, 2 * A2_SLOTB);
    A2_WAIT_BAR(3);
    { const LAS unsigned char* kb = kp0;
      KLOAD2(kb, 0); KLOAD2(kb, 1); KLOAD2(kb, 2); KLOAD2(kb, 3);
      pA0 = MFMA32(kf[0], qr[0], zero16); pA1 = MFMA32(kf[1], qr[0], zero16);
#pragma unroll
      for (int d0 = 1; d0 < 4; ++d0) { pA0 = MFMA32(kf[2 * d0], qr[d0], pA0); pA1 = MFMA32(kf[2 * d0 + 1], qr[d0], pA1); }
      a2_m8 m0 = a2_sload8(MW), m1 = a2_sload8(MW + 8), m2 = a2_sload8(MW + MS), m3 = a2_sload8(MW + MS + 8); A2_SWAIT4(m0, m1, m2, m3);
#pragma unroll
      for (int r = 0; r < 8; ++r) { pA0[r] = INVB(m0[r]) ? EXP2F(pA0[r]) : 0.f; pA0[8 + r] = INVB(m1[r]) ? EXP2F(pA0[8 + r]) : 0.f; pA1[r] = INVB(m2[r]) ? EXP2F(pA1[r]) : 0.f; pA1[8 + r] = INVB(m3[r]) ? EXP2F(pA1[8 + r]) : 0.f; } }
    A2_WAIT_BAR(0);
    DMA_K(3, 0); DMA_V(1, A2_SLOTB);
    ROT();
    { const LAS unsigned char* kb = kp0 + sl_cur; KLOAD2(kb, 0); KLOAD2(kb, 1); KLOAD2(kb, 2); KLOAD2(kb, 3); }
    A2_WAIT_BAR(2);
    s16x4 vlo[8], vhi[8]; u32x4 pw0, pw1, pw2, pw3;
#define PKW(P, B) A2_CVTPK(P[B], P[(B) + 1])
#define PAF(k) __builtin_bit_cast(bf16x8, pw##k)
#define VFR(i) (bf16x8){vlo[i][0], vlo[i][1], vlo[i][2], vlo[i][3], vhi[i][0], vhi[i][1], vhi[i][2], vhi[i][3]}
#define GAPA(MF, A0, A1, A2, A3, W0, W1, PW) do { MF; sacc += A0; sacc += A1; sacc += A2; sacc += A3; A2_PIN(sacc); W0; W1; A2_PIN(PW); A2_SBAR(); } while (0)
#define GAPB(MF, X, B, J, MK) do { MF; X[B] = INVB(MK[J]) ? EXP2F(X[B]) : 0.f; X[(B) + 1] = INVB(MK[(J) + 1]) ? EXP2F(X[(B) + 1]) : 0.f; X[(B) + 2] = INVB(MK[(J) + 2]) ? EXP2F(X[(B) + 2]) : 0.f; X[(B) + 3] = INVB(MK[(J) + 3]) ? EXP2F(X[(B) + 3]) : 0.f; A2_PIN(X); A2_SBAR(); } while (0)
#define VRD(i) do { vlo[i] = DS_TR16(vp_ + (((i) >> 2) * 4096 + ((i) & 3) * 1024)); vhi[i] = DS_TR16(vp_ + (((i) >> 2) * 4096 + ((i) & 3) * 1024 + 512)); } while (0)
#define KRD(G, j) do { if (G) { KLOAD2(kp0 + sl_next, j); A2_SBAR(); } } while (0)
#define STEP(C0, C1, P0, P1, t, GK, GV, GL) do { A2_SBAR(); \
    const LAS unsigned char* vp_ = vp0 + sl_prev; const u64* mka_ = MW + (size_t)(2 * (t)) * MS; const u64* mkb_ = mka_ + MS; \
    a2_m8 ma0_ = a2_sload8(mka_), ma1_ = a2_sload8(mka_ + 8), mb0_ = a2_sload8(mkb_), mb1_ = a2_sload8(mkb_ + 8); \
    VRD(0); A2_SBAR(); float sacc = (P0[0] + P0[1]); \
    GAPA(C0 = MFMA32(kf[0], qr[0], zero16), P0[2], P0[3], P0[4], P0[5],     pw0[0] = PKW(P0, 0), pw0[1] = PKW(P0, 2), pw0); \
    VRD(4); A2_SBAR(); GAPA(C1 = MFMA32(kf[1], qr[0], zero16), P0[6], P0[7], P0[8], P0[9],     pw0[2] = PKW(P0, 4), pw0[3] = PKW(P0, 6), pw0); \
    VRD(1); A2_SBAR(); GAPA(C0 = MFMA32(kf[2], qr[1], C0),   P0[10], P0[11], P0[12], P0[13], pw1[0] = PKW(P0, 8), pw1[1] = PKW(P0, 10), pw1); \
    VRD(5); A2_SBAR(); GAPA(C1 = MFMA32(kf[3], qr[1], C1),   P0[14], P0[15], P1[0], P1[1],   pw1[2] = PKW(P0, 12), pw1[3] = PKW(P0, 14), pw1); \
    VRD(2); A2_SBAR(); GAPA(C0 = MFMA32(kf[4], qr[2], C0),   P1[2], P1[3], P1[4], P1[5],     pw2[0] = PKW(P1, 0), pw2[1] = PKW(P1, 2), pw2); \
    VRD(6); A2_SBAR(); GAPA(C1 = MFMA32(kf[5], qr[2], C1),   P1[6], P1[7], P1[8], P1[9],     pw2[2] = PKW(P1, 4), pw2[3] = PKW(P1, 6), pw2); \
    VRD(3); A2_SBAR(); GAPA(C0 = MFMA32(kf[6], qr[3], C0),   P1[10], P1[11], P1[12], P1[13], pw3[0] = PKW(P1, 8), pw3[1] = PKW(P1, 10), pw3); \
    VRD(7); A2_SBAR(); GAPA(C1 = MFMA32(kf[7], qr[3], C1),   P1[14], P1[15], 0.f, 0.f,       pw3[2] = PKW(P1, 12), pw3[3] = PKW(P1, 14), pw3); \
    l_reg += sacc; \
    if (GK) { DMA_K((t) + 3, sl_cur); } if (GV) { DMA_V((t) + 1, sl_next); } \
    A2_SWAIT4(ma0_, ma1_, mb0_, mb1_); A2_SBAR(); \
    GAPB(o[0] = MFMA32(PAF(0), VFR(0), o[0]), C0, 0, 0, ma0_); \
    GAPB(o[1] = MFMA32(PAF(0), VFR(4), o[1]), C0, 4, 4, ma0_); \
    KRD(GL, 0); GAPB(o[0] = MFMA32(PAF(1), VFR(1), o[0]), C0, 8, 0, ma1_); \
    KRD(GL, 1); GAPB(o[1] = MFMA32(PAF(1), VFR(5), o[1]), C0, 12, 4, ma1_); \
    KRD(GL, 2); GAPB(o[0] = MFMA32(PAF(2), VFR(2), o[0]), C1, 0, 0, mb0_); \
    KRD(GL, 3); GAPB(o[1] = MFMA32(PAF(2), VFR(6), o[1]), C1, 4, 4, mb0_); \
    GAPB(o[0] = MFMA32(PAF(3), VFR(3), o[0]), C1, 8, 0, mb1_); \
    GAPB(o[1] = MFMA32(PAF(3), VFR(7), o[1]), C1, 12, 4, mb1_); \
    } while (0)
    int t = 1;
    for (; t + 5 < NT; t += 2) {
        STEP(pB0, pB1, pA0, pA1, t, true, true, true);     A2_WAIT_BAR(2); ROT();
        STEP(pA0, pA1, pB0, pB1, t + 1, true, true, true); A2_WAIT_BAR(2); ROT();
    }
#define ENDW(tt) do { if ((tt) + 3 < NT) { A2_WAIT_BAR(2); } else if ((tt) + 2 < NT) { A2_WAIT_BAR(1); } else { A2_WAIT_BAR(0); } } while (0)
    for (; t + 1 < NT; t += 2) {
        STEP(pB0, pB1, pA0, pA1, t, (t + 3 < NT), (t + 1 < NT), (t + 1 < NT));         ENDW(t);     ROT();
        STEP(pA0, pA1, pB0, pB1, t + 1, (t + 4 < NT), (t + 2 < NT), (t + 2 < NT));     ENDW(t + 1); ROT();
    }
    STEP(pB0, pB1, pA0, pA1, NT - 1, false, false, false);
    { float sacc = pB0[0] + pB0[1];
#pragma unroll
      for (int r = 2; r < 16; ++r) sacc += pB0[r];
#pragma unroll
      for (int r = 0; r < 16; ++r) sacc += pB1[r];
      l_reg += sacc;
      pw0 = (u32x4){PKW(pB0, 0), PKW(pB0, 2), PKW(pB0, 4), PKW(pB0, 6)}; pw1 = (u32x4){PKW(pB0, 8), PKW(pB0, 10), PKW(pB0, 12), PKW(pB0, 14)};
      pw2 = (u32x4){PKW(pB1, 0), PKW(pB1, 2), PKW(pB1, 4), PKW(pB1, 6)}; pw3 = (u32x4){PKW(pB1, 8), PKW(pB1, 10), PKW(pB1, 12), PKW(pB1, 14)};
      A2_SBAR();
      const LAS unsigned char* vp_ = vp0 + sl_cur;
#pragma unroll
      for (int d0 = 0; d0 < 2; ++d0) {
#pragma unroll
          for (int ks = 0; ks < 4; ++ks) { VRD(d0 * 4 + ks); }
          o[d0] = MFMA32(PAF(0), VFR(d0 * 4 + 0), o[d0]); o[d0] = MFMA32(PAF(1), VFR(d0 * 4 + 1), o[d0]); o[d0] = MFMA32(PAF(2), VFR(d0 * 4 + 2), o[d0]); o[d0] = MFMA32(PAF(3), VFR(d0 * 4 + 3), o[d0]); } }
    l_reg = sum_x32(l_reg);
    if (hi == 0) wsf[32 + r32] = l_reg;
    WAIT_L(0);
    float rli[16];
#pragma unroll
    for (int r = 0; r < 16; ++r) rli[r] = RCPF(wsf[32 + crow(r, hi)]);
    bf16_t* Ow = Qg + (size_t)(q0 + wid * 32) * D_MODEL + h * 64;
    { LAS bf16_t* stg = (LAS bf16_t*)(F.lds + A2_OST) + wid * 2048;
#pragma unroll
      for (int r = 0; r < 16; ++r) { const int orow = crow(r, hi);
#pragma unroll
          for (int d0 = 0; d0 < 2; ++d0) stg[orow * 64 + d0 * 32 + r32] = (bf16_t)f2bf(o[d0][r] * rli[r]); }
      WAIT_L(0);
#pragma unroll
      for (int i = 0; i < 4; ++i) { const int row = i * 8 + (lane >> 3), ch = lane & 7; const u32x4 v = *(const LAS u32x4*)(stg + row * 64 + ch * 8); *(u32x4*)(Ow + (size_t)row * D_MODEL + ch * 8) = v; } }
    A2_WAIT_BAR(0);
#undef DMA_K
#undef DMA_V
#undef ROT
#undef KLOAD2
#undef PKW
#undef PAF
#undef VFR
#undef GAPA
#undef GAPB
#undef VRD
#undef KRD
#undef STEP
#undef ENDW
}
__device__ __forceinline__ void attn_phase(Frame& F) {
    constexpr int NQB = SEQ / 256, NP = N_HEADS * (NQB / 2);
    const bool remap = (F.G == 256 && N_HEADS == 16 && NQB == 64);
    for (int p = F.vcu, i = 0; p < NP; p += F.G, ++i) {
        const int head = remap ? (F.vcu >> 5) + 8 * ((F.vcu & 31) >> 4) : p / (NQB / 2), s = remap ? (F.vcu & 15) + 16 * i : p % (NQB / 2);
        attn_unit2(F, head, s); attn_unit2(F, head, NQB - 1 - s); }
    __syncthreads();
}

#ifdef EMU
#define CG_SYNC() emu::grid_barrier()
#define LDS_DECL(name) unsigned char* name = emu::lds_ptr()
#else
namespace cg = cooperative_groups;
#define CG_SYNC() cg::this_grid().sync()
#define LDS_DECL(name) extern __shared__ __attribute__((aligned(16))) unsigned char name[]
#endif

#ifdef EMU
static int g_emu_max_layers = DEPTH;
#define MAX_LAYERS g_emu_max_layers
static int g_emu_stop = 0;
#define EMU_STOP(k) do { if (g_emu_stop == (k)) return; } while (0)
#else
#define MAX_LAYERS DEPTH
#define EMU_SNAPSHOT() do {} while (0)
#define EMU_STOP(k) do {} while (0)
#endif
__global__ void __launch_bounds__(NTHREADS, 2) mega_fwd(Args args) {
    LDS_DECL(lds_raw);
    Frame F;
    F.lds = (LAS unsigned char*)lds_raw; F.tid = threadIdx.x; F.lane = F.tid & 63; F.wave = RFL(F.tid >> 6);
    F.G = gridDim.x; { const int bx = blockIdx.x; F.vcu = (F.G % 8 == 0) ? (bx % 8) * (F.G / 8) + bx / 8 : bx; }
#pragma unroll
    for (int i = 0; i < 18; ++i) F.in[i] = args.in[i];
    F.out = args.out; F.ws = args.ws;
    volatile LAS unsigned* MISC = (volatile LAS unsigned*)(F.lds + LDSCTL_OFF + 1024);
    if (F.tid < 64) MISC[F.tid] = 0u;
    __syncthreads();
    XcdBarrier bar = xcd_barrier_post((unsigned*)(F.ws + WS_CTL) + 4096, MISC + 8);
#define GRID_BAR() xcd_barrier(bar)
    u64* rowss = (u64*)(F.ws + WS_ROWSS); bf16_t* XB = (bf16_t*)(F.ws + WS_XB);
    LAS unsigned char* ring = F.lds;

#ifndef KN
#define KN 0xffff
#endif
#ifndef TSEL
#define TSEL 0
#endif
#if TSEL && !defined(EMU)
    unsigned long long tacc = 0ull, tt0 = 0ull;
#define T_BEGIN(bit) do { if (TSEL & (bit)) tt0 = wall_clock64(); } while (0)
#define T_END(bit) do { if (TSEL & (bit)) tacc += wall_clock64() - tt0; } while (0)
#else
#define T_BEGIN(bit)
#define T_END(bit)
#endif
    T_BEGIN(1);
    if (KN & 1) { s5_pre(F);
    WAIT_VM0(); __syncthreads();
    s5_setup(F);
    __syncthreads();
    convert_weights(F);
    prologue_rows(F); }
    EMU_STOP(1);
    GRID_BAR(); T_END(1);
    if (opaque_s(0) != 0) CG_SYNC();

    const Frame F_ = F;
    for (int layer = 0; layer < MAX_LAYERS; ++layer) {
        const int j = layer >> 1;
        Frame F = F_; F.ws = opaque_p(F_.ws); u64* rowss = (u64*)(F.ws + WS_ROWSS); bf16_t* XB = (bf16_t*)(F.ws + WS_XB);
        u64* rs_mix = rowss + (size_t)(2 * layer) * SEQ; u64* rs_ffn = rowss + (size_t)(2 * layer + 1) * SEQ; u64* rs_next = rowss + (size_t)(2 * layer + 2) * SEQ;
        if ((layer & 1) == 0) {
            T_BEGIN(2); if (KN & 2) s5_build_ux(F, XB, rs_mix, F.in[16] + (size_t)layer * D_MODEL);
            GRID_BAR(); T_END(2); EMU_STOP(2);
            T_BEGIN(4); if (KN & 4) { pg8::Gemm g{(const bf16_t*)(F.ws + WS_R + R_UX), (const bf16_t*)(F.ws + WS_S5TAB + (size_t)j * SZ_S5TAB + MIX_W1), UXW, 256, 256}; pg8::GroupOrder S{F.G, F.vcu};
              EpiS5State E{(bf16_t*)(F.ws + WS_R + R_S)}; pg8::gemm_phase(ring, F.wave, g, S, E); }
            GRID_BAR(); T_END(4); EMU_STOP(3);
            T_BEGIN(8); if (KN & 8) s5_scan(F, j);
            GRID_BAR(); T_END(8); EMU_STOP(4);
            T_BEGIN(16); if (KN & 16) { pg8::Gemm g{(const bf16_t*)(F.ws + WS_R + R_UX), (const bf16_t*)(F.ws + WS_S5TAB + (size_t)j * SZ_S5TAB + MIX_AM), UXW, UXW, UXW}; pg8::GroupOrder S{F.G, F.vcu};
              EpiS5Out E{(bf16_t*)(F.ws + WS_R + R_Y), (const bf16_t*)(F.ws + WS_R + R_UX), F.in[8] + (size_t)j * D_MODEL}; pg8::gemm_phase(ring, F.wave, g, S, E); }
            GRID_BAR(); T_END(16); EMU_STOP(5);
            T_BEGIN(32); if (KN & 32) { pg8::Gemm g{(const bf16_t*)(F.ws + WS_R + R_Y), (const bf16_t*)(F.ws + WS_WGLU + j * SZ_WGLU), D_MODEL, D_MODEL, D_MODEL}; pg8::StaticOrder S; S.init(SEQ, 2 * D_MODEL, F.G, (int)blockIdx.x);
              EpiRes<true> E{XB, nullptr, rs_ffn}; pg8::gemm_phase(ring, F.wave, g, S, E); }
            GRID_BAR(); T_END(32);
        } else {
            T_BEGIN(64); if (KN & 64) { pg8::Gemm g{XB, (const bf16_t*)(F.ws + WS_WIN + j * SZ_WIN), D_MODEL, D_MODEL, D_MODEL}; pg8::StaticOrder S; S.init(SEQ, NIN_PAD, F.G, (int)blockIdx.x);
              EpiInProj E{(bf16_t*)(F.ws + WS_R + R_Q), (bf16_t*)(F.ws + WS_R + R_K), (bf16_t*)(F.ws + WS_R + R_V), (bf16_t*)(F.ws + WS_MIX + MIX_QI), (bf16_t*)(F.ws + WS_MIX + MIX_KI), (float*)(F.ws + WS_MIX + MIX_WI),
                          rs_mix, (const float*)(F.ws + WS_ROPE), F.in[11] + (size_t)j * 64, F.in[12] + (size_t)j * 64};
              pg8::gemm_phase(ring, F.wave, g, S, E); }
            GRID_BAR(); T_END(64); EMU_STOP(7);
            T_BEGIN(128); if (KN & 128) indexer_phase(F);
            GRID_BAR(); T_END(128); EMU_STOP(8);
            T_BEGIN(256); if (KN & 256) attn_phase(F);
            GRID_BAR(); T_END(256); EMU_STOP(9);
            T_BEGIN(512); if (KN & 512) { pg8::Gemm g{(const bf16_t*)(F.ws + WS_R + R_Q), (const bf16_t*)(F.ws + WS_WO + j * SZ_WO), D_MODEL, D_MODEL, D_MODEL}; pg8::StaticOrder S; S.init(SEQ, D_MODEL, F.G, (int)blockIdx.x);
              EpiRes<false> E{XB, nullptr, rs_ffn}; pg8::gemm_phase(ring, F.wave, g, S, E); }
            GRID_BAR(); T_END(512);
        }
        EMU_SNAPSHOT();
        T_BEGIN(1024); if (KN & 1024) { pg8::Gemm g{XB, (const bf16_t*)(F.ws + WS_WGU + layer * SZ_WGU), D_MODEL, D_MODEL, D_MODEL}; pg8::StaticOrder S; S.init(SEQ, 2 * D_FF, F.G, (int)blockIdx.x);
          EpiSwiGLU E{(bf16_t*)(F.ws + WS_R + R_ACT), rs_ffn}; pg8::gemm_phase(ring, F.wave, g, S, E); }
        if ((KN & 1) && opaque_s(layer) + 1 < MAX_LAYERS) convert_next_layer(F, layer + 1);
        GRID_BAR(); T_END(1024);
        T_BEGIN(2048); if (KN & 2048) { pg8::Gemm g{(const bf16_t*)(F.ws + WS_R + R_ACT), (const bf16_t*)(F.ws + WS_WDN + layer * SZ_WDN), D_FF, D_FF, D_FF}; pg8::StaticOrder S; S.init(SEQ, D_MODEL, F.G, (int)blockIdx.x);
          EpiRes<false> E{XB, opaque_s(layer) + 1 < MAX_LAYERS ? nullptr : F.out, rs_next}; pg8::gemm_phase(ring, F.wave, g, S, E); }
        if (opaque_s(layer) + 1 < DEPTH) GRID_BAR();
#ifdef EMU
        else GRID_BAR();
        EMU_SNAPSHOT();
#endif
        T_END(2048);
    }
#if TSEL && !defined(EMU)
    GRID_BAR(); if (blockIdx.x == 0 && threadIdx.x == 0) F_.out[0] += (float)tacc * 1e-4f;
#endif
}

#ifndef EMU
extern "C" void kernel_launch(void* const* d_in, const int* in_sizes, int n_in, void* d_out, int out_size, void* d_ws, size_t ws_size, hipStream_t stream) {
    static int grid = 0;
    if (grid == 0) {
        if (n_in != 18 || out_size != SEQ * D_MODEL || ws_size < WS_END) { fprintf(stderr, "kernel_launch: unexpected shapes (n_in %d out %d ws %zu need %zu)\n", n_in, out_size, ws_size, (size_t)WS_END); grid = -1; return; }
        int dev = 0, cus = 0, per_cu = 0;
        hipGetDevice(&dev); hipDeviceGetAttribute(&cus, hipDeviceAttributeMultiprocessorCount, dev);
        hipFuncSetAttribute((const void*)mega_fwd, hipFuncAttributeMaxDynamicSharedMemorySize, LDS_BYTES);
        hipOccupancyMaxActiveBlocksPerMultiprocessor(&per_cu, (const void*)mega_fwd, NTHREADS, LDS_BYTES);
        if (per_cu < 1) { fprintf(stderr, "kernel_launch: occupancy query says %d blocks/CU\n", per_cu); grid = -1; return; }
        grid = cus;
        (void)hipGetLastError();
    }
    if (grid < 0) return;
    hipMemsetAsync((char*)d_ws + WS_CTL, 0, CTL_BYTES, stream);
    Args a{};
    for (int i = 0; i < 18; ++i) a.in[i] = (const float*)d_in[i];
    a.out = (float*)d_out; a.ws = (unsigned char*)d_ws;
    void* params[] = {&a};
    hipError_t e = hipLaunchCooperativeKernel((const void*)mega_fwd, dim3(grid), dim3(NTHREADS), params, LDS_BYTES, stream);
    if (e != hipSuccess) fprintf(stderr, "cooperative launch failed: %s (grid %d)\n", hipGetErrorString(e), grid);
}
#endif
```

```cpp
#ifndef EMU
#include <hip/hip_runtime.h>
#include <hip/hip_cooperative_groups.h>
#include <cstdio>
#include <cstdint>
#include <cmath>
#endif

#ifdef CFG_SMALL
constexpr int D_MODEL = 256, SEQ = 4096, DEPTH = 2, N_HEADS = 4;
#else
constexpr int D_MODEL = 1024, SEQ = 16384, DEPTH = 4, N_HEADS = 16;
#endif
constexpr int S5_GROUPS = D_MODEL / 16, S5_STATE = 64, HEAD_DIM = 64, IDX_HEADS = 8, TOPK = 256;
constexpr int D_FF = ((8 * D_MODEL / 3 + 255) / 256) * 256;
constexpr int N_S5 = (DEPTH + 1) / 2, N_DSA = DEPTH / 2;
constexpr int DSA_PROJ = 3 * D_MODEL + 512 + 64 + 8;
constexpr int NH4 = D_MODEL / 256;
constexpr int NIN_TILES = 3 * NH4 + 3, NIN_PAD = NIN_TILES * 256;
constexpr int NCH = SEQ / 16, NCHT = NCH / 256;
constexpr int UXW = 384;
constexpr int NSEG = 32, SEGL = NCH / NSEG;
constexpr float EPS = 1e-6f;
constexpr float C2 = 0.125f * 1.4426950408889634f;
constexpr int NWAVES = 8, NTHREADS = 512;
#ifndef PROBE_DUP
#define PROBE_DUP 0
#endif
constexpr int NB = 512; constexpr float BIN_SCALE = 32.f, BIN_MAGIC = 8388608.f;
constexpr int CAND_CAP = 256;

constexpr size_t MiB = 1u << 20;
constexpr size_t WS_CTL = 0, CTL_BYTES = 3 * MiB;
constexpr size_t WS_ROWSS = 1 * MiB;
constexpr size_t SZ_WGLU = (size_t)2 * D_MODEL * D_MODEL * 2, SZ_WIN = (size_t)NIN_PAD * D_MODEL * 2, SZ_WO = (size_t)D_MODEL * D_MODEL * 2,
                 SZ_WGU = (size_t)2 * D_FF * D_MODEL * 2, SZ_WDN = (size_t)D_MODEL * D_FF * 2;
constexpr size_t WS_WGLU = CTL_BYTES, WS_WIN = WS_WGLU + N_S5 * SZ_WGLU, WS_WO = WS_WIN + N_DSA * SZ_WIN, WS_WGU = WS_WO + N_DSA * SZ_WO,
                 WS_WDN = WS_WGU + DEPTH * SZ_WGU, WS_ROPE = WS_WDN + DEPTH * SZ_WDN;
constexpr size_t SZ_ROPE = (size_t)SEQ * 64 * 4;
constexpr size_t S5PRE_STRIDE = 18432;
constexpr size_t WS_S5PRE = WS_ROPE + SZ_ROPE, SZ_S5PRE = (size_t)N_S5 * S5_GROUPS * S5PRE_STRIDE;
constexpr size_t WS_MIX = WS_S5PRE + SZ_S5PRE;
constexpr size_t SZ_AM = (size_t)S5_GROUPS * 256 * UXW * 2, SZ_W1 = (size_t)S5_GROUPS * 256 * 256 * 2, SZ_APOW = (size_t)S5_GROUPS * 64 * 16;
constexpr size_t MIX_AM = 0, MIX_W1 = MIX_AM + SZ_AM;
constexpr size_t MIX_QI = 0, SZ_QI = (size_t)SEQ * 512 * 2, MIX_KI = MIX_QI + SZ_QI, SZ_KI = (size_t)SEQ * 64 * 2, MIX_WI = MIX_KI + SZ_KI, SZ_WI = (size_t)SEQ * 8 * 4;
constexpr size_t SZ_S5TAB = MIX_W1 + SZ_W1, SZ_MIX_DSA = MIX_WI + SZ_WI;
constexpr size_t SZ_MIX = (SZ_MIX_DSA + 4095) / 4096 * 4096;
constexpr size_t WS_XB = WS_MIX + SZ_MIX, SZ_XB = (size_t)SEQ * D_MODEL * 2;
constexpr size_t WS_MASK = WS_XB + SZ_XB, SZ_MASK = (size_t)(SEQ / 32) * SEQ * 4;
constexpr size_t WS_R = WS_MASK + SZ_MASK;
constexpr size_t R_Q = 0, R_K = SZ_XB, R_V = 2 * SZ_XB;
constexpr size_t R_ACT = 0, SZ_ACT = (size_t)SEQ * D_FF * 2;
constexpr size_t R_UX = 0, SZ_UX = (size_t)S5_GROUPS * NCH * UXW * 2, R_S = ((SZ_UX + 4095) / 4096) * 4096, SZ_S = (size_t)S5_GROUPS * NCH * 128 * 4, R_Y = R_S;
constexpr size_t SZ_R0 = 3 * SZ_XB > SZ_ACT ? 3 * SZ_XB : SZ_ACT, SZ_R1 = R_S + SZ_S, SZ_R = SZ_R0 > SZ_R1 ? SZ_R0 : SZ_R1;
constexpr size_t WS_S5TAB = ((WS_R + SZ_R + 4095) / 4096) * 4096;
constexpr size_t WS_END = WS_S5TAB + N_S5 * SZ_S5TAB;
static_assert(SZ_S >= (size_t)SEQ * D_MODEL * 2, "Y fits over S");
static_assert(SEQ <= 16384, "candidate packing holds 14-bit keys");
static_assert((2 * DEPTH + 1) * (size_t)SEQ * 8 <= 2 * MiB, "rowss arrays fit");
typedef unsigned long long u64;
constexpr float SS_FIX = 1048576.0f, SS_INV = 1.0f / 1048576.0f;

typedef unsigned short bf16_t;
typedef short bf16x8 __attribute__((ext_vector_type(8)));
typedef float f32x4 __attribute__((ext_vector_type(4)));
typedef float f32x16 __attribute__((ext_vector_type(16)));
typedef unsigned u32x4 __attribute__((ext_vector_type(4)));
typedef unsigned u32x2 __attribute__((ext_vector_type(2)));
typedef short s16x4 __attribute__((ext_vector_type(4)));
typedef float f32x2 __attribute__((ext_vector_type(2)));

#ifdef EMU
#define LAS
#define GAS
#define MFMA16(a, b, c) emu_mfma16(a, b, c)
#define MFMA32(a, b, c) emu_mfma32(a, b, c)
#define WAIT_V(n)
#define WAIT_L(n) emu::wave_barrier()
#define WAIT_VM0() do {} while (0)
#define S_BARRIER() emu::block_barrier()
#define SCHED_BAR()
#define PIN16(x)
#define PIN1(x)
#define PINS(x)
#define PIN2(x)
#define SETPRIO(x)
#define RFL(x) (x)
#define LANE_ID() ((int)(threadIdx.x & 63))
#define GLDS16B(base, voff, l) emu_glds16((const void*)((const char*)(base) + (voff)), (void*)(l))
#define DS_TR16(p) emu_ds_read_tr16((const void*)(p))
#define EXP2F(x) exp2f(x)
#define RCPF(x) (1.0f / (x))
#define RSQF(x) (1.0f / sqrtf(x))
#define LDS_ATOMIC_ADD(p, v) atomicAdd((unsigned*)(p), (unsigned)(v))
#define LDS_ATOMIC_OR(p, v) atomicOr((unsigned*)(p), (unsigned)(v))
#define INVB(m) ((int)(((m) >> (threadIdx.x & 63)) & 1ull))
#define BALLOT64(p) __ballot(p)
#define WRITELANE64(lo, hi, b, r) do { if ((int)(threadIdx.x & 63) == (r)) { lo = (unsigned)(b); hi = (unsigned)((b) >> 32); } } while (0)
#define MED3F(a, lo, hi) fminf(fmaxf((a), (lo)), (hi))
#define RLX_LOAD(p) (*(p))
#define RLX_STORE(p, v) (*(p) = (v))
#define RLX_ADD(p, v) atomicAdd((unsigned*)(p), (unsigned)(v))
#else
#define LAS __attribute__((address_space(3)))
#define GAS __attribute__((address_space(1)))
#define MFMA16(a, b, c) __builtin_amdgcn_mfma_f32_16x16x32_bf16(a, b, c, 0, 0, 0)
#define MFMA32(a, b, c) __builtin_amdgcn_mfma_f32_32x32x16_bf16(a, b, c, 0, 0, 0)
#define WAIT_V(n) asm volatile("s_waitcnt vmcnt(" #n ")" ::: "memory")
#define WAIT_L(n) asm volatile("s_waitcnt lgkmcnt(" #n ")" ::: "memory")
#define WAIT_VM0() asm volatile("s_waitcnt vmcnt(0)" ::: "memory")
#define S_BARRIER() __builtin_amdgcn_s_barrier()
#define SCHED_BAR() __builtin_amdgcn_sched_barrier(0)
#define PIN16(x) asm volatile("" : "+v"(x))
#define PIN1(x) asm volatile("" : "+v"(x))
#define PINS(x) asm volatile("" : "+s"(x))
#define PIN2(x) asm volatile("" : "+v"(x))
#define SETPRIO(x) __builtin_amdgcn_s_setprio(x)
#define RFL(x) __builtin_amdgcn_readfirstlane(x)
#define LANE_ID() lane_id_now()
__device__ __forceinline__ void glds16b_(const char* base, unsigned voff, unsigned lds_dst) { asm volatile("s_mov_b32 m0, %2\n\ts_nop 0\n\tglobal_load_lds_dwordx4 %0, %1" :: "v"(voff), "s"(base), "s"(lds_dst) : "memory", "m0"); }
#define GLDS16B(base, voff, l) glds16b_((base), (voff), (unsigned)__builtin_amdgcn_readfirstlane((int)(unsigned)(size_t)(l)))
typedef short v4i16_t __attribute__((ext_vector_type(4)));
#define DS_TR16(p) __builtin_bit_cast(s16x4, __builtin_amdgcn_ds_read_tr16_b64_v4i16((LAS v4i16_t*)(p)))
#define EXP2F(x) __builtin_amdgcn_exp2f(x)
#define RCPF(x) __builtin_amdgcn_rcpf(x)
#define RSQF(x) __builtin_amdgcn_rsqf(x)
#define LDS_ATOMIC_ADD(p, v) __hip_atomic_fetch_add((LAS unsigned*)(p), (unsigned)(v), __ATOMIC_RELAXED, __HIP_MEMORY_SCOPE_WORKGROUP)
#define LDS_ATOMIC_OR(p, v) __hip_atomic_fetch_or((LAS unsigned*)(p), (unsigned)(v), __ATOMIC_RELAXED, __HIP_MEMORY_SCOPE_WORKGROUP)
#define INVB(m) __builtin_amdgcn_inverse_ballot_w64(m)
#define BALLOT64(p) __builtin_amdgcn_ballot_w64(p)
#define WRITELANE64(lo, hi, b, r) do { asm("v_writelane_b32 %0, %1, %2" : "+v"(lo) : "s"((unsigned)(b)), "n"(r)); asm("v_writelane_b32 %0, %1, %2" : "+v"(hi) : "s"((unsigned)((b) >> 32)), "n"(r)); } while (0)
#define MED3F(a, lo, hi) __builtin_amdgcn_fmed3f((a), (lo), (hi))
#define RLX_LOAD(p) __hip_atomic_load(p, __ATOMIC_RELAXED, __HIP_MEMORY_SCOPE_AGENT)
#define RLX_STORE(p, v) __hip_atomic_store(p, v, __ATOMIC_RELAXED, __HIP_MEMORY_SCOPE_AGENT)
#define RLX_ADD(p, v) __hip_atomic_fetch_add(p, v, __ATOMIC_RELAXED, __HIP_MEMORY_SCOPE_AGENT)
#endif

__device__ __forceinline__ int opaque(int v) { PIN1(v); return v; }
#ifndef EMU
__device__ __forceinline__ int lane_id_now() { int l; asm volatile("v_mbcnt_lo_u32_b32 %0, -1, 0\n\tv_mbcnt_hi_u32_b32 %0, -1, %0" : "=v"(l)); return l; }
#endif
__device__ __forceinline__ int opaque_s(int v) { PINS(v); return v; }
#ifdef EMU
__device__ __forceinline__ unsigned char* opaque_p(unsigned char* p) { PINS(p); return p; }
#else
__device__ __forceinline__ unsigned char* opaque_p(unsigned char* p) { unsigned long long v = (unsigned long long)p; PINS(v); return (unsigned char*)(__attribute__((address_space(1))) unsigned char*)v; }
#endif
#ifdef EMU
__device__ __forceinline__ const char* uni_ptr(const char* p) { return p; }
#else
__device__ __forceinline__ const char* uni_ptr(const char* p) { const unsigned long long v = (unsigned long long)p; const unsigned lo = __builtin_amdgcn_readfirstlane((unsigned)v), hi = __builtin_amdgcn_readfirstlane((unsigned)(v >> 32));
    return (const char*)(((unsigned long long)hi << 32) | lo); }
#endif
#ifdef EMU
__device__ __forceinline__ unsigned f2bf(float f) { unsigned u = __builtin_bit_cast(unsigned, f); return (u + 0x7fffu + ((u >> 16) & 1u)) >> 16; }
#else
__device__ __forceinline__ unsigned f2bf(float f) { return (unsigned)__builtin_bit_cast(unsigned short, (__bf16)f); }
#endif
#ifdef EMU
__device__ __forceinline__ unsigned pk2(float lo, float hi) { return f2bf(lo) | (f2bf(hi) << 16); }
#else
typedef __bf16 hw_bf16x2 __attribute__((ext_vector_type(2)));
__device__ __forceinline__ unsigned pk2(float lo, float hi) { f32x2 v = {lo, hi}; hw_bf16x2 b = __builtin_convertvector(v, hw_bf16x2); return __builtin_bit_cast(unsigned, b); }
#endif
__device__ __forceinline__ float bf2f(unsigned h) { return __builtin_bit_cast(float, h << 16); }
__device__ __forceinline__ float bflo(unsigned w) { return __builtin_bit_cast(float, w << 16); }
__device__ __forceinline__ float bfhi(unsigned w) { return __builtin_bit_cast(float, w & 0xffff0000u); }
__device__ __forceinline__ float sigmoidf_(float v) { return RCPF(1.0f + EXP2F(-1.4426950408889634f * v)); }
__device__ __forceinline__ float gelu_tanh(float v) { const float p = __builtin_fmaf(-0.10294322f, v * v, -2.30220819f); return v * RCPF(1.0f + EXP2F(v * p)); }
__device__ __forceinline__ float rs_of(u64 ss) { const float f = __builtin_fmaf((float)(unsigned)(ss >> 32), 4294967296.0f, (float)(unsigned)ss); return RSQF(f * (SS_INV / D_MODEL) + EPS); }
__device__ __forceinline__ float row_rs(const u64* rowss, int r) { return rs_of(rowss[r]); }
#ifdef EMU
#define PIN64(x)
#else
#define PIN64(x) asm volatile("" : "+v"(x))
#endif
__device__ __forceinline__ void row_rs8(float (&rs)[8], const u64* rowss, int r0) { u64 raw[8];
#pragma unroll
    for (int it = 0; it < 8; ++it) raw[it] = rowss[r0 + (it >> 2) * 128 + (it & 3) * 16];
#pragma unroll
    for (int it = 0; it < 8; ++it) PIN64(raw[it]);
#pragma unroll
    for (int it = 0; it < 8; ++it) rs[it] = rs_of(raw[it]); }
__device__ __forceinline__ int crow(int r, int hi) { return (r & 3) + 8 * (r >> 2) + 4 * hi; }

#define XB_TMO      128
#define XB_XCNT(j)  (256  + 64 * (j))
#define XB_XSUB(j)  (1280 + 64 * (j))
#define XB_XGEN(j)  (2304 + 64 * (j))
#define XB_TOP      3328
#define XB_TOPGEN   3392
#define XCD_BAR_WORDS 3456
#define XB_SPIN_CAP 0xF0000000u
struct XcdBarrier { unsigned* bar; unsigned x; volatile LAS unsigned* st; };
#ifdef EMU
__device__ __forceinline__ XcdBarrier xcd_barrier_post(unsigned* bar, volatile unsigned* st) { XcdBarrier b; b.bar = bar; b.x = 0; b.st = st; return b; }
__device__ __forceinline__ void xcd_barrier(const XcdBarrier&) { emu::grid_barrier(); }
#else
__device__ __forceinline__ unsigned xb_ld(unsigned* p)              { return __hip_atomic_load(p, __ATOMIC_RELAXED, __HIP_MEMORY_SCOPE_AGENT); }
__device__ __forceinline__ unsigned xb_add(unsigned* p, unsigned v) { return __hip_atomic_fetch_add(p + opaque(0), v, __ATOMIC_RELAXED, __HIP_MEMORY_SCOPE_AGENT); }
__device__ __forceinline__ unsigned xb_xcc_id() { return (unsigned)__builtin_amdgcn_s_getreg((3 << 11) | 20) & 0xFu; }
#define XB_SPIN(cond, bar) do { unsigned _sp = 0; while (cond) { __builtin_amdgcn_s_sleep(1); \
    if ((++_sp & 255u) == 0u) { if (xb_ld(&(bar)[XB_TMO])) break; if (_sp > XB_SPIN_CAP) { atomicAdd(&(bar)[XB_TMO], 1u); break; } } } } while (0)
__device__ __forceinline__ XcdBarrier xcd_barrier_post(unsigned* bar, volatile LAS unsigned* st) {
    XcdBarrier b; b.bar = bar; b.x = (unsigned)__builtin_amdgcn_readfirstlane((int)xb_xcc_id()); b.st = st;
    if (threadIdx.x == 0) (void)xb_add(&bar[XB_XCNT(b.x)], 1u);
    return b;
}
__device__ __forceinline__ void xcd_barrier_complete(unsigned* bar, unsigned x, unsigned& nloc, unsigned& nx) {
    const unsigned G = gridDim.x * gridDim.y * gridDim.z;
    unsigned sum, cnt, mine, sp = 0u;
    for (;;) {
        sum = 0u; cnt = 0u; mine = 0u;
#pragma unroll
        for (unsigned j = 0; j < 16; ++j) { const unsigned c = xb_ld(&bar[XB_XCNT(j)]); sum += c; cnt += (c > 0u) ? 1u : 0u; mine = (j == x) ? c : mine; }
        if (sum == G) break;
        __builtin_amdgcn_s_sleep(1);
        if ((++sp & 255u) == 0u) { if (xb_ld(&bar[XB_TMO])) break; if (sp > XB_SPIN_CAP) { atomicAdd(&bar[XB_TMO], 1u); break; } }
    }
    nloc = mine > 0u ? mine : 1u; nx = cnt > 0u ? cnt : 1u;
}
__device__ __forceinline__ void xcd_barrier(const XcdBarrier& b) {
    asm volatile("s_waitcnt vmcnt(0)" ::: "memory");
    __syncthreads();
    if (threadIdx.x == 0) {
        unsigned* bar = b.bar; const unsigned bx = (unsigned)__builtin_amdgcn_readfirstlane(opaque((int)b.x));
        __builtin_amdgcn_s_waitcnt(0);
        unsigned nloc = b.st[0], nx = b.st[1];
        if (nloc == 0u) { xcd_barrier_complete(bar, bx, nloc, nx); b.st[0] = nloc; b.st[1] = nx; }
        const unsigned old = xb_add(&bar[XB_XSUB(bx)], 1u);
        const unsigned gen = old / nloc;
        if (old + 1u == (gen + 1u) * nloc) {
            __builtin_amdgcn_fence(__ATOMIC_RELEASE, "agent");
            asm volatile("s_waitcnt vmcnt(0)" ::: "memory");
            const unsigned og = xb_add(&bar[XB_TOP], 1u);
            const unsigned tg = og / nx;
            if (og + 1u == (tg + 1u) * nx) xb_add(&bar[XB_TOPGEN], 1u);
            else XB_SPIN(xb_ld(&bar[XB_TOPGEN]) == tg, bar);
            __builtin_amdgcn_fence(__ATOMIC_ACQUIRE, "agent");
            xb_add(&bar[XB_XGEN(bx)], 1u);
            asm volatile("s_waitcnt vmcnt(0)" ::: "memory");
        } else {
            XB_SPIN(xb_ld(&bar[XB_XGEN(bx)]) == gen, bar);
            __builtin_amdgcn_fence(__ATOMIC_ACQUIRE, "agent");
            asm volatile("s_waitcnt vmcnt(0)" ::: "memory");
        }
    }
    __syncthreads();
}
#endif

namespace pg8 {
constexpr int BM = 256, BK = 64, HALF = 128, HTB = HALF * BK * 2, STAGE_BYTES = 8 * HTB, NXCD = 8, WGM = 8;
__host__ __device__ __forceinline__ int lds_byte(int r, int c) { const int st = (r >> 4) * 2 + (c >> 5), rr = r & 15, cc = c & 31, ob = rr * 64 + cc * 2; return st * 1024 + (ob ^ (((ob >> 9) & 1) << 5)); }
__host__ __device__ __forceinline__ void stage_rc(int b, int& R, int& C) { const int st = b / 1024, sb = b % 1024, swz = sb ^ (((sb >> 9) & 1) << 5); R = (st >> 1) * 16 + swz / 64; C = (st & 1) * 32 + (swz % 64) / 2; }
__host__ __device__ __forceinline__ int perm32(int rho) { const int n = rho >> 4, i = rho & 15; return 8 * (i >> 2) + 4 * n + (i & 3); }
struct Unit { int pm, pn; };
struct Gemm { const bf16_t* A; const bf16_t* Bt; int lda, ldb, K; };
struct StaticOrder {
    int nM, nN, nwg, G, c;
    __host__ __device__ void init(int M, int N, int G_, int c_) { nM = M / BM; nN = N / BM; nwg = nM * nN; G = G_; c = c_; }
    __host__ __device__ bool next(int i, Unit& u) const {
        const long L = (long)i * G + c; if (L >= nwg) return false;
        int wgid = (int)L; { const int q = nwg / NXCD, r = nwg % NXCD, xcd = wgid % NXCD, off = wgid / NXCD; wgid = (xcd < r ? xcd * (q + 1) : r * (q + 1) + (xcd - r) * q) + off; }
        const int nig = WGM * nN, gid = wgid / nig, fm = gid * WGM, gsz = (nM - fm) < WGM ? (nM - fm) : WGM;
        u.pm = fm + ((wgid % nig) % gsz); u.pn = (wgid % nig) / gsz; return true;
    }
};
struct GroupOrder {
    int G, c;
    __host__ __device__ bool next(int i, Unit& u) const { const int idx = i * G + c; if (idx >= S5_GROUPS * NCHT) return false; const int g = idx / NCHT; u.pm = idx; u.pn = g; return true; }
};

template <class Epi, class Sched>
__device__ __forceinline__ void gemm_phase(LAS unsigned char* lds, const int wave_id, const Gemm g, const Sched& S, const Epi& E) {
    const int lane = LANE_ID(), wid = opaque_s(wave_id), tid = wid * 64 + lane, wr = wid >> 2, wc = wid & 3, fr = lane & 15, fq = lane >> 4;
    const int K = g.K, nt = K / BK;
    unsigned voffA[2], voffB[2];
#pragma unroll
    for (int i = 0; i < 2; ++i) { int R, C; stage_rc(tid * 16 + i * 8192, R, C); const int Rb = Epi::PERM ? ((R & ~31) + perm32(R & 31)) : R;
        voffA[i] = (unsigned)(R * g.lda + C) * 2u; voffB[i] = (unsigned)(Rb * g.ldb + C) * 2u; }
    const size_t kstep = (size_t)(BK * 2);
    const size_t hstepA = (size_t)HALF * g.lda * 2, hstepB = (size_t)HALF * g.ldb * 2;
    const size_t tstepA = 2 * hstepA, tstepB = 2 * hstepB;
    const unsigned ldsw = (unsigned)wid * 1024u;
    const int aoff = lds_byte(wr * 64 + fr, fq * 8), boff = lds_byte(wc * 32 + fr, fq * 8);
#define PG8_SA(b, h) (((b) * 2 + (h)) * HTB)
#define PG8_SB(b, h) ((4 + (b) * 2 + (h)) * HTB)
#define PG8_STAGE(bufoff, gbase, voff) do { const char* _gb = uni_ptr((const char*)(gbase));     \
    _Pragma("unroll") for (int _i = 0; _i < 2; ++_i) \
        GLDS16B(_gb, (voff)[_i], lds + (bufoff) + ldsw + _i * 8192); } while (0)
#define PG8_LDA(dst, b, h) do { _Pragma("unroll") for (int m = 0; m < 4; ++m) _Pragma("unroll") for (int k = 0; k < 2; ++k) dst[m][k] = *(const LAS bf16x8*)(lds + PG8_SA(b, h) + aoff + m * 2048 + k * 1024); } while (0)
#define PG8_LDB(dst, b, h) do { _Pragma("unroll") for (int n = 0; n < 2; ++n) _Pragma("unroll") for (int k = 0; k < 2; ++k) dst[n][k] = *(const LAS bf16x8*)(lds + PG8_SB(b, h) + boff + n * 2048 + k * 1024); } while (0)
#define PG8_MMA(ai, bj, At, Bt) do { SETPRIO(1); _Pragma("unroll") for (int m = 0; m < 4; ++m) _Pragma("unroll") for (int n = 0; n < 2; ++n) _Pragma("unroll") for (int k = 0; k < 2; ++k) \
        acc[ai][bj][m][n] = MFMA16(Bt[n][k], At[m][k], acc[ai][bj][m][n]); SETPRIO(0); } while (0)
#define PG8_BAR S_BARRIER()
    Unit cur, nxt; int ui = 0;
    if (!S.next(0, cur)) return;
    f32x4 acc[2][2][4][2];
#pragma unroll
    for (int a = 0; a < 2; ++a)
#pragma unroll
        for (int b = 0; b < 2; ++b)
#pragma unroll
            for (int m = 0; m < 4; ++m)
#pragma unroll
                for (int n = 0; n < 2; ++n) acc[a][b][m][n] = (f32x4){0.f, 0.f, 0.f, 0.f};
    bf16x8 At[4][2], B0[2][2], B1[2][2];
    const char* cA = (const char*)g.A + (size_t)cur.pm * tstepA; const char* cB = (const char*)g.Bt + (size_t)cur.pn * tstepB;
    PG8_STAGE(PG8_SB(0, 0), cB, voffB); PG8_STAGE(PG8_SB(0, 1), cB + hstepB, voffB); PG8_STAGE(PG8_SA(0, 0), cA, voffA); PG8_STAGE(PG8_SA(0, 1), cA + hstepA, voffA);
    if (wr == 1) PG8_BAR;
    WAIT_V(2); PG8_BAR;
    PG8_STAGE(PG8_SB(1, 0), cB + kstep, voffB); PG8_STAGE(PG8_SA(1, 0), cA + kstep, voffA); PG8_STAGE(PG8_SB(1, 1), cB + hstepB + kstep, voffB);
    WAIT_V(6); PG8_BAR;
    for (;;) {
        const bool has_next = S.next(ui + 1, nxt);
        const char* nA = has_next ? (const char*)g.A + (size_t)nxt.pm * tstepA : cA; const char* nB = has_next ? (const char*)g.Bt + (size_t)nxt.pn * tstepB : cB;
        for (int t = 0; t < nt; t += 2) {
            const bool last = (t == nt - 2);
            const char* a1 = cA + (size_t)(t + 1) * kstep;
            const char* a2 = last ? nA : cA + (size_t)(t + 2) * kstep; const char* b2 = last ? nB : cB + (size_t)(t + 2) * kstep;
            const char* a3 = a2 + kstep; const char* b3 = b2 + kstep;
            PG8_LDB(B0, 0, 0); PG8_LDB(B1, 0, 1); SCHED_BAR(); PG8_LDA(At, 0, 0); PG8_STAGE(PG8_SA(1, 1), a1 + hstepA, voffA);
            WAIT_V(8); WAIT_L(0); PG8_BAR; PG8_MMA(0, 0, At, B0); PG8_MMA(0, 1, At, B1); PG8_BAR; SCHED_BAR();
            PG8_LDA(At, 0, 1); PG8_STAGE(PG8_SB(0, 0), b2, voffB); PG8_STAGE(PG8_SB(0, 1), b2 + hstepB, voffB); PG8_STAGE(PG8_SA(0, 0), a2, voffA);
            WAIT_V(8); WAIT_L(0); PG8_BAR; PG8_MMA(1, 0, At, B0); PG8_MMA(1, 1, At, B1); PG8_BAR; SCHED_BAR();
            PG8_LDB(B0, 1, 0); PG8_LDB(B1, 1, 1); SCHED_BAR(); PG8_LDA(At, 1, 0); PG8_STAGE(PG8_SA(0, 1), a2 + hstepA, voffA);
            WAIT_V(8); WAIT_L(0); PG8_BAR; PG8_MMA(0, 0, At, B0); PG8_MMA(0, 1, At, B1); PG8_BAR; SCHED_BAR();
            PG8_LDA(At, 1, 1); PG8_STAGE(PG8_SB(1, 0), b3, voffB); PG8_STAGE(PG8_SB(1, 1), b3 + hstepB, voffB); PG8_STAGE(PG8_SA(1, 0), a3, voffA);
            WAIT_V(8); WAIT_L(0); PG8_BAR; PG8_MMA(1, 0, At, B0); PG8_MMA(1, 1, At, B1); PG8_BAR; SCHED_BAR();
        }
        if (wr == 0) PG8_BAR;
        { const int le = LANE_ID(); E(acc, cur, wr, wc, le & 15, le >> 4); }
        if (!has_next) break;
#pragma unroll
        for (int a = 0; a < 2; ++a)
#pragma unroll
            for (int b = 0; b < 2; ++b)
#pragma unroll
                for (int m = 0; m < 4; ++m)
#pragma unroll
                    for (int n = 0; n < 2; ++n) acc[a][b][m][n] = (f32x4){0.f, 0.f, 0.f, 0.f};
        cur = nxt; cA = nA; cB = nB; ++ui;
        if (wr == 1) PG8_BAR;
    }
    WAIT_V(0);
    PG8_BAR;
#undef PG8_SA
#undef PG8_SB
#undef PG8_STAGE
#undef PG8_LDA
#undef PG8_LDB
#undef PG8_MMA
#undef PG8_BAR
}
}
using pg8::Unit;

#ifdef EMU
#define SHFL_XOR_F(v, m) __shfl_xor(v, m)
#define SHFL_IDX_U(v, i) __shfl(v, i)
__device__ __forceinline__ float sum_x16(float s) { return s + __shfl_xor(s, 16); }
__device__ __forceinline__ float sum_x32(float s) { return s + __shfl_xor(s, 32); }
#else
#define SHFL_XOR_F(v, m) __builtin_bit_cast(float, __builtin_amdgcn_ds_swizzle(__builtin_bit_cast(int, (float)(v)), (((m) << 10) | 0x1F)))
#define SHFL_IDX_U(v, i) ((unsigned)__builtin_amdgcn_ds_bpermute((i) << 2, (int)(v)))
__device__ __forceinline__ float sum_x16(float s) { float a = s, b = s; asm("s_nop 1\n\tv_permlane16_swap_b32 %0, %1" : "+v"(a), "+v"(b)); return a + b; }
__device__ __forceinline__ float sum_x32(float s) { float a = s, b = s; asm("s_nop 1\n\tv_permlane32_swap_b32 %0, %1" : "+v"(a), "+v"(b)); return a + b; }
#endif
__device__ __forceinline__ float quad_sum(float s) { return sum_x32(sum_x16(s)); }

template <bool GLU> struct EpiRes {
    static constexpr bool PERM = true;
    bf16_t* xb; float* xout; u64* rowss;
    __device__ __forceinline__ void operator()(const f32x4 (&acc)[2][2][4][2], const Unit& u, int wr, int wc, int fr, int fq) const {
        PIN1(fr); PIN1(fq);
        constexpr int NB = GLU ? 1 : 2;
        const bool last = xout != nullptr;
#pragma unroll
        for (int ai = 0; ai < 2; ++ai) {
            u32x4 xo[4][NB];
#pragma unroll
            for (int m = 0; m < 4; ++m) { const int r = u.pm * 256 + ai * 128 + wr * 64 + m * 16 + fr;
#pragma unroll
                for (int bj = 0; bj < NB; ++bj) { const size_t off = (size_t)r * D_MODEL + (GLU ? u.pn * 128 : u.pn * 256 + bj * 128) + wc * 32 + 8 * fq; xo[m][bj] = *(const u32x4*)(xb + off); } }
#pragma unroll
            for (int m = 0; m < 4; ++m) { const int r = u.pm * 256 + ai * 128 + wr * 64 + m * 16 + fr; float ss = 0.f;
#pragma unroll
                for (int bj = 0; bj < NB; ++bj) { const size_t off = (size_t)r * D_MODEL + (GLU ? u.pn * 128 : u.pn * 256 + bj * 128) + wc * 32 + 8 * fq; f32x4 o[2];
                    const unsigned xw[4] = {xo[m][bj].x, xo[m][bj].y, xo[m][bj].z, xo[m][bj].w};
#pragma unroll
                    for (int n = 0; n < 2; ++n)
#pragma unroll
                        for (int i = 0; i < 4; ++i) { const unsigned w2 = xw[2 * n + (i >> 1)]; const float xv = (i & 1) ? bfhi(w2) : bflo(w2);
                            const float t = xv + (GLU ? acc[ai][0][m][n][i] * sigmoidf_(acc[ai][1][m][n][i]) : acc[ai][bj][m][n][i]); o[n][i] = t; ss += t * t; }
                    if (last) { *(f32x4*)(xout + off) = o[0]; *(f32x4*)(xout + off + 4) = o[1]; }
                    else { u32x4 w; w.x = pk2(o[0][0], o[0][1]); w.y = pk2(o[0][2], o[0][3]); w.z = pk2(o[1][0], o[1][1]); w.w = pk2(o[1][2], o[1][3]); *(u32x4*)(xb + off) = w; } }
                if (!last) { ss = quad_sum(ss); if (fq == 0) atomicAdd(rowss + r, (u64)(ss * SS_FIX)); } }
        }
    }
};
struct EpiSwiGLU {
    static constexpr bool PERM = true;
    bf16_t* act; const u64* rowss;
    __device__ __forceinline__ void operator()(const f32x4 (&acc)[2][2][4][2], const Unit& u, int wr, int wc, int fr, int fq) const {
        PIN1(fr); PIN1(fq);
        float rsv8[8]; row_rs8(rsv8, rowss, u.pm * 256 + wr * 64 + fr);
#pragma unroll
        for (int ai = 0; ai < 2; ++ai)
#pragma unroll
            for (int m = 0; m < 4; ++m) {
                const int r = u.pm * 256 + ai * 128 + wr * 64 + m * 16 + fr; const float rs = rsv8[ai * 4 + m], rs2 = rs * rs, nrs = -1.4426950408889634f * rs;
                float o[8];
#pragma unroll
                for (int n = 0; n < 2; ++n)
#pragma unroll
                    for (int i = 0; i < 4; ++i) { const float g_ = acc[ai][0][m][n][i], u_ = acc[ai][1][m][n][i]; o[4 * n + i] = (g_ * u_) * (rs2 * RCPF(1.0f + EXP2F(nrs * g_))); }
                u32x4 w; w.x = pk2(o[0], o[1]); w.y = pk2(o[2], o[3]); w.z = pk2(o[4], o[5]); w.w = pk2(o[6], o[7]);
                *(u32x4*)(act + (size_t)r * D_FF + u.pn * 128 + wc * 32 + 8 * fq) = w;
            }
    }
};
struct EpiInProj {
    static constexpr bool PERM = true;
    bf16_t *Q, *Kb, *V, *QI, *KI; float* WI; const u64* rowss; const float* rope; const float* qg; const float* kg;
    __device__ __forceinline__ void operator()(const f32x4 (&acc)[2][2][4][2], const Unit& u, int wr, int wc, int fr, int fq) const {
        PIN1(fr); PIN1(fq);
        const int pn = u.pn; const int r0 = u.pm * 256 + wr * 64 + fr;
        if (pn >= 2 * NH4 && pn < 3 * NH4) {
            float rsv[8]; row_rs8(rsv, rowss, r0);
#pragma unroll
            for (int it = 0; it < 8; ++it) { const int ai = it >> 2, m = it & 3; const int r = r0 + ai * 128 + m * 16; const float rs = rsv[it];
                const size_t off = (size_t)r * D_MODEL + (pn - 2 * NH4) * 256 + wc * 32 + 8 * fq; u32x4 w;
                w.x = pk2(rs * acc[ai][0][m][0][0], rs * acc[ai][0][m][0][1]); w.y = pk2(rs * acc[ai][0][m][0][2], rs * acc[ai][0][m][0][3]); w.z = pk2(rs * acc[ai][0][m][1][0], rs * acc[ai][0][m][1][1]); w.w = pk2(rs * acc[ai][0][m][1][2], rs * acc[ai][0][m][1][3]); *(u32x4*)(V + off) = w;
                w.x = pk2(rs * acc[ai][1][m][0][0], rs * acc[ai][1][m][0][1]); w.y = pk2(rs * acc[ai][1][m][0][2], rs * acc[ai][1][m][0][3]); w.z = pk2(rs * acc[ai][1][m][1][0], rs * acc[ai][1][m][1][1]); w.w = pk2(rs * acc[ai][1][m][1][2], rs * acc[ai][1][m][1][3]); *(u32x4*)(V + off + 128) = w; }
            return;
        }
        const bool last = (pn == 3 * NH4 + 2);
        if (last && wc == 1) {
#pragma unroll
            for (int it = 0; it < 8; ++it) { const int ai = it >> 2, m = it & 3; const int r = r0 + ai * 128 + m * 16; const float sc = row_rs(rowss, r) * (0.35355339059327373f * 0.125f);
                if (fq == 0) { *(f32x4*)(WI + (size_t)r * 8) = (f32x4){acc[ai][0][m][0][0] * sc, acc[ai][0][m][0][1] * sc, acc[ai][0][m][0][2] * sc, acc[ai][0][m][0][3] * sc};
                               *(f32x4*)(WI + (size_t)r * 8 + 4) = (f32x4){acc[ai][0][m][1][0] * sc, acc[ai][0][m][1][1] * sc, acc[ai][0][m][1][2] * sc, acc[ai][0][m][1][3] * sc}; } }
            return;
        }
        if (last && wc != 0) return;
        const bool isq = pn < NH4, isk = (pn >= NH4 && pn < 2 * NH4), nrm = isq || isk || last;
        float g1[8], g2[8];
        { const float* gn = isq ? qg : kg;
#pragma unroll
          for (int i = 0; i < 8; ++i) { g1[i] = (isq || isk) ? gn[8 * fq + i] : 1.0f; g2[i] = (isq || isk) ? gn[32 + 8 * fq + i] : 1.0f; } }
        const float qs = isq ? C2 : 1.0f;
        bf16_t* dst0;
        if (isq) dst0 = Q + (size_t)r0 * D_MODEL + (pn * 4 + wc) * 64; else if (isk) dst0 = Kb + (size_t)r0 * D_MODEL + ((pn - NH4) * 4 + wc) * 64;
        else if (last) dst0 = KI + (size_t)r0 * 64; else dst0 = QI + (size_t)r0 * 512 + ((pn - 3 * NH4) * 4 + wc) * 64;
        const size_t dstride = (isq || isk) ? (size_t)D_MODEL : (last ? (size_t)64 : (size_t)512);
        f32x4 cn[4]; float rsn;
        { const float* cs = rope + (size_t)r0 * 64 + 8 * fq; rsn = row_rs(rowss, r0); cn[0] = *(const f32x4*)cs; cn[1] = *(const f32x4*)(cs + 4); cn[2] = *(const f32x4*)(cs + 32); cn[3] = *(const f32x4*)(cs + 36); }
#pragma unroll
        for (int it = 0; it < 8; ++it) { const int ai = it >> 2, m = it & 3; const int rofs = ai * 128 + m * 16;
            const f32x4 c0 = cn[0], c1 = cn[1], s0 = cn[2], s1 = cn[3]; const float rs = rsn;
            if (it < 7) { const int rn_ = r0 + ((it + 1) >> 2) * 128 + ((it + 1) & 3) * 16; const float* cs = rope + (size_t)rn_ * 64 + 8 * fq; rsn = row_rs(rowss, rn_);
                cn[0] = *(const f32x4*)cs; cn[1] = *(const f32x4*)(cs + 4); cn[2] = *(const f32x4*)(cs + 32); cn[3] = *(const f32x4*)(cs + 36); }
            float t1[8], t2[8];
#pragma unroll
            for (int n = 0; n < 2; ++n)
#pragma unroll
                for (int i = 0; i < 4; ++i) { t1[4 * n + i] = acc[ai][0][m][n][i]; t2[4 * n + i] = acc[ai][1][m][n][i]; }
            float f = rs * qs;
            if (nrm) {
                float ss = 0.f;
#pragma unroll
                for (int i = 0; i < 8; ++i) ss += t1[i] * t1[i] + t2[i] * t2[i];
                ss = quad_sum(ss); f *= RSQF(rs * rs * ss * (1.0f / 64.0f) + EPS);
            }
#pragma unroll
            for (int i = 0; i < 8; ++i) { t1[i] *= f * g1[i]; t2[i] *= f * g2[i]; }
            const float cc[8] = {c0[0], c0[1], c0[2], c0[3], c1[0], c1[1], c1[2], c1[3]}, sv[8] = {s0[0], s0[1], s0[2], s0[3], s1[0], s1[1], s1[2], s1[3]};
            float o1[8], o2[8];
#pragma unroll
            for (int i = 0; i < 8; ++i) { o1[i] = t1[i] * cc[i] - t2[i] * sv[i]; o2[i] = t2[i] * cc[i] + t1[i] * sv[i]; }
            bf16_t* dst = dst0 + (size_t)rofs * dstride;
            u32x4 w; w.x = pk2(o1[0], o1[1]); w.y = pk2(o1[2], o1[3]); w.z = pk2(o1[4], o1[5]); w.w = pk2(o1[6], o1[7]); *(u32x4*)(dst + 8 * fq) = w;
            w.x = pk2(o2[0], o2[1]); w.y = pk2(o2[2], o2[3]); w.z = pk2(o2[4], o2[5]); w.w = pk2(o2[6], o2[7]); *(u32x4*)(dst + 32 + 8 * fq) = w;
        }
    }
};
struct EpiS5State {
    static constexpr bool PERM = true;
    bf16_t* S;
    __device__ __forceinline__ void operator()(const f32x4 (&acc)[2][2][4][2], const Unit& u, int wr, int wc, int fr, int fq) const {
        PIN1(fr); PIN1(fq);
#pragma unroll
        for (int ai = 0; ai < 2; ++ai)
#pragma unroll
            for (int m = 0; m < 4; ++m) { const size_t row = (size_t)u.pm * 256 + ai * 128 + wr * 64 + m * 16 + fr;
                u32x4 w; w.x = pk2(acc[ai][0][m][0][0], acc[ai][0][m][0][1]); w.y = pk2(acc[ai][0][m][0][2], acc[ai][0][m][0][3]); w.z = pk2(acc[ai][0][m][1][0], acc[ai][0][m][1][1]); w.w = pk2(acc[ai][0][m][1][2], acc[ai][0][m][1][3]);
                *(u32x4*)(S + row * 128 + wc * 32 + 8 * fq) = w; }
    }
};
struct EpiS5Out {
    static constexpr bool PERM = true;
    bf16_t* Y; const bf16_t* UX; const float* dskip;
    __device__ __forceinline__ void operator()(const f32x4 (&acc)[2][2][4][2], const Unit& u, int wr, int wc, int fr, int fq) const {
        PIN1(fr); PIN1(fq);
        const int g = u.pn;
        float dk[8];
        { const float* dp = dskip + 16 * g + ((wc * 32 + 8 * fq) & 15);
#pragma unroll
          for (int e = 0; e < 8; ++e) dk[e] = dp[e]; }
#pragma unroll
        for (int ai = 0; ai < 2; ++ai)
#pragma unroll
            for (int mp = 0; mp < 2; ++mp) {
                u32x4 uw[2][2];
#pragma unroll
                for (int mm = 0; mm < 2; ++mm) { const size_t row = (size_t)u.pm * 256 + ai * 128 + wr * 64 + (2 * mp + mm) * 16 + fr;
#pragma unroll
                    for (int bj = 0; bj < 2; ++bj) uw[mm][bj] = *(const u32x4*)(UX + row * UXW + bj * 128 + wc * 32 + 8 * fq); }
#pragma unroll
                for (int mm = 0; mm < 2; ++mm) { const int m = 2 * mp + mm; const size_t row = (size_t)u.pm * 256 + ai * 128 + wr * 64 + m * 16 + fr; const int c = (int)(row - (size_t)g * NCH);
#pragma unroll
                    for (int bj = 0; bj < 2; ++bj) { const int col = bj * 128 + wc * 32 + 8 * fq, i = col >> 4, ho = col & 15;
                        float o[8]; const unsigned uu[4] = {uw[mm][bj].x, uw[mm][bj].y, uw[mm][bj].z, uw[mm][bj].w};
#pragma unroll
                        for (int n = 0; n < 2; ++n)
#pragma unroll
                            for (int j = 0; j < 4; ++j) { const int e = 4 * n + j; const float uv = (e & 1) ? bfhi(uu[e >> 1]) : bflo(uu[e >> 1]); o[e] = gelu_tanh(acc[ai][bj][m][n][j] + dk[e] * uv); }
                        u32x4 w; w.x = pk2(o[0], o[1]); w.y = pk2(o[2], o[3]); w.z = pk2(o[4], o[5]); w.w = pk2(o[6], o[7]);
                        *(u32x4*)(Y + (size_t)(16 * c + i) * D_MODEL + 16 * g + ho) = w; } }
            }
    }
};

constexpr int RING_BYTES = 131072, LDSCTL_OFF = RING_BYTES, LDS_BYTES = 147456;
struct Args { const float* in[18]; float* out; unsigned char* ws; };
struct Frame {
    LAS unsigned char* lds; int tid, lane, wave, vcu, G;
    const float* in[18]; float* out; unsigned char* ws;
};
__device__ __forceinline__ float wave_sum(float v) {
    v += SHFL_XOR_F(v, 1); v += SHFL_XOR_F(v, 2); v += SHFL_XOR_F(v, 4); v += SHFL_XOR_F(v, 8); v += SHFL_XOR_F(v, 16);
    return sum_x32(v);
}
__device__ __forceinline__ int win_src(int np) {
    const int pn = np >> 8, y = np & 255, bj = y >> 7, hh = (y >> 5) & 3, dd = y & 31;
    if (pn < 2 * NH4) { const int base = pn < NH4 ? 0 : D_MODEL, t = pn < NH4 ? pn : pn - NH4; return base + (4 * t + hh) * 64 + 32 * bj + dd; }
    if (pn < 3 * NH4) return np;
    if (pn < 3 * NH4 + 2) return 3 * D_MODEL + (4 * (pn - 3 * NH4) + hh) * 64 + 32 * bj + dd;
    if (hh == 0) return 3 * D_MODEL + 512 + 32 * bj + dd;
    if (hh == 1 && bj == 0 && dd < 8) return 3 * D_MODEL + 512 + 64 + dd;
    return -1;
}
__device__ __forceinline__ int glu_src(int np, int HW) { const int pn = np >> 8, y = np & 255; return (y >> 7) * HW + pn * 128 + (y & 127); }

struct TItem { const float* W; const float* gain; bf16_t* WT; int K, N, HW, NP, mode, item; };
__device__ __forceinline__ void ti_load(const TItem& T, float (&v)[32], f32x4 (&g)[2], int lane) {
    const int nblk = T.NP / 32, kb = T.item / nblk, nb = T.item % nblk, k0 = 64 * kb, n0 = 32 * nb;
    const int np = n0 + (lane & 31); const int src = T.mode == 0 ? np : (T.mode == 1 ? glu_src(np, T.HW) : win_src(np));
    const float* wp = T.W + (size_t)(k0 + (lane >> 5)) * T.N + (src >= 0 ? src : 0);
#pragma unroll
    for (int i = 0; i < 32; ++i) { const float x = wp[(size_t)(2 * i) * T.N]; v[i] = (src >= 0) ? x : 0.f; }
    if (T.gain) { g[0] = *(const f32x4*)(T.gain + k0 + 8 * (lane & 7)); g[1] = *(const f32x4*)(T.gain + k0 + 8 * (lane & 7) + 4); }
    else { g[0] = (f32x4){1.f, 1.f, 1.f, 1.f}; g[1] = g[0]; }
}
__device__ __forceinline__ void ti_finish(const TItem& T, const float (&v)[32], const f32x4 (&g)[2], LAS float* scr, int lane) {
    const int nblk = T.NP / 32, kb = T.item / nblk, nb = T.item % nblk, k0 = 64 * kb, n0 = 32 * nb;
#pragma unroll
    for (int i = 0; i < 32; ++i) scr[(2 * i + (lane >> 5)) * 33 + (lane & 31)] = v[i];
    WAIT_L(0);
    const int c = lane & 7;
#pragma unroll
    for (int j = 0; j < 4; ++j) { const int n = (lane >> 3) + 8 * j; const LAS float* q = scr + (8 * c) * 33 + n;
        u32x4 o; o.x = pk2(q[0 * 33] * g[0][0], q[1 * 33] * g[0][1]); o.y = pk2(q[2 * 33] * g[0][2], q[3 * 33] * g[0][3]); o.z = pk2(q[4 * 33] * g[1][0], q[5 * 33] * g[1][1]); o.w = pk2(q[6 * 33] * g[1][2], q[7 * 33] * g[1][3]);
        *(u32x4*)(T.WT + (size_t)(n0 + n) * T.K + k0 + 8 * c) = o; }
    WAIT_L(0);
}
__device__ __forceinline__ void s5_pre(Frame& F0) {
    Frame F = F0; F.lane = LANE_ID(); F.tid = F0.wave * 64 + F.lane;
    static_assert((SEGL & (SEGL - 1)) == 0, "a^(16 SEGL) by repeated squaring");
    for (int jg = blockIdx.x; jg < N_S5 * S5_GROUPS; jg += F.G) {
        const float* lre = F.in[1] + (size_t)jg * 64; const float* lim = F.in[2] + (size_t)jg * 64; const float* bre = F.in[4] + (size_t)jg * 1024; const float* bim = F.in[5] + (size_t)jg * 1024;
        float* pre = (float*)(F.ws + WS_S5PRE + (size_t)jg * S5PRE_STRIDE);
        if (F.tid < 64) { const int p = F.tid;
            const double dt = exp((double)F.in[3][jg]), lr = lre[p], li = lim[p], m = exp(lr * dt), ar = m * cos(li * dt), ai = m * sin(li * dt);
            double pr = 1.0, pi = 0.0, a16r = 1.0, a16i = 0.0;
            for (int tau = 0; tau < 18; ++tau) { pre[(tau * 64 + p) * 2] = (float)pr; pre[(tau * 64 + p) * 2 + 1] = (float)pi; if (tau == 16) { a16r = pr; a16i = pi; }
                const double nr = pr * ar - pi * ai, ni = pr * ai + pi * ar; pr = nr; pi = ni; }
            const double den = lr * lr + li * li, qr = ((ar - 1.0) * lr + ai * li) / den, qi = (ai * lr - (ar - 1.0) * li) / den;
            for (int h = 0; h < 16; ++h) { const int e = p * 16 + h; const double br = bre[e], bi = bim[e]; pre[2304 + e * 2] = (float)(qr * br - qi * bi); pre[2304 + e * 2 + 1] = (float)(qr * bi + qi * br); }
            double sr = a16r, si = a16i;
            for (int k = SEGL; k > 1; k >>= 1) { const double nr = sr * sr - si * si, ni = 2.0 * sr * si; sr = nr; si = ni; }
            f32x4 v; v.x = (float)a16r; v.y = (float)a16i; v.z = (float)sr; v.w = (float)si;
            *(f32x4*)(pre + 4352 + p * 4) = v; }
    }
}
__device__ __forceinline__ void s5_setup(Frame& F0) {
    Frame F = F0; F.lane = LANE_ID(); F.tid = F0.wave * 64 + F.lane;
    LAS float* ap = (LAS float*)F.lds;
    LAS float* bb = ap + 18 * 128;
    LAS float* cc = bb + 2048;
    LAS float* kt = cc + 2048;
    for (int jg = blockIdx.x; jg < N_S5 * S5_GROUPS; jg += F.G) {
        const int j = jg / S5_GROUPS, g = jg % S5_GROUPS;
        const float* cre = F.in[6] + (size_t)j * S5_GROUPS * 1024; const float* cim = F.in[7] + (size_t)j * S5_GROUPS * 1024;
        bf16_t* AM = (bf16_t*)(F.ws + WS_S5TAB + (size_t)j * SZ_S5TAB + MIX_AM); bf16_t* W1 = (bf16_t*)(F.ws + WS_S5TAB + (size_t)j * SZ_S5TAB + MIX_W1);
        __syncthreads();
        const float* pre = (const float*)(F.ws + WS_S5PRE + ((size_t)j * S5_GROUPS + g) * S5PRE_STRIDE);
        { static_assert(NTHREADS == 512, "table staging: 9 + 2 + 2 loads per thread");
          float pv[9], cr[2], ci[2];
#pragma unroll
          for (int k = 0; k < 9; ++k) { const int e = F.tid + k * NTHREADS; pv[k] = pre[e < 4352 ? e : 0]; }
#pragma unroll
          for (int k = 0; k < 2; ++k) { const int e = F.tid + k * NTHREADS; cr[k] = cre[(size_t)g * 1024 + e]; ci[k] = cim[(size_t)g * 1024 + e]; }
#pragma unroll
          for (int k = 0; k < 9; ++k) { const int e = F.tid + k * NTHREADS; if (e < 4352) ap[e] = pv[k]; }
#pragma unroll
          for (int k = 0; k < 2; ++k) { const int e = F.tid + k * NTHREADS; cc[e * 2] = cr[k]; cc[e * 2 + 1] = ci[k]; } }
        __syncthreads();
        if (F.tid < 256) { const int tau = F.tid >> 4, ho = F.tid & 15; float sk[16];
#pragma unroll
            for (int hi = 0; hi < 16; ++hi) sk[hi] = 0.f;
            for (int p = 0; p < 64; ++p) { const float cr = cc[(ho * 64 + p) * 2], ci = cc[(ho * 64 + p) * 2 + 1], ar = ap[(tau * 64 + p) * 2], ai = ap[(tau * 64 + p) * 2 + 1];
                const float xr = cr * ar - ci * ai, xi = cr * ai + ci * ar; const LAS f32x4* bq = (const LAS f32x4*)(bb + p * 32);
#pragma unroll
                for (int q = 0; q < 8; ++q) { const f32x4 b2 = bq[q]; sk[2 * q] += xr * b2.x - xi * b2.y; sk[2 * q + 1] += xr * b2.z - xi * b2.w; } }
#pragma unroll
            for (int hi = 0; hi < 16; ++hi) kt[F.tid * 16 + hi] = sk[hi]; }
        __syncthreads();
        bf16_t* am = AM + (size_t)g * 256 * UXW;
        for (int e = F.tid; e < 256 * (UXW / 2); e += NTHREADS) { const int np = e / (UXW / 2), k = 2 * (e % (UXW / 2)), i = np >> 4, ho = np & 15; float v0, v1;
            if (k < 256) { const int jj = k >> 4, hi = k & 15; v0 = (jj <= i) ? kt[((i - jj) * 16 + ho) * 16 + hi] : 0.f; v1 = (jj <= i) ? kt[((i - jj) * 16 + ho) * 16 + hi + 1] : 0.f; }
            else { const int p = (k - 256) >> 1; const float cr = cc[(ho * 64 + p) * 2], ci = cc[(ho * 64 + p) * 2 + 1], ar = ap[((i + 1) * 64 + p) * 2], ai = ap[((i + 1) * 64 + p) * 2 + 1];
                v0 = cr * ar - ci * ai; v1 = -(cr * ai + ci * ar); }
            *(unsigned*)(am + (size_t)np * UXW + k) = pk2(v0, v1); }
        bf16_t* w1 = W1 + (size_t)g * 256 * 256;
        for (int e = F.tid; e < 256 * 128; e += NTHREADS) { const int np = e >> 7, k = 2 * (e & 127); float v[2] = {0.f, 0.f};
            if (np < 128) { const int p = np >> 1, comp = np & 1, jj = k >> 4;
#pragma unroll
                for (int t = 0; t < 2; ++t) { const int h = (k & 15) + t; const float ar = ap[((15 - jj) * 64 + p) * 2], ai = ap[((15 - jj) * 64 + p) * 2 + 1], br = bb[(p * 16 + h) * 2], bi = bb[(p * 16 + h) * 2 + 1];
                    v[t] = comp ? (ar * bi + ai * br) : (ar * br - ai * bi); } }
            *(unsigned*)(w1 + (size_t)np * 256 + k) = pk2(v[0], v[1]); }
    }
    __syncthreads();
}

constexpr int I_GLU = (D_MODEL / 64) * (2 * D_MODEL / 32), I_IN = (D_MODEL / 64) * (NIN_PAD / 32), I_O = (D_MODEL / 64) * (D_MODEL / 32), I_GU = (D_MODEL / 64) * (2 * D_FF / 32), I_DN = (D_FF / 64) * (D_MODEL / 32);
__device__ __forceinline__ int ti_layer_items(int layer) { return ((layer & 1) ? I_IN + I_O : I_GLU) + I_GU + I_DN; }
__device__ __forceinline__ TItem ti_decode_layer(const Frame& F, int layer, int r) {
    const int j = layer >> 1; TItem T;
    if ((layer & 1) == 0) { if (r < I_GLU) { T = TItem{F.in[9] + (size_t)j * D_MODEL * 2 * D_MODEL, nullptr, (bf16_t*)(F.ws + WS_WGLU + j * SZ_WGLU), D_MODEL, 2 * D_MODEL, D_MODEL, 2 * D_MODEL, 1, r}; return T; } r -= I_GLU; }
    else { if (r < I_IN) { T = TItem{F.in[10] + (size_t)j * D_MODEL * DSA_PROJ, F.in[16] + (size_t)(2 * j + 1) * D_MODEL, (bf16_t*)(F.ws + WS_WIN + j * SZ_WIN), D_MODEL, DSA_PROJ, 0, NIN_PAD, 2, r}; return T; } r -= I_IN;
           if (r < I_O) { T = TItem{F.in[13] + (size_t)j * D_MODEL * D_MODEL, nullptr, (bf16_t*)(F.ws + WS_WO + j * SZ_WO), D_MODEL, D_MODEL, 0, D_MODEL, 0, r}; return T; } r -= I_O; }
    if (r < I_GU) { T = TItem{F.in[14] + (size_t)layer * D_MODEL * 2 * D_FF, F.in[17] + (size_t)layer * D_MODEL, (bf16_t*)(F.ws + WS_WGU + layer * SZ_WGU), D_MODEL, 2 * D_FF, D_FF, 2 * D_FF, 1, r}; return T; } r -= I_GU;
    T = TItem{F.in[15] + (size_t)layer * D_FF * D_MODEL, nullptr, (bf16_t*)(F.ws + WS_WDN + layer * SZ_WDN), D_FF, D_MODEL, 0, D_MODEL, 0, r}; return T;
}
template <class ItemFn> __device__ __forceinline__ void convert_run(Frame& F, int layer, ItemFn item) {
    LAS float* scr = (LAS float*)(F.lds + 32768 + F.wave * 8704);
    const int nitems = ti_layer_items(layer);
    int it = item(0);
    if (it >= nitems) return;
    TItem cur = ti_decode_layer(F, layer, it); float v[32]; f32x4 g[2]; ti_load(cur, v, g, F.lane);
    for (int k = 1; ; ++k) {
        const int nit = item(k); const bool more = nit < nitems; TItem nxt = cur; float vn[32]; f32x4 gn[2];
        if (more) { nxt = ti_decode_layer(F, layer, nit); ti_load(nxt, vn, gn, F.lane); }
        ti_finish(cur, v, g, scr, F.lane);
        if (!more) break;
        cur = nxt; g[0] = gn[0]; g[1] = gn[1];
#pragma unroll
        for (int i = 0; i < 32; ++i) v[i] = vn[i];
    }
}
constexpr int CW_RATIO = 2;
__device__ __forceinline__ int cw_item(int k, bool busy, int w, int NBW, int BW) { const int P = CW_RATIO * NBW + BW; return busy ? k * P + CW_RATIO * NBW + w : (k / CW_RATIO) * P + (k % CW_RATIO) * NBW + w; }
__device__ __forceinline__ void convert_weights(Frame& F0) {
    Frame F = F0; F.lane = LANE_ID(); F.tid = F0.wave * 64 + F.lane;
    const int nbusy = N_S5 * S5_GROUPS < F.G ? N_S5 * S5_GROUPS : F.G, bx = (int)blockIdx.x;
    const bool busy = bx < nbusy; const int NBW = (F.G - nbusy) * NWAVES, BW = nbusy * NWAVES, w = busy ? bx * NWAVES + F.wave : (bx - nbusy) * NWAVES + F.wave;
    convert_run(F, 0, [&](int k) { return cw_item(k, busy, w, NBW, BW); });
}
__device__ __forceinline__ void convert_next_layer(Frame& F0, int layer) {
    Frame F = F0; F.lane = LANE_ID(); F.tid = F0.wave * 64 + F.lane;
    const int ntl = (SEQ / 256) * (2 * D_FF / 256), rem = ntl % F.G, bx = (int)blockIdx.x;
    WAIT_VM0(); __syncthreads();
    if (rem == 0 || bx >= rem) { const int rank = rem == 0 ? bx : bx - rem, cnt = rem == 0 ? F.G : F.G - rem; const int w0 = rank * NWAVES + F.wave, st = cnt * NWAVES;
        convert_run(F, layer, [&](int k) { return w0 + k * st; }); }
    __syncthreads();
}
__device__ __forceinline__ void prologue_rows(Frame& F0) {
    Frame F = F0; F.lane = LANE_ID(); F.tid = F0.wave * 64 + F.lane;
    const int gw = F.vcu * NWAVES + F.wave, NGW = F.G * NWAVES;
    u64* rowss0 = (u64*)(F.ws + WS_ROWSS); float* rope = (float*)(F.ws + WS_ROPE); bf16_t* XB = (bf16_t*)(F.ws + WS_XB);
    const float inv_freq = powf(10000.0f, -(float)(2 * (F.lane & 31)) / 64.0f);
    static_assert(D_MODEL % 256 == 0 && D_MODEL / 256 <= 4, "row chunks per lane");
    constexpr int NCK = D_MODEL / 256; f32x4 xv[NCK], xn[NCK];
    if (gw < SEQ) {
#pragma unroll
        for (int k = 0; k < NCK; ++k) xv[k] = *(const f32x4*)(F.in[0] + (size_t)gw * D_MODEL + F.lane * 4 + 256 * k); }
    for (int m = gw; m < SEQ; m += NGW) {
        float s = 0.f;
        if (m + NGW < SEQ) {
#pragma unroll
            for (int k = 0; k < NCK; ++k) xn[k] = *(const f32x4*)(F.in[0] + (size_t)(m + NGW) * D_MODEL + F.lane * 4 + 256 * k); }
#pragma unroll
        for (int k = 0; k < NCK; ++k) { const f32x4 v = xv[k]; s += (v.x * v.x + v.y * v.y) + (v.z * v.z + v.w * v.w);
            u32x2 w; w.x = pk2(v.x, v.y); w.y = pk2(v.z, v.w); *(u32x2*)(XB + (size_t)m * D_MODEL + F.lane * 4 + 256 * k) = w; }
#pragma unroll
        for (int k = 0; k < NCK; ++k) xv[k] = xn[k];
        s = wave_sum(s); if (F.lane == 0) rowss0[m] = (u64)(s * SS_FIX);
        if (F.lane < 32) { const float ang = (float)m * inv_freq;
            const double ad = (double)ang, nq = rint(ad * 0.63661977236758134308); const float r = (float)fma(-nq, 1.57079632679489661923, ad), r2 = r * r; const int qd = (int)nq & 3;
            const float sn = r + r * r2 * (-1.6666667163e-1f + r2 * (8.3333337680e-3f + r2 * (-1.9841270114e-4f + r2 * 2.7557314297e-6f)));
            const float cs = 1.0f + r2 * (-0.5f + r2 * (4.1666667908e-2f + r2 * (-1.3888889225e-3f + r2 * (2.4801587642e-5f + r2 * -2.7557314297e-7f))));
            const float c1 = (qd & 1) ? sn : cs, s1 = (qd & 1) ? cs : sn;
            rope[(size_t)m * 64 + F.lane] = (qd == 1 || qd == 2) ? -c1 : c1; rope[(size_t)m * 64 + 32 + F.lane] = (qd >= 2) ? -s1 : s1; }
    }
}

__device__ __forceinline__ void s5_build_ux(Frame& F0, const bf16_t* x, const u64* rowss, const float* gain) {
    Frame F = F0; F.lane = LANE_ID(); F.tid = F0.wave * 64 + F.lane;
    bf16_t* UX = (bf16_t*)(F.ws + WS_R + R_UX);
    const int gw = F.vcu * NWAVES + F.wave, NGW = F.G * NWAVES; const int j = F.lane >> 2, p = F.lane & 3;
    constexpr int NIT = NCH * (S5_GROUPS / 4);
    u32x4 xa, xc, na, nc; f32x4 gg[4], ng[4]; u64 ssq = 0, nss = 0;
#define BUX_LOAD(it_, A_, C_, G_, S_) do { const int c_ = (it_) / (S5_GROUPS / 4), gq_ = (it_) % (S5_GROUPS / 4), g_ = 4 * gq_ + p, t_ = 16 * c_ + j; const bf16_t* xr_ = x + (size_t)t_ * D_MODEL + 16 * g_; \
        A_ = *(const u32x4*)xr_; C_ = *(const u32x4*)(xr_ + 8); S_ = rowss[t_]; _Pragma("unroll") for (int q = 0; q < 4; ++q) G_[q] = *(const f32x4*)(gain + 16 * g_ + 4 * q); } while (0)
    if (gw < NIT) BUX_LOAD(gw, xa, xc, gg, ssq);
    for (int it = gw; it < NIT; it += NGW) { const int c = it / (S5_GROUPS / 4), gq = it % (S5_GROUPS / 4), g = 4 * gq + p;
        if (it + NGW < NIT) BUX_LOAD(it + NGW, na, nc, ng, nss);
        const float rs = rs_of(ssq); float v[16];
        const unsigned xw[8] = {xa.x, xa.y, xa.z, xa.w, xc.x, xc.y, xc.z, xc.w};
#pragma unroll
        for (int q = 0; q < 4; ++q) { v[4 * q] = bflo(xw[2 * q]) * rs * gg[q].x; v[4 * q + 1] = bfhi(xw[2 * q]) * rs * gg[q].y; v[4 * q + 2] = bflo(xw[2 * q + 1]) * rs * gg[q].z; v[4 * q + 3] = bfhi(xw[2 * q + 1]) * rs * gg[q].w; }
        bf16_t* dst = UX + ((size_t)g * NCH + c) * UXW + 16 * j;
        u32x4 w; w.x = pk2(v[0], v[1]); w.y = pk2(v[2], v[3]); w.z = pk2(v[4], v[5]); w.w = pk2(v[6], v[7]); *(u32x4*)dst = w;
        w.x = pk2(v[8], v[9]); w.y = pk2(v[10], v[11]); w.z = pk2(v[12], v[13]); w.w = pk2(v[14], v[15]); *(u32x4*)(dst + 8) = w;
        xa = na; xc = nc; ssq = nss;
#pragma unroll
        for (int q = 0; q < 4; ++q) gg[q] = ng[q]; }
#undef BUX_LOAD
}
__device__ __forceinline__ void s5_scan(Frame& F0, int j) {
    Frame F = F0; F.lane = LANE_ID(); F.tid = F0.wave * 64 + F.lane;
    bf16_t* UX = (bf16_t*)(F.ws + WS_R + R_UX); const bf16_t* S = (const bf16_t*)(F.ws + WS_R + R_S);
    constexpr int SPI = NTHREADS / NSEG, IPG = 64 / SPI;
    LAS float* E = (LAS float*)F.lds;
    const int pl = F.tid % SPI, seg = F.tid / SPI;
    for (int b = F.vcu; b < S5_GROUPS * IPG; b += F.G) { const int g = b / IPG, p = (b % IPG) * SPI + pl;
        __syncthreads();
        const f32x4 av = *(const f32x4*)((const float*)(F.ws + WS_S5PRE + ((size_t)j * S5_GROUPS + g) * S5PRE_STRIDE) + 4352 + p * 4); const float ar = av.x, ai = av.y, sr = av.z, si = av.w;
        const bf16_t* sp = S + ((size_t)g * NCH + (size_t)seg * SEGL) * 128 + 2 * p; float xr = 0.f, xi = 0.f;
        unsigned sv[SEGL];
#pragma unroll
        for (int c = 0; c < SEGL; ++c) sv[c] = *(const unsigned*)(sp + (size_t)c * 128);
#pragma unroll
        for (int c = 0; c < SEGL; ++c) { const float br = bflo(sv[c]), bi = bfhi(sv[c]); const float nr = ar * xr - ai * xi + br, ni = ar * xi + ai * xr + bi; xr = nr; xi = ni; }
        E[(seg * SPI + pl) * 2] = xr; E[(seg * SPI + pl) * 2 + 1] = xi;
        __syncthreads();
        xr = 0.f; xi = 0.f;
        for (int s = 0; s < seg; ++s) { const float er = E[(s * SPI + pl) * 2], ei = E[(s * SPI + pl) * 2 + 1]; const float nr = sr * xr - si * xi + er, ni = sr * xi + si * xr + ei; xr = nr; xi = ni; }
        bf16_t* up = UX + ((size_t)g * NCH + (size_t)seg * SEGL) * UXW + 256 + 2 * p;
#pragma unroll
        for (int c = 0; c < SEGL; ++c) { *(unsigned*)(up + (size_t)c * UXW) = pk2(xr, xi); const float br = bflo(sv[c]), bi = bfhi(sv[c]); const float nr = ar * xr - ai * xi + br, ni = ar * xi + ai * xr + bi; xr = nr; xi = ni; }
    }
    __syncthreads();
}

__device__ __forceinline__ void idx_kload(bf16x8 (&ka)[2][4], const bf16_t* KI, int k0, int lane) {
    const bf16_t* kp = KI + (size_t)(k0 + (lane & 31)) * 64 + 8 * (lane >> 5);
#pragma unroll
    for (int t = 0; t < 2; ++t)
#pragma unroll
        for (int ks = 0; ks < 4; ++ks) ka[t][ks] = *(const bf16x8*)(kp + (size_t)t * 32 * 64 + 16 * ks);
}
struct QAddr { int e[4], o[4], l[4]; };
constexpr int QLIN_OFF = 135168;
#ifdef EMU
#define QBASE(qt) 0
#define QPTR(qt, off) ((const LAS bf16x8*)((qt) + (off)))
#else
#define QBASE(qt) ((int)(unsigned)(size_t)(qt))
#define QPTR(qt, off) ((const LAS bf16x8*)(size_t)(unsigned)(off))
#endif
__device__ __forceinline__ QAddr idx_qaddr(int lane, const LAS unsigned char* qt) { QAddr A; const int ql = lane & 31, hi = lane >> 5, s3 = (ql >> 3) & 1, qb = QBASE(qt);
#pragma unroll
    for (int ks = 0; ks < 4; ++ks) { const int lo = qb + ql * 1024 + (((2 * ks + hi) ^ (ql & 7)) * 16); A.e[ks] = opaque(lo + (s3 ? 128 : 0)); A.o[ks] = opaque(lo - (s3 ? 128 : 0)); A.l[ks] = opaque(qb + QLIN_OFF - 65536 + ql * 128 + (((2 * ks + hi) ^ (ql & 7)) * 16)); }
    return A; }
__device__ __forceinline__ void idx_qload(bf16x8 (&qf)[4], const LAS unsigned char* qt, const QAddr& A, int h) {
#pragma unroll
    for (int ks = 0; ks < 4; ++ks) qf[ks] = (h == 8) ? *QPTR(qt, A.l[ks]) : *QPTR(qt, ((h & 1) ? A.o[ks] : A.e[ks]) + 128 * h);
}
__device__ __forceinline__ void idx_mma(f32x16& d0, f32x16& d1, const bf16x8 (&ka)[2][4], const bf16x8 (&qf)[4]) {
#pragma unroll
    for (int r = 0; r < 16; ++r) { d0[r] = 0.f; d1[r] = 0.f; }
#pragma unroll
    for (int ks = 0; ks < 4; ++ks) { d0 = MFMA32(ka[0][ks], qf[ks], d0); d1 = MFMA32(ka[1][ks], qf[ks], d1); }
}
#ifdef EMU
#define MFMA_SETTLE(x, y)
#define FMA_ABS(s, d, w) (s) = fmaf(fabsf(d), (w), (s))
#else
#define MFMA_SETTLE(x, y) asm volatile("s_nop 11" : "+v"(x), "+v"(y))
#define FMA_ABS(s, d, w) asm("v_fma_f32 %0, |%1|, %2, %0" : "+v"(s) : "v"(d), "v"(w))
#endif
__device__ __forceinline__ void idx_acc(f32x16& S, const f32x16& D, const float hw) {
#pragma unroll
    for (int i = 0; i < 16; ++i) { float t = S[i]; const float d = D[i]; FMA_ABS(t, d, hw); S[i] = t; }
}
template <bool MMA, bool ACC, bool LOAD>
__device__ __forceinline__ void idx_step(f32x16& n0, f32x16& n1, const bf16x8 (&ka)[2][4], const bf16x8 (&qf)[4], f32x16& s0, f32x16& s1, const f32x16& p0, const f32x16& p1, const float w,
                                         bf16x8 (&ql)[4], const LAS unsigned char* qt, const QAddr& A, const int hl) {
    const f32x16 z = {0.f, 0.f, 0.f, 0.f, 0.f, 0.f, 0.f, 0.f, 0.f, 0.f, 0.f, 0.f, 0.f, 0.f, 0.f, 0.f};
#pragma unroll
    for (int i = 0; i < 8; ++i) { const int ks = i & 3;
        if (MMA) { if (i < 4) n0 = MFMA32(ka[0][ks], qf[ks], ks == 0 ? z : n0); else n1 = MFMA32(ka[1][ks], qf[ks], ks == 0 ? z : n1); }
        if (ACC) {
#pragma unroll
            for (int e = 0; e < 4; ++e) { const int r = 4 * ks + e; if (i < 4) { float t = s0[r]; const float d = p0[r]; FMA_ABS(t, d, w); s0[r] = t; } else { float t = s1[r]; const float d = p1[r]; FMA_ABS(t, d, w); s1[r] = t; } } }
        if (LOAD && i < 4) ql[i] = (hl == 8) ? *QPTR(qt, A.l[i]) : *QPTR(qt, ((hl & 1) ? A.o[i] : A.e[i]) + 128 * hl);
        SCHED_BAR();
    }
}
template <int MODE = 0>
__device__ __forceinline__ void idx_scores2(f32x16& s0, f32x16& s1, const LAS unsigned char* qt, const QAddr& A, const float (&hw)[8], const bf16x8 (&ka)[2][4]) {
    constexpr bool M = MODE != 3, C = MODE != 2;
    bf16x8 qx[4], qy[4]; f32x16 a0, a1, b0, b1;
    if (MODE == 3) {
#pragma unroll
        for (int r = 0; r < 16; ++r) { a0[r] = 0.f; a1[r] = 0.f; b0[r] = 0.f; b1[r] = 0.f; s0[r] = 0.f; s1[r] = 0.f; }
        PIN16(a0); PIN16(a1); PIN16(b0); PIN16(b1); }
    idx_qload(qx, qt, A, 0); idx_qload(qy, qt, A, 8); SCHED_BAR();
    idx_step<M, false, false>(a0, a1, ka, qx, s0, s1, a0, a1, 0.f, qx, qt, A, 0);
    if (MODE == 2) { PIN16(a0); PIN16(a1); }
    idx_step<M, false, M>(s0, s1, ka, qy, s0, s1, a0, a1, 0.f, qx, qt, A, 1);
    idx_step<M, C, M>(b0, b1, ka, qx, s0, s1, a0, a1, hw[0], qy, qt, A, 2);
    if (MODE == 2) { PIN16(b0); PIN16(b1); }
    idx_step<M, C, M>(a0, a1, ka, qy, s0, s1, b0, b1, hw[1], qx, qt, A, 3);
    if (MODE == 2) { PIN16(a0); PIN16(a1); }
    idx_step<M, C, M>(b0, b1, ka, qx, s0, s1, a0, a1, hw[2], qy, qt, A, 4);
    if (MODE == 2) { PIN16(b0); PIN16(b1); }
    idx_step<M, C, M>(a0, a1, ka, qy, s0, s1, b0, b1, hw[3], qx, qt, A, 5);
    if (MODE == 2) { PIN16(a0); PIN16(a1); }
    idx_step<M, C, M>(b0, b1, ka, qx, s0, s1, a0, a1, hw[4], qy, qt, A, 6);
    if (MODE == 2) { PIN16(b0); PIN16(b1); }
    idx_step<M, C, M>(a0, a1, ka, qy, s0, s1, b0, b1, hw[5], qx, qt, A, 7);
    if (MODE == 2) { PIN16(a0); PIN16(a1); }
    idx_step<M, C, false>(b0, b1, ka, qx, s0, s1, a0, a1, hw[6], qy, qt, A, 0);
    if (MODE == 2) { PIN16(b0); PIN16(b1); }
    idx_step<false, C, false>(b0, b1, ka, qx, s0, s1, b0, b1, hw[7], qy, qt, A, 0);
}
__device__ __forceinline__ float score_u(float s, float inv32) { return __builtin_fmaf(s, inv32, (float)(NB / 2) + BIN_MAGIC); }
#ifdef EMU
#define HIST_ADD(hq, hadj, m) LDS_ATOMIC_ADD((hq) + (__float_as_uint(m) - 0x4B000000u), 1u)
#else
#if PROBE_DUP == 4
#define HIST_ADD(hq, hadj, m) do { LDS_ATOMIC_ADD((LAS unsigned*)(size_t)((__float_as_uint(m) << 2) + (hadj)), 1u); LDS_ATOMIC_ADD((LAS unsigned*)(size_t)((__float_as_uint(m) << 2) + (hadj)), (unsigned)opaque(0)); } while (0)
#else
#define HIST_ADD(hq, hadj, m) LDS_ATOMIC_ADD((LAS unsigned*)(size_t)((__float_as_uint(m) << 2) + (hadj)), 1u)
#endif
#endif

template <int PASS> __device__ __forceinline__ void idx_pass(Frame& F0, int un, LAS unsigned* hist, LAS int* qinfo) {
    Frame F = F0; F.lane = LANE_ID(); F.tid = F0.wave * 64 + F.lane;
    const bf16_t* KI = (const bf16_t*)(F.ws + WS_MIX + MIX_KI); const float* WI = (const float*)(F.ws + WS_MIX + MIX_WI);
    const int lane = F.lane, ql = lane & 31, hi = lane >> 5, q = 32 * un + ql, ntiles = un + 1, npairs = (ntiles + 1) >> 1;
    const LAS unsigned char* qt = F.lds + 65536;
    float hwp[8];
#pragma unroll
    for (int h = 0; h < 8; ++h) hwp[h] = 0.5f * WI[(size_t)q * 8 + h];
    const int bstar = PASS == 2 ? qinfo[ql * 4] : 0; const float inv32 = __builtin_bit_cast(float, qinfo[ql * 4 + 3]) * BIN_SCALE;
    const float thr_hi = bstar < 0 ? -__builtin_inff() : (bstar >= NB - 1 ? __builtin_inff() : BIN_MAGIC + (float)bstar);
    const float thr_lo = bstar <= 0 ? -__builtin_inff() : BIN_MAGIC + (float)bstar;
    const float cpos = (float)(NB / 2) + 0.5f - (float)bstar;
    LAS unsigned* cand = (LAS unsigned*)(F.lds + 98304) + (ql * 16 + F.wave * 2 + hi) * 16; int mycnt = 0;
    const float cmax = __builtin_bit_cast(float, opaque_s(__builtin_bit_cast(int, BIN_MAGIC + (float)(NB - 1))));
    LAS unsigned* hq = hist + ql * NB; const unsigned hadj = (unsigned)(size_t)hq - (0x4B000000u << 2); (void)hadj; (void)hq;
    const QAddr QA = idx_qaddr(lane, qt);
    bf16x8 ka[2][4];
    if (F.wave < npairs) idx_kload(ka, KI, 64 * F.wave, lane);
    for (int kp = F.wave; kp < npairs; kp += NWAVES) {
        const bool more = kp + NWAVES < npairs;
        f32x16 sc0, sc1; idx_scores2(sc0, sc1, qt, QA, hwp, ka);
        PIN16(sc0); PIN16(sc1);
#if PROBE_DUP >= 1 && PROBE_DUP <= 3
        { f32x16 t0, t1; idx_scores2<PROBE_DUP == 1 ? 0 : PROBE_DUP>(t0, t1, qt, QA, hwp, ka); PIN16(t0); PIN16(t1); }
#endif
        if (more) idx_kload(ka, KI, 64 * (kp + NWAVES), lane);
        const bool full = (2 * kp + 1 < ntiles - 1);
#pragma unroll
        for (int t = 0; t < 2; ++t) { const int kt = 2 * kp + t;
            if (PASS == 1) {
                if (full) {
#pragma unroll
                    for (int r = 0; r < 16; ++r) { const float m = MED3F(score_u(t ? sc1[r] : sc0[r], inv32), BIN_MAGIC, cmax); HIST_ADD(hq, hadj, m); }
                } else {
#pragma unroll
                    for (int r = 0; r < 16; ++r) { const int key = 32 * kt + crow(r, hi); const float m = MED3F(score_u(t ? sc1[r] : sc0[r], inv32), BIN_MAGIC, cmax);
                        if (key <= q) HIST_ADD(hq, hadj, m); }
                }
            } else if (kt < ntiles) {
                unsigned mlo = 0u, mhi = 0u;
#pragma unroll
                for (int r = 0; r < 16; ++r) { const int key = 32 * kt + crow(r, hi); const float sv = t ? sc1[r] : sc0[r]; float u = score_u(sv, inv32);
                    if (!full) u = key <= q ? u : __builtin_nanf("");
                    const u64 above = BALLOT64(u > thr_hi); WRITELANE64(mlo, mhi, above, r);
                    const u64 cm = BALLOT64(u >= thr_lo) & ~above;
                    if (cm != 0ull) { if (u >= thr_lo && !(u > thr_hi)) { if (mycnt < 16) { const float fr_ = MED3F(__builtin_fmaf(sv, inv32, cpos) * 262144.0f, 0.f, 262143.0f); cand[mycnt] = ((unsigned)fr_ << 14) | (unsigned)(16383 - key); } ++mycnt; } } }
                if (lane < 16) { u32x2 w; w.x = mlo; w.y = mhi; ((LAS u32x2*)hist)[kt * 16 + lane] = w; }
            }
        }
    }
    if (PASS == 2) ((LAS int*)(F.lds + RING_BYTES + 2048))[ql * 16 + F.wave * 2 + hi] = mycnt < 16 ? mycnt : 16;
}
__device__ __forceinline__ void indexer_unit(Frame& F0, int un) {
    Frame F = F0; F.lane = LANE_ID(); F.tid = F0.wave * 64 + F.lane;
    const bf16_t* QI = (const bf16_t*)(F.ws + WS_MIX + MIX_QI); const bf16_t* KI = (const bf16_t*)(F.ws + WS_MIX + MIX_KI); const float* WI = (const float*)(F.ws + WS_MIX + MIX_WI);
    unsigned* M32 = (unsigned*)(F.ws + WS_MASK);
    LAS unsigned* hist = (LAS unsigned*)F.lds; LAS int* qinfo = (LAS int*)(F.lds + RING_BYTES); LAS int* ccnt = (LAS int*)(F.lds + RING_BYTES + 2048);
    LAS float* nrm = (LAS float*)(F.lds + 98304);
    const int lane = F.lane, q0 = 32 * un;
    __syncthreads();
    { const unsigned zz = (unsigned)opaque(0); const u32x4 z4 = (u32x4){zz, zz, zz, zz};
      for (int e = F.tid; e < 32 * NB / 4; e += NTHREADS) ((LAS u32x4*)hist)[e] = z4; }
    if (F.tid < 128) qinfo[F.tid] = 0;
    { static_assert(32 * 64 == 4 * NTHREADS, "four Q~ chunks per thread");
      u32x4 qv[4];
#pragma unroll
      for (int k = 0; k < 4; ++k) { const int e = F.tid + k * NTHREADS, row = e >> 6, c = e & 63; qv[k] = *(const u32x4*)(QI + (size_t)(q0 + row) * 512 + 8 * c); }
#pragma unroll
      for (int k = 0; k < 4; ++k) { const int e = F.tid + k * NTHREADS, row = e >> 6, c = e & 63; *(LAS u32x4*)(F.lds + 65536 + row * 1024 + ((c ^ (row & 15)) * 16)) = qv[k]; } }
    if (F.tid < 256) { const int row = F.tid & 31, h = F.tid >> 5; const bf16_t* qr = QI + (size_t)(q0 + row) * 512 + h * 64; float ss = 0.f;
        for (int e = 0; e < 64; e += 8) { const u32x4 a = *(const u32x4*)(qr + e); ss += bflo(a.x) * bflo(a.x) + bfhi(a.x) * bfhi(a.x) + bflo(a.y) * bflo(a.y) + bfhi(a.y) * bfhi(a.y) + bflo(a.z) * bflo(a.z) + bfhi(a.z) * bfhi(a.z) + bflo(a.w) * bflo(a.w) + bfhi(a.w) * bfhi(a.w); }
        const float w = WI[(size_t)(q0 + row) * 8 + h]; nrm[row * 8 + h] = w * w * ss; }
    { const int row = F.tid & 31, d4 = (F.tid >> 5) * 4; float a0 = 0.f, a1 = 0.f, a2 = 0.f, a3 = 0.f;
#pragma unroll
      for (int h = 0; h < 8; ++h) { const float w = 0.5f * WI[(size_t)(q0 + row) * 8 + h]; const u32x2 v = *(const u32x2*)(QI + (size_t)(q0 + row) * 512 + h * 64 + d4);
          a0 += w * bflo(v.x); a1 += w * bfhi(v.x); a2 += w * bflo(v.y); a3 += w * bfhi(v.y); }
      u32x2 o; o.x = pk2(a0, a1); o.y = pk2(a2, a3); *(LAS u32x2*)(F.lds + QLIN_OFF + row * 128 + (((d4 >> 3) ^ (row & 7)) * 16) + (d4 & 7) * 2) = o; }
    __syncthreads();
    if (F.tid < 32) { float a = 0.f;
#pragma unroll
        for (int h = 0; h < 8; ++h) a += nrm[F.tid * 8 + h];
        const float inv = a > 1e-30f ? RSQF(0.5f * a) : 1.0f; qinfo[F.tid * 4 + 3] = __builtin_bit_cast(int, inv); }
    __syncthreads();
    idx_pass<1>(F, un, hist, qinfo);
    __syncthreads();
    for (int i = 0; i < 4; ++i) { const int qq = 4 * F.wave + i; const int n = q0 + qq + 1;
        unsigned cnt[8]; unsigned tot = 0;
#pragma unroll
        for (int e = 0; e < 2; ++e) { const u32x4 w = ((const LAS u32x4*)(hist + qq * NB + lane * 8))[e]; cnt[4 * e] = w.x; cnt[4 * e + 1] = w.y; cnt[4 * e + 2] = w.z; cnt[4 * e + 3] = w.w; tot += w.x + w.y + w.z + w.w; }
        unsigned v = tot;
#pragma unroll
        for (int o = 1; o < 64; o <<= 1) { const unsigned t = SHFL_IDX_U(v, (lane + o) & 63); if (lane + o < 64) v += t; }
        const unsigned above = v - tot;
        if (n > TOPK) { const bool mine = (above < (unsigned)TOPK) && (above + tot >= (unsigned)TOPK);
            if (mine) { unsigned a = above, abest = above; int bb = 7; bool found = false;
#pragma unroll
                for (int t = 7; t >= 0; --t) { const bool hit = !found && (a + cnt[t] >= (unsigned)TOPK); if (hit) { bb = t; abest = a; found = true; } a += cnt[t]; }
                qinfo[qq * 4] = lane * 8 + bb; qinfo[qq * 4 + 1] = TOPK - (int)abest; }
        } else if (lane == 0) { qinfo[qq * 4] = opaque(-1); qinfo[qq * 4 + 1] = opaque(0); }
    }
    __syncthreads();
    idx_pass<2>(F, un, hist, qinfo);
    __syncthreads();
    LAS unsigned* cand = (LAS unsigned*)(F.lds + 98304);
    for (int i = 0; i < 4; ++i) { const int qq = 4 * F.wave + i; const int rneed = qinfo[qq * 4 + 1];
        if (rneed <= 0) continue;
#pragma unroll
        for (int k = 0; k < 4; ++k) { const int sl = lane + 64 * k;
            if ((sl & 15) < ccnt[qq * 16 + (sl >> 4)]) { const unsigned me = cand[qq * 256 + sl]; int rank = 0;
                for (int sb = 0; sb < 16; ++sb) { const int c2 = ccnt[qq * 16 + sb];
                    for (int p2 = 0; p2 < c2; ++p2) rank += (cand[qq * 256 + sb * 16 + p2] > me) ? 1 : 0; }
                if (rank < rneed) { const unsigned key = 16383u - (me & 16383u); const int kk = key & 31, h2 = (kk >> 2) & 1, r = (kk & 3) + 4 * (kk >> 3); LDS_ATOMIC_OR(hist + (key >> 5) * 32 + r * 2 + h2, 1u << qq); } } }
    }
    __syncthreads();
    const int ktz = 8 * (un >> 3) + 8;
    for (int e = F.tid; e < ktz * 8; e += NTHREADS) { const int kt = e >> 3; const unsigned zz = 0u;
        *(u32x4*)(M32 + ((size_t)kt * (SEQ / 32) + un) * 32 + 4 * (e & 7)) = kt <= un ? ((const LAS u32x4*)hist)[e] : (u32x4){zz, zz, zz, zz}; }
}
__device__ __forceinline__ void indexer_phase(Frame& F) {
    constexpr int NU = SEQ / 32;
    for (int p = F.vcu; p < NU / 2; p += F.G) { indexer_unit(F, p); indexer_unit(F, NU - 1 - p); }
    __syncthreads();
}

#ifdef EMU
#define A2_DMA(gsrc, ldsoff) emu_glds16((const void*)(gsrc), (void*)(F.lds + (ldsoff)))
#define A2_WAIT_BAR(N) emu::block_barrier()
#define A2_SBAR()
#define A2_PIN(x)
#define A2_CVTPK(lo, hi) pk2(lo, hi)
struct a2_m8 { u64 v[8]; u64 operator[](int i) const { return v[i]; } };
static inline a2_m8 a2_sload8(const u64* p) { a2_m8 r; for (int i = 0; i < 8; ++i) r.v[i] = p[i]; return r; }
#define A2_SWAIT4(a, b, c, d)
#else
typedef unsigned long long a2_m8 __attribute__((ext_vector_type(8)));
__device__ __forceinline__ a2_m8 a2_sload8(const u64* p) { a2_m8 r; asm volatile("s_load_dwordx16 %0, %1, 0x0 glc" : "=s"(r) : "s"(p)); return r; }
#define A2_SWAIT4(a, b, c, d) asm volatile("s_waitcnt lgkmcnt(0)" : "+s"(a), "+s"(b), "+s"(c), "+s"(d))
__device__ __forceinline__ void a2_glds16(const void* gsrc, unsigned lds_dst) { unsigned keep;
    asm volatile("s_mov_b32 %0, m0\n\ts_mov_b32 m0, %2\n\ts_nop 0\n\tglobal_load_lds_dwordx4 %1, off\n\ts_mov_b32 m0, %0" : "=&s"(keep) : "v"(gsrc), "s"(lds_dst) : "memory"); }
typedef __bf16 a2_bf16x2 __attribute__((ext_vector_type(2)));
__device__ __forceinline__ unsigned a2_cvtpk(float lo, float hi) { f32x2 v = {lo, hi}; a2_bf16x2 b = __builtin_convertvector(v, a2_bf16x2); return __builtin_bit_cast(unsigned, b); }
#define A2_DMA(gsrc, ldsoff) a2_glds16((const void*)(gsrc), (unsigned)__builtin_amdgcn_readfirstlane((int)(lds0 + (unsigned)(ldsoff))))
#define A2_WAIT_BAR(N) asm volatile("s_waitcnt vmcnt(" #N ") lgkmcnt(0)\n\ts_barrier" ::: "memory")
#define A2_SBAR() __builtin_amdgcn_sched_barrier(0)
#define A2_PIN(x) asm volatile("" : "+v"(x))
#define A2_CVTPK(lo, hi) a2_cvtpk(lo, hi)
#endif
constexpr int A2_NSLOT = 3, A2_SLOTB = 8192, A2_K = 0, A2_V = A2_NSLOT * A2_SLOTB, A2_WS = 2 * A2_NSLOT * A2_SLOTB, A2_OST = A2_WS + 8 * 64 * 4, A2_BYTES = A2_OST + 8 * 4096;
static_assert(A2_BYTES <= RING_BYTES, "attention scratch fits the ring");
__device__ __forceinline__ void attn_unit2(Frame& F0, int h, int qb) {
    Frame F = F0; F.lane = LANE_ID(); F.tid = F0.wave * 64 + F.lane;
    bf16_t* Qg = (bf16_t*)(F.ws + WS_R + R_Q); const bf16_t* Kg = (const bf16_t*)(F.ws + WS_R + R_K); const bf16_t* Vg = (const bf16_t*)(F.ws + WS_R + R_V);
    const int lane = F.lane, r32 = lane & 31, hi = lane >> 5, wid = F.wave, q0 = qb * 256;
    const bf16_t* Qw = Qg + (size_t)(q0 + wid * 32) * D_MODEL + h * 64; const bf16_t* Kh = Kg + h * 64; const bf16_t* Vh = Vg + h * 64;
#ifndef EMU
    const unsigned lds0 = (unsigned)(uintptr_t)F.lds;
#endif
    LAS float* wsf = (LAS float*)(F.lds + A2_WS) + wid * 64;
    const bf16_t* ksrc = Kh + (size_t)lane * D_MODEL + wid * 8;
    const bf16_t* vsrc = Vh + (size_t)(16 * (wid & 3) + (lane >> 2)) * D_MODEL + (wid >> 2) * 32 + (lane & 3) * 8;
    const int kdst = A2_K + wid * 1024, vdst = A2_V + wid * 1024;
#define DMA_K(t, slot) A2_DMA(ksrc + (size_t)(t) * 64 * D_MODEL, kdst + (slot))
#define DMA_V(t, slot) A2_DMA(vsrc + (size_t)(t) * 64 * D_MODEL, vdst + (slot))
    const LAS unsigned char* kp0 = F.lds + A2_K + hi * 1024 + r32 * 16;
    const LAS unsigned char* vp0 = F.lds + A2_V + ((lane >> 4) & 1) * 32 + (lane & 3) * 8 + (4 * hi + ((lane & 15) >> 2)) * 64;
    const int NT = (q0 + 256) / 64;
    const u64* MW = (const u64*)(F.ws + WS_MASK) + (size_t)(8 * qb + wid) * 16; constexpr size_t MS = (size_t)(SEQ / 32) * 16;
    DMA_K(0, 0); DMA_V(0, 0); DMA_K(1, A2_SLOTB);
    bf16x8 qr[4];
#pragma unroll
    for (int d0 = 0; d0 < 4; ++d0) qr[d0] = *(const bf16x8*)(Qw + (size_t)r32 * D_MODEL + d0 * 16 + hi * 8);
    float l_reg = 0.f; f32x16 o[2]; f32x16 zero16;
#pragma unroll
    for (int r = 0; r < 16; ++r) { o[0][r] = 0.f; o[1][r] = 0.f; zero16[r] = 0.f; }
    f32x16 pA0, pA1, pB0, pB1; bf16x8 kf[8];
    int sl_prev = 0, sl_cur = 0, sl_next = A2_SLOTB;
#define ROT() do { sl_prev = sl_cur; sl_cur = sl_next; sl_next = (sl_next == (A2_NSLOT - 1) * A2_SLOTB) ? 0 : sl_next + A2_SLOTB; } while (0)
#define KLOAD2(kp, j) do { kf[2 * (j)] = *(const LAS bf16x8*)((kp) + (j) * 2048); kf[2 * (j) + 1] = *(const LAS bf16x8*)((kp) + (j) * 2048 + 512); } while (0)
    DMA_K(2, 2 * A2_SLOTB);
    A2_WAIT_BAR(3);
    { const LAS unsigned char* kb = kp0;
      KLOAD2(kb, 0); KLOAD2(kb, 1); KLOAD2(kb, 2); KLOAD2(kb, 3);
      pA0 = MFMA32(kf[0], qr[0], zero16); pA1 = MFMA32(kf[1], qr[0], zero16);
#pragma unroll
      for (int d0 = 1; d0 < 4; ++d0) { pA0 = MFMA32(kf[2 * d0], qr[d0], pA0); pA1 = MFMA32(kf[2 * d0 + 1], qr[d0], pA1); }
      a2_m8 m0 = a2_sload8(MW), m1 = a2_sload8(MW + 8), m2 = a2_sload8(MW + MS), m3 = a2_sload8(MW + MS + 8); A2_SWAIT4(m0, m1, m2, m3);
#pragma unroll
      for (int r = 0; r < 8; ++r) { pA0[r] = INVB(m0[r]) ? EXP2F(pA0[r]) : 0.f; pA0[8 + r] = INVB(m1[r]) ? EXP2F(pA0[8 + r]) : 0.f; pA1[r] = INVB(m2[r]) ? EXP2F(pA1[r]) : 0.f; pA1[8 + r] = INVB(m3[r]) ? EXP2F(pA1[8 + r]) : 0.f; } }
    A2_WAIT_BAR(0);
    DMA_K(3, 0); DMA_V(1, A2_SLOTB);
    ROT();
    { const LAS unsigned char* kb = kp0 + sl_cur; KLOAD2(kb, 0); KLOAD2(kb, 1); KLOAD2(kb, 2); KLOAD2(kb, 3); }
    A2_WAIT_BAR(2);
    s16x4 vlo[8], vhi[8]; u32x4 pw0, pw1, pw2, pw3;
#define PKW(P, B) A2_CVTPK(P[B], P[(B) + 1])
#define PAF(k) __builtin_bit_cast(bf16x8, pw##k)
#define VFR(i) (bf16x8){vlo[i][0], vlo[i][1], vlo[i][2], vlo[i][3], vhi[i][0], vhi[i][1], vhi[i][2], vhi[i][3]}
#define GAPA(MF, A0, A1, A2, A3, W0, W1, PW) do { MF; sacc += A0; sacc += A1; sacc += A2; sacc += A3; A2_PIN(sacc); W0; W1; A2_PIN(PW); A2_SBAR(); } while (0)
#define GAPB(MF, X, B, J, MK) do { MF; X[B] = INVB(MK[J]) ? EXP2F(X[B]) : 0.f; X[(B) + 1] = INVB(MK[(J) + 1]) ? EXP2F(X[(B) + 1]) : 0.f; X[(B) + 2] = INVB(MK[(J) + 2]) ? EXP2F(X[(B) + 2]) : 0.f; X[(B) + 3] = INVB(MK[(J) + 3]) ? EXP2F(X[(B) + 3]) : 0.f; A2_PIN(X); A2_SBAR(); } while (0)
#define VRD(i) do { vlo[i] = DS_TR16(vp_ + (((i) >> 2) * 4096 + ((i) & 3) * 1024)); vhi[i] = DS_TR16(vp_ + (((i) >> 2) * 4096 + ((i) & 3) * 1024 + 512)); } while (0)
#define KRD(G, j) do { if (G) { KLOAD2(kp0 + sl_next, j); A2_SBAR(); } } while (0)
#define STEP(C0, C1, P0, P1, t, GK, GV, GL) do { A2_SBAR(); \
    const LAS unsigned char* vp_ = vp0 + sl_prev; const u64* mka_ = MW + (size_t)(2 * (t)) * MS; const u64* mkb_ = mka_ + MS; \
    a2_m8 ma0_ = a2_sload8(mka_), ma1_ = a2_sload8(mka_ + 8), mb0_ = a2_sload8(mkb_), mb1_ = a2_sload8(mkb_ + 8); \
    VRD(0); A2_SBAR(); float sacc = (P0[0] + P0[1]); \
    GAPA(C0 = MFMA32(kf[0], qr[0], zero16), P0[2], P0[3], P0[4], P0[5],     pw0[0] = PKW(P0, 0), pw0[1] = PKW(P0, 2), pw0); \
    VRD(4); A2_SBAR(); GAPA(C1 = MFMA32(kf[1], qr[0], zero16), P0[6], P0[7], P0[8], P0[9],     pw0[2] = PKW(P0, 4), pw0[3] = PKW(P0, 6), pw0); \
    VRD(1); A2_SBAR(); GAPA(C0 = MFMA32(kf[2], qr[1], C0),   P0[10], P0[11], P0[12], P0[13], pw1[0] = PKW(P0, 8), pw1[1] = PKW(P0, 10), pw1); \
    VRD(5); A2_SBAR(); GAPA(C1 = MFMA32(kf[3], qr[1], C1),   P0[14], P0[15], P1[0], P1[1],   pw1[2] = PKW(P0, 12), pw1[3] = PKW(P0, 14), pw1); \
    VRD(2); A2_SBAR(); GAPA(C0 = MFMA32(kf[4], qr[2], C0),   P1[2], P1[3], P1[4], P1[5],     pw2[0] = PKW(P1, 0), pw2[1] = PKW(P1, 2), pw2); \
    VRD(6); A2_SBAR(); GAPA(C1 = MFMA32(kf[5], qr[2], C1),   P1[6], P1[7], P1[8], P1[9],     pw2[2] = PKW(P1, 4), pw2[3] = PKW(P1, 6), pw2); \
    VRD(3); A2_SBAR(); GAPA(C0 = MFMA32(kf[6], qr[3], C0),   P1[10], P1[11], P1[12], P1[13], pw3[0] = PKW(P1, 8), pw3[1] = PKW(P1, 10), pw3); \
    VRD(7); A2_SBAR(); GAPA(C1 = MFMA32(kf[7], qr[3], C1),   P1[14], P1[15], 0.f, 0.f,       pw3[2] = PKW(P1, 12), pw3[3] = PKW(P1, 14), pw3); \
    l_reg += sacc; \
    if (GK) { DMA_K((t) + 3, sl_cur); } if (GV) { DMA_V((t) + 1, sl_next); } \
    A2_SWAIT4(ma0_, ma1_, mb0_, mb1_); A2_SBAR(); \
    GAPB(o[0] = MFMA32(PAF(0), VFR(0), o[0]), C0, 0, 0, ma0_); \
    GAPB(o[1] = MFMA32(PAF(0), VFR(4), o[1]), C0, 4, 4, ma0_); \
    KRD(GL, 0); GAPB(o[0] = MFMA32(PAF(1), VFR(1), o[0]), C0, 8, 0, ma1_); \
    KRD(GL, 1); GAPB(o[1] = MFMA32(PAF(1), VFR(5), o[1]), C0, 12, 4, ma1_); \
    KRD(GL, 2); GAPB(o[0] = MFMA32(PAF(2), VFR(2), o[0]), C1, 0, 0, mb0_); \
    KRD(GL, 3); GAPB(o[1] = MFMA32(PAF(2), VFR(6), o[1]), C1, 4, 4, mb0_); \
    GAPB(o[0] = MFMA32(PAF(3), VFR(3), o[0]), C1, 8, 0, mb1_); \
    GAPB(o[1] = MFMA32(PAF(3), VFR(7), o[1]), C1, 12, 4, mb1_); \
    } while (0)
    int t = 1;
    for (; t + 5 < NT; t += 2) {
        STEP(pB0, pB1, pA0, pA1, t, true, true, true);     A2_WAIT_BAR(2); ROT();
        STEP(pA0, pA1, pB0, pB1, t + 1, true, true, true); A2_WAIT_BAR(2); ROT();
    }
#define ENDW(tt) do { if ((tt) + 3 < NT) { A2_WAIT_BAR(2); } else if ((tt) + 2 < NT) { A2_WAIT_BAR(1); } else { A2_WAIT_BAR(0); } } while (0)
    for (; t + 1 < NT; t += 2) {
        STEP(pB0, pB1, pA0, pA1, t, (t + 3 < NT), (t + 1 < NT), (t + 1 < NT));         ENDW(t);     ROT();
        STEP(pA0, pA1, pB0, pB1, t + 1, (t + 4 < NT), (t + 2 < NT), (t + 2 < NT));     ENDW(t + 1); ROT();
    }
    STEP(pB0, pB1, pA0, pA1, NT - 1, false, false, false);
    { float sacc = pB0[0] + pB0[1];
#pragma unroll
      for (int r = 2; r < 16; ++r) sacc += pB0[r];
#pragma unroll
      for (int r = 0; r < 16; ++r) sacc += pB1[r];
      l_reg += sacc;
      pw0 = (u32x4){PKW(pB0, 0), PKW(pB0, 2), PKW(pB0, 4), PKW(pB0, 6)}; pw1 = (u32x4){PKW(pB0, 8), PKW(pB0, 10), PKW(pB0, 12), PKW(pB0, 14)};
      pw2 = (u32x4){PKW(pB1, 0), PKW(pB1, 2), PKW(pB1, 4), PKW(pB1, 6)}; pw3 = (u32x4){PKW(pB1, 8), PKW(pB1, 10), PKW(pB1, 12), PKW(pB1, 14)};
      A2_SBAR();
      const LAS unsigned char* vp_ = vp0 + sl_cur;
#pragma unroll
      for (int d0 = 0; d0 < 2; ++d0) {
#pragma unroll
          for (int ks = 0; ks < 4; ++ks) { VRD(d0 * 4 + ks); }
          o[d0] = MFMA32(PAF(0), VFR(d0 * 4 + 0), o[d0]); o[d0] = MFMA32(PAF(1), VFR(d0 * 4 + 1), o[d0]); o[d0] = MFMA32(PAF(2), VFR(d0 * 4 + 2), o[d0]); o[d0] = MFMA32(PAF(3), VFR(d0 * 4 + 3), o[d0]); } }
    l_reg = sum_x32(l_reg);
    if (hi == 0) wsf[32 + r32] = l_reg;
    WAIT_L(0);
    float rli[16];
#pragma unroll
    for (int r = 0; r < 16; ++r) rli[r] = RCPF(wsf[32 + crow(r, hi)]);
    bf16_t* Ow = Qg + (size_t)(q0 + wid * 32) * D_MODEL + h * 64;
    { LAS bf16_t* stg = (LAS bf16_t*)(F.lds + A2_OST) + wid * 2048;
#pragma unroll
      for (int r = 0; r < 16; ++r) { const int orow = crow(r, hi);
#pragma unroll
          for (int d0 = 0; d0 < 2; ++d0) stg[orow * 64 + d0 * 32 + r32] = (bf16_t)f2bf(o[d0][r] * rli[r]); }
      WAIT_L(0);
#pragma unroll
      for (int i = 0; i < 4; ++i) { const int row = i * 8 + (lane >> 3), ch = lane & 7; const u32x4 v = *(const LAS u32x4*)(stg + row * 64 + ch * 8); *(u32x4*)(Ow + (size_t)row * D_MODEL + ch * 8) = v; } }
    A2_WAIT_BAR(0);
#undef DMA_K
#undef DMA_V
#undef ROT
#undef KLOAD2
#undef PKW
#undef PAF
#undef VFR
#undef GAPA
#undef GAPB
#undef VRD
#undef KRD
#undef STEP
#undef ENDW
}
__device__ __forceinline__ void attn_phase(Frame& F) {
    constexpr int NQB = SEQ / 256, NP = N_HEADS * (NQB / 2);
    const bool remap = (F.G == 256 && N_HEADS == 16 && NQB == 64);
    for (int p = F.vcu, i = 0; p < NP; p += F.G, ++i) {
        const int head = remap ? (F.vcu >> 5) + 8 * ((F.vcu & 31) >> 4) : p / (NQB / 2), s = remap ? (F.vcu & 15) + 16 * i : p % (NQB / 2);
        attn_unit2(F, head, s); attn_unit2(F, head, NQB - 1 - s); }
    __syncthreads();
}

#ifdef EMU
#define CG_SYNC() emu::grid_barrier()
#define LDS_DECL(name) unsigned char* name = emu::lds_ptr()
#else
namespace cg = cooperative_groups;
#define CG_SYNC() cg::this_grid().sync()
#define LDS_DECL(name) extern __shared__ __attribute__((aligned(16))) unsigned char name[]
#endif

#ifdef EMU
static int g_emu_max_layers = DEPTH;
#define MAX_LAYERS g_emu_max_layers
static int g_emu_stop = 0;
#define EMU_STOP(k) do { if (g_emu_stop == (k)) return; } while (0)
#else
#define MAX_LAYERS DEPTH
#define EMU_SNAPSHOT() do {} while (0)
#define EMU_STOP(k) do {} while (0)
#endif
__global__ void __launch_bounds__(NTHREADS, 2) mega_fwd(Args args) {
    LDS_DECL(lds_raw);
    Frame F;
    F.lds = (LAS unsigned char*)lds_raw; F.tid = threadIdx.x; F.lane = F.tid & 63; F.wave = RFL(F.tid >> 6);
    F.G = gridDim.x; { const int bx = blockIdx.x; F.vcu = (F.G % 8 == 0) ? (bx % 8) * (F.G / 8) + bx / 8 : bx; }
#pragma unroll
    for (int i = 0; i < 18; ++i) F.in[i] = args.in[i];
    F.out = args.out; F.ws = args.ws;
    volatile LAS unsigned* MISC = (volatile LAS unsigned*)(F.lds + LDSCTL_OFF + 1024);
    if (F.tid < 64) MISC[F.tid] = 0u;
    __syncthreads();
    XcdBarrier bar = xcd_barrier_post((unsigned*)(F.ws + WS_CTL) + 4096, MISC + 8);
#define GRID_BAR() xcd_barrier(bar)
    u64* rowss = (u64*)(F.ws + WS_ROWSS); bf16_t* XB = (bf16_t*)(F.ws + WS_XB);
    LAS unsigned char* ring = F.lds;

#ifndef KN
#define KN 0xffff
#endif
#ifndef TSEL
#define TSEL 0
#endif
#if TSEL && !defined(EMU)
    unsigned long long tacc = 0ull, tt0 = 0ull;
#define T_BEGIN(bit) do { if (TSEL & (bit)) tt0 = wall_clock64(); } while (0)
#define T_END(bit) do { if (TSEL & (bit)) tacc += wall_clock64() - tt0; } while (0)
#else
#define T_BEGIN(bit)
#define T_END(bit)
#endif
    T_BEGIN(1);
    if (KN & 1) { s5_pre(F);
    WAIT_VM0(); __syncthreads();
    s5_setup(F);
    __syncthreads();
    convert_weights(F);
    prologue_rows(F); }
    EMU_STOP(1);
    GRID_BAR(); T_END(1);
    if (opaque_s(0) != 0) CG_SYNC();

    const Frame F_ = F;
    for (int layer = 0; layer < MAX_LAYERS; ++layer) {
        const int j = layer >> 1;
        Frame F = F_; F.ws = opaque_p(F_.ws); u64* rowss = (u64*)(F.ws + WS_ROWSS); bf16_t* XB = (bf16_t*)(F.ws + WS_XB);
        u64* rs_mix = rowss + (size_t)(2 * layer) * SEQ; u64* rs_ffn = rowss + (size_t)(2 * layer + 1) * SEQ; u64* rs_next = rowss + (size_t)(2 * layer + 2) * SEQ;
        if ((layer & 1) == 0) {
            T_BEGIN(2); if (KN & 2) s5_build_ux(F, XB, rs_mix, F.in[16] + (size_t)layer * D_MODEL);
            GRID_BAR(); T_END(2); EMU_STOP(2);
            T_BEGIN(4); if (KN & 4) { pg8::Gemm g{(const bf16_t*)(F.ws + WS_R + R_UX), (const bf16_t*)(F.ws + WS_S5TAB + (size_t)j * SZ_S5TAB + MIX_W1), UXW, 256, 256}; pg8::GroupOrder S{F.G, F.vcu};
              EpiS5State E{(bf16_t*)(F.ws + WS_R + R_S)}; pg8::gemm_phase(ring, F.wave, g, S, E); }
            GRID_BAR(); T_END(4); EMU_STOP(3);
            T_BEGIN(8); if (KN & 8) s5_scan(F, j);
            GRID_BAR(); T_END(8); EMU_STOP(4);
            T_BEGIN(16); if (KN & 16) { pg8::Gemm g{(const bf16_t*)(F.ws + WS_R + R_UX), (const bf16_t*)(F.ws + WS_S5TAB + (size_t)j * SZ_S5TAB + MIX_AM), UXW, UXW, UXW}; pg8::GroupOrder S{F.G, F.vcu};
              EpiS5Out E{(bf16_t*)(F.ws + WS_R + R_Y), (const bf16_t*)(F.ws + WS_R + R_UX), F.in[8] + (size_t)j * D_MODEL}; pg8::gemm_phase(ring, F.wave, g, S, E); }
            GRID_BAR(); T_END(16); EMU_STOP(5);
            T_BEGIN(32); if (KN & 32) { pg8::Gemm g{(const bf16_t*)(F.ws + WS_R + R_Y), (const bf16_t*)(F.ws + WS_WGLU + j * SZ_WGLU), D_MODEL, D_MODEL, D_MODEL}; pg8::StaticOrder S; S.init(SEQ, 2 * D_MODEL, F.G, (int)blockIdx.x);
              EpiRes<true> E{XB, nullptr, rs_ffn}; pg8::gemm_phase(ring, F.wave, g, S, E); }
            GRID_BAR(); T_END(32);
        } else {
            T_BEGIN(64); if (KN & 64) { pg8::Gemm g{XB, (const bf16_t*)(F.ws + WS_WIN + j * SZ_WIN), D_MODEL, D_MODEL, D_MODEL}; pg8::StaticOrder S; S.init(SEQ, NIN_PAD, F.G, (int)blockIdx.x);
              EpiInProj E{(bf16_t*)(F.ws + WS_R + R_Q), (bf16_t*)(F.ws + WS_R + R_K), (bf16_t*)(F.ws + WS_R + R_V), (bf16_t*)(F.ws + WS_MIX + MIX_QI), (bf16_t*)(F.ws + WS_MIX + MIX_KI), (float*)(F.ws + WS_MIX + MIX_WI),
                          rs_mix, (const float*)(F.ws + WS_ROPE), F.in[11] + (size_t)j * 64, F.in[12] + (size_t)j * 64};
              pg8::gemm_phase(ring, F.wave, g, S, E); }
            GRID_BAR(); T_END(64); EMU_STOP(7);
            T_BEGIN(128); if (KN & 128) indexer_phase(F);
            GRID_BAR(); T_END(128); EMU_STOP(8);
            T_BEGIN(256); if (KN & 256) attn_phase(F);
            GRID_BAR(); T_END(256); EMU_STOP(9);
            T_BEGIN(512); if (KN & 512) { pg8::Gemm g{(const bf16_t*)(F.ws + WS_R + R_Q), (const bf16_t*)(F.ws + WS_WO + j * SZ_WO), D_MODEL, D_MODEL, D_MODEL}; pg8::StaticOrder S; S.init(SEQ, D_MODEL, F.G, (int)blockIdx.x);
              EpiRes<false> E{XB, nullptr, rs_ffn}; pg8::gemm_phase(ring, F.wave, g, S, E); }
            GRID_BAR(); T_END(512);
        }
        EMU_SNAPSHOT();
        T_BEGIN(1024); if (KN & 1024) { pg8::Gemm g{XB, (const bf16_t*)(F.ws + WS_WGU + layer * SZ_WGU), D_MODEL, D_MODEL, D_MODEL}; pg8::StaticOrder S; S.init(SEQ, 2 * D_FF, F.G, (int)blockIdx.x);
          EpiSwiGLU E{(bf16_t*)(F.ws + WS_R + R_ACT), rs_ffn}; pg8::gemm_phase(ring, F.wave, g, S, E); }
        if ((KN & 1) && opaque_s(layer) + 1 < MAX_LAYERS) convert_next_layer(F, layer + 1);
        GRID_BAR(); T_END(1024);
        T_BEGIN(2048); if (KN & 2048) { pg8::Gemm g{(const bf16_t*)(F.ws + WS_R + R_ACT), (const bf16_t*)(F.ws + WS_WDN + layer * SZ_WDN), D_FF, D_FF, D_FF}; pg8::StaticOrder S; S.init(SEQ, D_MODEL, F.G, (int)blockIdx.x);
          EpiRes<false> E{XB, opaque_s(layer) + 1 < MAX_LAYERS ? nullptr : F.out, rs_next}; pg8::gemm_phase(ring, F.wave, g, S, E); }
        if (opaque_s(layer) + 1 < DEPTH) GRID_BAR();
#ifdef EMU
        else GRID_BAR();
        EMU_SNAPSHOT();
#endif
        T_END(2048);
    }
#if TSEL && !defined(EMU)
    GRID_BAR(); if (blockIdx.x == 0 && threadIdx.x == 0) F_.out[0] += (float)tacc * 1e-4f;
#endif
}

#ifndef EMU
extern "C" void kernel_launch(void* const* d_in, const int* in_sizes, int n_in, void* d_out, int out_size, void* d_ws, size_t ws_size, hipStream_t stream) {
    static int grid = 0;
    if (grid == 0) {
        if (n_in != 18 || out_size != SEQ * D_MODEL || ws_size < WS_END) { fprintf(stderr, "kernel_launch: unexpected shapes (n_in %d out %d ws %zu need %zu)\n", n_in, out_size, ws_size, (size_t)WS_END); grid = -1; return; }
        int dev = 0, cus = 0, per_cu = 0;
        hipGetDevice(&dev); hipDeviceGetAttribute(&cus, hipDeviceAttributeMultiprocessorCount, dev);
        hipFuncSetAttribute((const void*)mega_fwd, hipFuncAttributeMaxDynamicSharedMemorySize, LDS_BYTES);
        hipOccupancyMaxActiveBlocksPerMultiprocessor(&per_cu, (const void*)mega_fwd, NTHREADS, LDS_BYTES);
        if (per_cu < 1) { fprintf(stderr, "kernel_launch: occupancy query says %d blocks/CU\n", per_cu); grid = -1; return; }
        grid = cus;
        (void)hipGetLastError();
    }
    if (grid < 0) return;
    hipMemsetAsync((char*)d_ws + WS_CTL, 0, CTL_BYTES, stream);
    Args a{};
    for (int i = 0; i < 18; ++i) a.in[i] = (const float*)d_in[i];
    a.out = (float*)d_out; a.ws = (unsigned char*)d_ws;
    void* params[] = {&a};
    hipError_t e = hipLaunchCooperativeKernel((const void*)mega_fwd, dim3(grid), dim3(NTHREADS), params, LDS_BYTES, stream);
    if (e != hipSuccess) fprintf(stderr, "cooperative launch failed: %s (grid %d)\n", hipGetErrorString(e), grid);
}
#endif
```
